# Optimizing an MI355X kernel written in HIP

```python
import jax
import jax.numpy as jnp
from jax import lax
import numpy as np

D_MODEL = 1024
BATCH = 4
SEQ = 8192
DEPTH = 2

CHUNK = 64
EPS = 1e-6
CONV_W = 4
N_BRANCH = 4
BR_WIDTH = D_MODEL // 2

RG_BLOCKS = 8
RG_BLOCK = BR_WIDTH // RG_BLOCKS
RG_C = 8.0

SSD_HEAD_DIM = 64
SSD_HEADS = BR_WIDTH // SSD_HEAD_DIM
SSD_GROUPS = 2
SSD_HPG = SSD_HEADS // SSD_GROUPS
SSD_STATE = 128
SSD_XBC = BR_WIDTH + 2 * SSD_GROUPS * SSD_STATE

ML_HEADS = 4
ML_HEAD_DIM = BR_WIDTH // ML_HEADS

RET_HEADS = 4
RET_QK_DIM = 64
RET_V_DIM = BR_WIDTH // RET_HEADS
ROPE_BASE = 10000.0

IN_WIDTHS = (
    BR_WIDTH, BR_WIDTH,
    SSD_XBC, BR_WIDTH, SSD_HEADS,
    BR_WIDTH, BR_WIDTH, BR_WIDTH, BR_WIDTH, BR_WIDTH,
    ML_HEADS, ML_HEADS,
    RET_HEADS * RET_QK_DIM, RET_HEADS * RET_QK_DIM,
    BR_WIDTH, BR_WIDTH,
    N_BRANCH * D_MODEL,
)
W_IN = sum(IN_WIDTHS)
SPLIT_POINTS = tuple(int(v) for v in np.cumsum(IN_WIDTHS)[:-1])

kernel_name = 'hybrid_rglru_ssd_mlstm_retention_encoder'


def rmsnorm(x, g):
    xf = x.astype(jnp.float32)
    y = xf * lax.rsqrt(jnp.mean(xf * xf, axis=-1, keepdims=True) + EPS)
    return (y * g.astype(jnp.float32)).astype(x.dtype)


def headwise_rmsnorm(y, g, n_heads):
    b, s, w = y.shape
    yh = y.reshape(b, s, n_heads, w // n_heads).astype(jnp.float32)
    yh = yh * lax.rsqrt(jnp.mean(yh * yh, axis=-1, keepdims=True) + EPS)
    return yh.reshape(b, s, w) * g.astype(jnp.float32)


def causal_depthwise_conv(x, w, b):
    s = x.shape[1]
    xp = jnp.pad(x, ((0, 0), (CONV_W - 1, 0), (0, 0)))
    out = b + w[CONV_W - 1] * x
    for j in range(CONV_W - 1):
        out = out + w[j] * xp[:, j:j + s]
    return out


def causal_mask(n):
    return jnp.tril(jnp.ones((n, n), dtype=bool))


def segsum_exp(a_cs):
    diff = a_cs[..., :, None] - a_cs[..., None, :]
    return jnp.exp(jnp.where(causal_mask(a_cs.shape[-1]), diff, -jnp.inf))


def chunk_heads(t, n_heads):
    b, s, w = t.shape
    return t.reshape(b, s // CHUNK, CHUNK, n_heads, w // n_heads).transpose(0, 3, 1, 2, 4).astype(jnp.float32)


def chunk_gates(t, n_heads):
    b, s, _ = t.shape
    return t.reshape(b, s // CHUNK, CHUNK, n_heads).transpose(0, 3, 1, 2).astype(jnp.float32)


def rope(x, pos):
    half = x.shape[-1] // 2
    inv = ROPE_BASE ** (-jnp.arange(half, dtype=jnp.float32) / half)
    ang = pos.astype(jnp.float32)[:, None] * inv
    cos = jnp.cos(ang)[None, :, None, :]
    sin = jnp.sin(ang)[None, :, None, :]
    x1, x2 = x[..., :half], x[..., half:]
    return jnp.concatenate([x1 * cos - x2 * sin, x1 * sin + x2 * cos], axis=-1)


def rglru_branch(u, z, conv_w, conv_b, wa, ba, wx, bx, lam):
    bsz, s, _ = u.shape
    xc = causal_depthwise_conv(u, conv_w, conv_b)
    xb = xc.reshape(bsz, s, RG_BLOCKS, RG_BLOCK)
    r = jax.nn.sigmoid(jnp.einsum('bshi,hij->bshj', xb, wa).reshape(bsz, s, BR_WIDTH) + ba)
    i = jax.nn.sigmoid(jnp.einsum('bshi,hij->bshj', xb, wx).reshape(bsz, s, BR_WIDTH) + bx)
    log_a = -RG_C * r.astype(jnp.float32) * jax.nn.softplus(-lam.astype(jnp.float32))
    a = jnp.exp(log_a)
    drive = jnp.sqrt(-jnp.expm1(2.0 * log_a)) * (i * xc).astype(jnp.float32)

    def combine(left, right):
        a1, b1 = left
        a2, b2 = right
        return a1 * a2, a2 * b1 + b2

    _, h = lax.associative_scan(combine, (a, drive), axis=1)
    return h * jax.nn.silu(z.astype(jnp.float32))


def ssd_branch(xbc_raw, z, dt_raw, conv_w, conv_b, dt_bias, a_log, d_skip, norm_g):
    bsz, s, _ = z.shape
    nc = s // CHUNK
    xbc = jax.nn.silu(causal_depthwise_conv(xbc_raw, conv_w, conv_b)).astype(jnp.float32)
    gn = SSD_GROUPS * SSD_STATE
    xh = xbc[..., :BR_WIDTH].reshape(bsz, nc, CHUNK, SSD_GROUPS, SSD_HPG, SSD_HEAD_DIM)
    bm = xbc[..., BR_WIDTH:BR_WIDTH + gn].reshape(bsz, nc, CHUNK, SSD_GROUPS, SSD_STATE)
    cm = xbc[..., BR_WIDTH + gn:].reshape(bsz, nc, CHUNK, SSD_GROUPS, SSD_STATE)
    dt = jax.nn.softplus(dt_raw.astype(jnp.float32) + dt_bias.astype(jnp.float32))
    a_dt = -jnp.exp(a_log.astype(jnp.float32)) * dt
    x_dt = xh * dt.reshape(bsz, nc, CHUNK, SSD_GROUPS, SSD_HPG)[..., None]
    a_cs = jnp.cumsum(a_dt.reshape(bsz, nc, CHUNK, SSD_GROUPS, SSD_HPG).transpose(0, 3, 4, 1, 2), axis=-1)
    cb = jnp.einsum('bclgn,bcsgn->bgcls', cm, bm)
    y_diag = jnp.einsum('bgcls,bgecls,bcsgep->bclgep', cb, segsum_exp(a_cs), x_dt)
    decay_to_end = jnp.exp(a_cs[..., -1:] - a_cs)
    states = jnp.einsum('bclgn,bgecl,bclgep->bcgepn', bm, decay_to_end, x_dt)
    chunk_decay = jnp.exp(a_cs[..., -1])

    def step(h, inp):
        dec, st = inp
        return dec[..., None, None] * h + st, h

    h0 = jnp.zeros((bsz, SSD_GROUPS, SSD_HPG, SSD_HEAD_DIM, SSD_STATE), jnp.float32)
    _, prev = lax.scan(step, h0, (jnp.moveaxis(chunk_decay, -1, 0), jnp.moveaxis(states, 1, 0)))
    y_off = jnp.einsum('bclgn,cbgepn,bgecl->bclgep', cm, prev, jnp.exp(a_cs))
    y = y_diag + y_off + d_skip.astype(jnp.float32).reshape(SSD_GROUPS, SSD_HPG)[:, :, None] * xh
    y = y.reshape(bsz, s, BR_WIDTH)
    return rmsnorm(y * jax.nn.silu(z.astype(jnp.float32)), norm_g)


def mlstm_branch(q, k, v, o_raw, z, i_raw, f_raw, i_bias, f_bias, norm_g):
    bsz, s, _ = q.shape
    qh = chunk_heads(q, ML_HEADS)
    kh = chunk_heads(k, ML_HEADS) * (ML_HEAD_DIM ** -0.5)
    vh = chunk_heads(v, ML_HEADS)
    log_i = chunk_gates(i_raw, ML_HEADS) + i_bias.astype(jnp.float32)[None, :, None, None]
    log_f = jax.nn.log_sigmoid(chunk_gates(f_raw, ML_HEADS) + f_bias.astype(jnp.float32)[None, :, None, None])
    f_cs = jnp.cumsum(log_f, axis=-1)
    f_tot = f_cs[..., -1]
    w_end = f_tot[..., None] - f_cs + log_i
    m_loc = jnp.max(w_end, axis=-1)
    p_end = jnp.exp(w_end - m_loc[..., None])
    c_loc = jnp.einsum('bhcl,bhcld,bhcle->bhcde', p_end, vh, kh)
    n_loc = jnp.einsum('bhcl,bhcle->bhce', p_end, kh)

    def step(carry, inp):
        c_st, n_st, m_st = carry
        ft, ml, cl, nl = inp
        m_new = jnp.maximum(ft + m_st, ml)
        s_old = jnp.exp(ft + m_st - m_new)
        s_loc = jnp.exp(ml - m_new)
        c_new = s_old[..., None, None] * c_st + s_loc[..., None, None] * cl
        n_new = s_old[..., None] * n_st + s_loc[..., None] * nl
        return (c_new, n_new, m_new), (c_st, n_st, m_st)

    init = (jnp.zeros((bsz, ML_HEADS, ML_HEAD_DIM, ML_HEAD_DIM), jnp.float32),
            jnp.zeros((bsz, ML_HEADS, ML_HEAD_DIM), jnp.float32),
            jnp.zeros((bsz, ML_HEADS), jnp.float32))
    _, (c_prev, n_prev, m_prev) = lax.scan(
        step, init, (jnp.moveaxis(f_tot, 2, 0), jnp.moveaxis(m_loc, 2, 0),
                     jnp.moveaxis(c_loc, 2, 0), jnp.moveaxis(n_loc, 2, 0)))
    m_prev = jnp.moveaxis(m_prev, 0, 2)
    log_d = f_cs[..., :, None] - f_cs[..., None, :] + log_i[..., None, :]
    log_d = jnp.where(causal_mask(CHUNK), log_d, -jnp.inf)
    log_a = f_cs + m_prev[..., None]
    m_row = jnp.maximum(log_a, jnp.max(log_d, axis=-1))
    scores = jnp.einsum('bhcld,bhcsd->bhcls', qh, kh) * jnp.exp(log_d - m_row[..., None])
    scale_prev = jnp.exp(log_a - m_row)
    num = jnp.einsum('bhcls,bhcsd->bhcld', scores, vh) + scale_prev[..., None] * jnp.einsum('cbhde,bhcle->bhcld', c_prev, qh)
    den = jnp.sum(scores, axis=-1) + scale_prev * jnp.einsum('cbhe,bhcle->bhcl', n_prev, qh)
    h = num / jnp.maximum(jnp.abs(den), jnp.exp(-m_row))[..., None]
    h = h.transpose(0, 2, 3, 1, 4).reshape(bsz, s, BR_WIDTH)
    h = jax.nn.sigmoid(o_raw.astype(jnp.float32)) * h
    return headwise_rmsnorm(h, norm_g, ML_HEADS) * jax.nn.silu(z.astype(jnp.float32))


def retention_branch(q, k, v, z, norm_g):
    bsz, s, _ = q.shape
    pos = jnp.arange(s)
    qr = rope(q.reshape(bsz, s, RET_HEADS, RET_QK_DIM).astype(jnp.float32), pos)
    kr = rope(k.reshape(bsz, s, RET_HEADS, RET_QK_DIM).astype(jnp.float32), pos) * (RET_QK_DIM ** -0.5)
    qh = chunk_heads(qr.reshape(bsz, s, -1), RET_HEADS)
    kh = chunk_heads(kr.reshape(bsz, s, -1), RET_HEADS)
    vh = chunk_heads(v, RET_HEADS)
    log_g = jnp.log1p(-jnp.exp2(-5.0 - jnp.arange(RET_HEADS, dtype=jnp.float32)))
    idx = jnp.arange(CHUNK, dtype=jnp.float32)
    rel = idx[:, None] - idx[None, :]
    dmat = jnp.where(rel >= 0, jnp.exp(log_g[:, None, None] * jnp.maximum(rel, 0.0)), 0.0)
    inner = jnp.einsum('bhcld,bhcsd->bhcls', qh, kh) * dmat[None, :, None]
    y_in = jnp.einsum('bhcls,bhcse->bhcle', inner, vh)
    dec_end = jnp.exp(log_g[:, None] * (CHUNK - 1.0 - idx))
    r_loc = jnp.einsum('bhcld,hl,bhcle->bhcde', kh, dec_end, vh)
    chunk_dec = jnp.exp(log_g * CHUNK)

    def step(r_st, r_c):
        return chunk_dec[None, :, None, None] * r_st + r_c, r_st

    r0 = jnp.zeros((bsz, RET_HEADS, RET_QK_DIM, RET_V_DIM), jnp.float32)
    _, r_prev = lax.scan(step, r0, jnp.moveaxis(r_loc, 2, 0))
    dec_start = jnp.exp(log_g[:, None] * (idx + 1.0))
    y = y_in + jnp.einsum('bhcld,cbhde,hl->bhcle', qh, r_prev, dec_start)
    y = y.transpose(0, 2, 3, 1, 4).reshape(bsz, s, BR_WIDTH)
    return headwise_rmsnorm(y, norm_g, RET_HEADS) * jax.nn.silu(z.astype(jnp.float32))


def hybrid_layer(x, norm_g, w_in, a_conv_w, a_conv_b, a_gate_a_w, a_gate_a_b, a_gate_x_w,
                 a_gate_x_b, a_lambda, b_conv_w, b_conv_b, b_dt_bias, b_a_log, b_d_skip,
                 b_norm_g, c_i_bias, c_f_bias, c_norm_g, d_norm_g, w_branch, w_out):
    bsz, s, _ = x.shape
    hn = rmsnorm(x, norm_g)
    proj = jnp.einsum('bsd,dw->bsw', hn, w_in)
    (a_x, a_z, b_xbc, b_z, b_dt, c_q, c_k, c_v, c_o, c_z, c_i, c_f,
     d_q, d_k, d_v, d_z, gates) = jnp.split(proj, SPLIT_POINTS, axis=-1)
    y_a = rglru_branch(a_x, a_z, a_conv_w, a_conv_b, a_gate_a_w, a_gate_a_b, a_gate_x_w, a_gate_x_b, a_lambda)
    y_b = ssd_branch(b_xbc, b_z, b_dt, b_conv_w, b_conv_b, b_dt_bias, b_a_log, b_d_skip, b_norm_g)
    y_c = mlstm_branch(c_q, c_k, c_v, c_o, c_z, c_i, c_f, c_i_bias, c_f_bias, c_norm_g)
    y_d = retention_branch(d_q, d_k, d_v, d_z, d_norm_g)
    branches = jnp.stack([y_a, y_b, y_c, y_d], axis=2).astype(x.dtype)
    up = jnp.einsum('bsnw,nwd->bsnd', branches, w_branch)
    g = jax.nn.sigmoid(gates.reshape(bsz, s, N_BRANCH, D_MODEL))
    merged = jnp.sum(g * up, axis=2)
    return x + jnp.einsum('bsd,de->bse', merged, w_out)


def setup_inputs(seed: int = 0) -> dict:
    key = jax.random.key(seed)
    ks = jax.random.split(key, 24)
    f32 = jnp.float32

    def nrm(k, shape, scale):
        return jax.random.normal(k, shape, f32) * scale

    L = DEPTH
    u_lam = jax.random.uniform(ks[9], (L, BR_WIDTH), f32, 0.9, 0.999)
    base = u_lam ** (1.0 / RG_C)
    dt0 = jnp.exp(jax.random.uniform(ks[12], (L, SSD_HEADS), f32, np.log(0.001), np.log(0.1)))
    return {
        'x': nrm(ks[0], (BATCH, SEQ, D_MODEL), 1.0),
        'norm_g': 1.0 + nrm(ks[1], (L, D_MODEL), 0.02),
        'w_in': nrm(ks[2], (L, D_MODEL, W_IN), D_MODEL ** -0.5),
        'a_conv_w': nrm(ks[3], (L, CONV_W, BR_WIDTH), CONV_W ** -0.5),
        'a_conv_b': nrm(ks[4], (L, BR_WIDTH), 0.02),
        'a_gate_a_w': nrm(ks[5], (L, RG_BLOCKS, RG_BLOCK, RG_BLOCK), RG_BLOCK ** -0.5),
        'a_gate_a_b': nrm(ks[6], (L, BR_WIDTH), 0.02),
        'a_gate_x_w': nrm(ks[7], (L, RG_BLOCKS, RG_BLOCK, RG_BLOCK), RG_BLOCK ** -0.5),
        'a_gate_x_b': nrm(ks[8], (L, BR_WIDTH), 0.02),
        'a_lambda': jnp.log(base) - jnp.log1p(-base),
        'b_conv_w': nrm(ks[10], (L, CONV_W, SSD_XBC), CONV_W ** -0.5),
        'b_conv_b': nrm(ks[11], (L, SSD_XBC), 0.02),
        'b_dt_bias': dt0 + jnp.log(-jnp.expm1(-dt0)),
        'b_a_log': jnp.log(jax.random.uniform(ks[13], (L, SSD_HEADS), f32, 1.0, 16.0)),
        'b_d_skip': 1.0 + nrm(ks[14], (L, SSD_HEADS), 0.1),
        'b_norm_g': 1.0 + nrm(ks[15], (L, BR_WIDTH), 0.02),
        'c_i_bias': nrm(ks[16], (L, ML_HEADS), 0.1),
        'c_f_bias': 3.0 + nrm(ks[17], (L, ML_HEADS), 0.5),
        'c_norm_g': 1.0 + nrm(ks[18], (L, BR_WIDTH), 0.02),
        'd_norm_g': 1.0 + nrm(ks[19], (L, BR_WIDTH), 0.02),
        'w_branch': nrm(ks[20], (L, N_BRANCH, BR_WIDTH, D_MODEL), BR_WIDTH ** -0.5),
        'w_out': nrm(ks[21], (L, D_MODEL, D_MODEL), D_MODEL ** -0.5),
        'final_norm_g': 1.0 + nrm(ks[22], (D_MODEL,), 0.02),
    }


def reference(x, norm_g, w_in, a_conv_w, a_conv_b, a_gate_a_w, a_gate_a_b, a_gate_x_w,
              a_gate_x_b, a_lambda, b_conv_w, b_conv_b, b_dt_bias, b_a_log, b_d_skip,
              b_norm_g, c_i_bias, c_f_bias, c_norm_g, d_norm_g, w_branch, w_out, final_norm_g):
    for l in range(DEPTH):
        x = hybrid_layer(x, norm_g[l], w_in[l], a_conv_w[l], a_conv_b[l], a_gate_a_w[l],
                         a_gate_a_b[l], a_gate_x_w[l], a_gate_x_b[l], a_lambda[l],
                         b_conv_w[l], b_conv_b[l], b_dt_bias[l], b_a_log[l], b_d_skip[l],
                         b_norm_g[l], c_i_bias[l], c_f_bias[l], c_norm_g[l], d_norm_g[l],
                         w_branch[l], w_out[l])
    return rmsnorm(x, final_norm_g)
```

```cpp
#include <hip/hip_runtime.h>
#include <hip/hip_cooperative_groups.h>
#include <cstdio>
#include <cstdint>

namespace pg8 {
#define PG8_LAS __attribute__((address_space(3)))
typedef unsigned short bf16_t;
typedef short bf16x8 __attribute__((ext_vector_type(8)));
typedef float f32x4 __attribute__((ext_vector_type(4)));
typedef unsigned u32x4 __attribute__((ext_vector_type(4)));
typedef unsigned u32x2 __attribute__((ext_vector_type(2)));
constexpr int BM = 256, BK = 64, HALF = 128, HTB = HALF * BK * 2  , STAGE_BYTES = 8 * HTB, NXCD = 8, WGM = 8;

__host__ __device__ __forceinline__ int lds_byte(int r, int c) { const int st = (r >> 4) * 2 + (c >> 5), rr = r & 15, cc = c & 31, ob = rr * 64 + cc * 2; return st * 1024 + (ob ^ (((ob >> 9) & 1) << 5)); }
__host__ __device__ __forceinline__ void stage_rc(int b, int& R, int& C) { const int st = b / 1024, sb = b % 1024, swz = sb ^ (((sb >> 9) & 1) << 5); R = (st >> 1) * 16 + swz / 64; C = (st & 1) * 32 + (swz % 64) / 2; }
__host__ __device__ __forceinline__ int perm32(int rho) { const int n = rho >> 4, i = rho & 15; return 8 * (i >> 2) + 4 * n + (i & 3); }

struct Unit { int pm, pn; };
struct Gemm { const bf16_t* A; const bf16_t* Bt; int M, N, K, lda, ldb; };

struct StaticOrder {
    int nM, nN, nwg, G, c;
    __host__ __device__ void init(int M, int N, int G_, int c_) { nM = M / BM; nN = N / BM; nwg = nM * nN; G = G_; c = c_; }
    __host__ __device__ bool next(int i, Unit& u) const {
        const long L = (long)i * G + c; if (L >= nwg) return false;
        int wgid = (int)L; { const int q = nwg / NXCD, r = nwg % NXCD, xcd = wgid % NXCD, off = wgid / NXCD; wgid = (xcd < r ? xcd * (q + 1) : r * (q + 1) + (xcd - r) * q) + off; }
        const int nig = WGM * nN, gid = wgid / nig, fm = gid * WGM, gsz = (nM - fm) < WGM ? (nM - fm) : WGM;
        u.pm = fm + ((wgid % nig) % gsz); u.pn = (wgid % nig) / gsz; return true;
    }
    __device__ __forceinline__ void a_ready(const Unit&) const {}
    __device__ __forceinline__ void done(const Unit&) const {}
};

__device__ __forceinline__ unsigned cvt_pk_bf16(float lo, float hi) { unsigned r; asm volatile("v_cvt_pk_bf16_f32 %0, %1, %2" : "=v"(r) : "v"(lo), "v"(hi)); return r; }
__device__ __forceinline__ float bf_lo(unsigned w) { return __uint_as_float(w << 16); }
__device__ __forceinline__ float bf_hi(unsigned w) { return __uint_as_float(w & 0xffff0000u); }
__device__ __forceinline__ float sigmoid_f(float x) { return 1.0f / (1.0f + __expf(-x)); }

struct EpiBf16S {
    static constexpr bool PERM = true, AFTER_DRAIN = false;
    bf16_t* O; int ldc; int sig;
    __device__ __forceinline__ void operator()(const f32x4 (&acc)[2][2][4][2], const Unit& u, int wr, int wc, int fr, int fq) const {
        const int row0 = u.pm * BM + wr * 64 + fr; const int col0 = u.pn * BM + wc * 32 + 8 * fq;
#pragma unroll
        for (int ai = 0; ai < 2; ++ai)
#pragma unroll
            for (int m = 0; m < 4; ++m) { bf16_t* rowp = O + (size_t)(row0 + ai * HALF + m * 16) * ldc + col0;
#pragma unroll
                for (int bj = 0; bj < 2; ++bj) { f32x4 v0 = acc[ai][bj][m][0], v1 = acc[ai][bj][m][1];
                    if (sig) {
#pragma unroll
                        for (int j = 0; j < 4; ++j) { v0[j] = sigmoid_f(v0[j]); v1[j] = sigmoid_f(v1[j]); } }
                    u32x4 w; w.x = cvt_pk_bf16(v0[0], v0[1]); w.y = cvt_pk_bf16(v0[2], v0[3]); w.z = cvt_pk_bf16(v1[0], v1[1]); w.w = cvt_pk_bf16(v1[2], v1[3]);
                    *(u32x4*)(rowp + bj * HALF) = w; } }
    }
};
struct EpiMergeRMW {
    static constexpr bool PERM = false, AFTER_DRAIN = false;
    const bf16_t* G; int ldg; float* M32; bf16_t* Mb; int ldc; int mode;
    __device__ __forceinline__ void operator()(const f32x4 (&acc)[2][2][4][2], const Unit& u, int wr, int wc, int fr, int fq) const {
        const int row0 = u.pm * BM + wr * 64 + fr, col0 = u.pn * BM + wc * 32 + 4 * fq;
#pragma unroll
        for (int ai = 0; ai < 2; ++ai)
#pragma unroll
            for (int m = 0; m < 4; ++m) { const size_t row = (size_t)(row0 + ai * HALF + m * 16);
#pragma unroll
                for (int bj = 0; bj < 2; ++bj)
#pragma unroll
                    for (int n = 0; n < 2; ++n) { const int c = col0 + bj * HALF + n * 16;
                        const u32x2 gw = *(const u32x2*)(G + row * ldg + c);
                        f32x4 g; g[0] = bf_lo(gw.x); g[1] = bf_hi(gw.x); g[2] = bf_lo(gw.y); g[3] = bf_hi(gw.y);
                        f32x4 v = acc[ai][bj][m][n] * g;
                        if (mode >= 1) v += *(const f32x4*)(M32 + row * ldc + c);
                        if (mode < 2) *(f32x4*)(M32 + row * ldc + c) = v;
                        else { u32x2 w; w.x = cvt_pk_bf16(v[0], v[1]); w.y = cvt_pk_bf16(v[2], v[3]); *(u32x2*)(Mb + row * ldc + c) = w; } } }
    }
};
struct EpiResid {
    static constexpr bool PERM = false, AFTER_DRAIN = false;
    const float* xin; float* out; int ldc;
    __device__ __forceinline__ void operator()(const f32x4 (&acc)[2][2][4][2], const Unit& u, int wr, int wc, int fr, int fq) const {
        const int row0 = u.pm * BM + wr * 64 + fr, col0 = u.pn * BM + wc * 32 + 4 * fq;
#pragma unroll
        for (int ai = 0; ai < 2; ++ai)
#pragma unroll
            for (int m = 0; m < 4; ++m) { const size_t off = (size_t)(row0 + ai * HALF + m * 16) * ldc + col0;
#pragma unroll
                for (int bj = 0; bj < 2; ++bj)
#pragma unroll
                    for (int n = 0; n < 2; ++n) { const f32x4 xs = *(const f32x4*)(xin + off + bj * HALF + n * 16); *(f32x4*)(out + off + bj * HALF + n * 16) = xs + acc[ai][bj][m][n]; } }
    }
};

template <class Epi, class Sched, bool ALIGN_EPI = false, bool SP2 = false>
__device__ __forceinline__ void gemm_phase(PG8_LAS unsigned char* lds, const Gemm g, const Sched& S, const Epi& E, const int tid) {
    const int wid = __builtin_amdgcn_readfirstlane(tid >> 6), lane = tid & 63, wr = wid >> 2, wc = wid & 3, fr = lane & 15, fq = lane >> 4;
    const int K = g.K, nt = K / BK;
    unsigned voffA[2], voffB[2];
#pragma unroll
    for (int i = 0; i < 2; ++i) { int R, C; stage_rc(tid * 16 + i * 8192, R, C); const int Rb = Epi::PERM ? ((R & ~31) + perm32(R & 31)) : R;
        voffA[i] = (unsigned)(R * g.lda + C) * 2u; voffB[i] = (unsigned)(Rb * g.ldb + C) * 2u; }
    const size_t kstep = (size_t)(BK * 2);
    const size_t hstepA = (size_t)HALF * g.lda * 2, hstepB = (size_t)HALF * g.ldb * 2;
    const size_t tstepA = 2 * hstepA, tstepB = 2 * hstepB;
    const unsigned ldsw = (unsigned)wid * 1024u;
    const int aoff = lds_byte(wr * 64 + fr, fq * 8), boff = lds_byte(wc * 32 + fr, fq * 8);
#define PG8_SA(b, h) (((b) * 2 + (h)) * HTB)
#define PG8_SB(b, h) ((4 + (b) * 2 + (h)) * HTB)
#define PG8_STAGE(bufoff, gbase, voff) do { _Pragma("unroll") for (int _i = 0; _i < 2; ++_i) \
        __builtin_amdgcn_global_load_lds((const unsigned*)((const char*)(gbase) + (voff)[_i]), (PG8_LAS unsigned*)(lds + (bufoff) + ldsw + _i * 8192), 16, 0, 0); } while (0)
#define PG8_LDA(dst, b, h) do { _Pragma("unroll") for (int m = 0; m < 4; ++m) _Pragma("unroll") for (int k = 0; k < 2; ++k) dst[m][k] = *(const PG8_LAS bf16x8*)(lds + PG8_SA(b, h) + aoff + m * 2048 + k * 1024); } while (0)
#define PG8_LDB(dst, b, h) do { _Pragma("unroll") for (int n = 0; n < 2; ++n) _Pragma("unroll") for (int k = 0; k < 2; ++k) dst[n][k] = *(const PG8_LAS bf16x8*)(lds + PG8_SB(b, h) + boff + n * 2048 + k * 1024); } while (0)
#define PG8_MMA(ai, bj, At, Bt) do { __builtin_amdgcn_s_setprio(1); _Pragma("unroll") for (int m = 0; m < 4; ++m) _Pragma("unroll") for (int n = 0; n < 2; ++n) _Pragma("unroll") for (int k = 0; k < 2; ++k) \
        acc[ai][bj][m][n] = __builtin_amdgcn_mfma_f32_16x16x32_bf16(Bt[n][k], At[m][k], acc[ai][bj][m][n], 0, 0, 0); __builtin_amdgcn_s_setprio(0); } while (0)
#define PG8_WAIT_V(n) asm volatile("s_waitcnt vmcnt(" #n ")" ::: "memory")
#define PG8_WAIT_L(n) asm volatile("s_waitcnt lgkmcnt(" #n ")" ::: "memory")
#define PG8_BAR __builtin_amdgcn_s_barrier()
#define PG8_SCHED __builtin_amdgcn_sched_barrier(0)
    Unit cur, nxt; int ui = 0;
    if (!S.next(0, cur)) return;
    f32x4 acc[2][2][4][2];
#pragma unroll
    for (int a = 0; a < 2; ++a)
#pragma unroll
        for (int b = 0; b < 2; ++b)
#pragma unroll
            for (int m = 0; m < 4; ++m)
#pragma unroll
                for (int n = 0; n < 2; ++n) acc[a][b][m][n] = (f32x4){0.f, 0.f, 0.f, 0.f};
    bf16x8 At[4][2], B0[2][2], B1[2][2];
    const char* cA = (const char*)g.A + (size_t)cur.pm * tstepA; const char* cB = (const char*)g.Bt + (size_t)cur.pn * tstepB;
    S.a_ready(cur);
    if constexpr (SP2) {
        PG8_STAGE(PG8_SB(0, 0), cB, voffB); PG8_STAGE(PG8_SB(0, 1), cB + hstepB, voffB); PG8_STAGE(PG8_SA(0, 0), cA, voffA); PG8_STAGE(PG8_SA(0, 1), cA + hstepA, voffA);
        if (wr == 1) PG8_BAR;
        PG8_WAIT_V(2); PG8_BAR;
        PG8_STAGE(PG8_SB(1, 0), cB + kstep, voffB); PG8_STAGE(PG8_SA(1, 0), cA + kstep, voffA); PG8_STAGE(PG8_SB(1, 1), cB + hstepB + kstep, voffB);
        PG8_WAIT_V(6); PG8_BAR;
    } else {
        PG8_STAGE(PG8_SB(0, 0), cB, voffB); PG8_STAGE(PG8_SA(0, 0), cA, voffA); PG8_STAGE(PG8_SB(0, 1), cB + hstepB, voffB); PG8_STAGE(PG8_SA(0, 1), cA + hstepA, voffA);
        if (wr == 1) PG8_BAR;
        PG8_WAIT_V(4); PG8_BAR;
        PG8_STAGE(PG8_SB(1, 0), cB + kstep, voffB); PG8_STAGE(PG8_SA(1, 0), cA + kstep, voffA); PG8_STAGE(PG8_SB(1, 1), cB + hstepB + kstep, voffB);
        PG8_WAIT_V(6); PG8_BAR;
    }
    for (;;) {
        const bool has_next = S.next(ui + 1, nxt);
        const char* nA = has_next ? (const char*)g.A + (size_t)nxt.pm * tstepA : cA; const char* nB = has_next ? (const char*)g.Bt + (size_t)nxt.pn * tstepB : cB;
        for (int t = 0; t < nt; t += 2) {
            const bool last = (t == nt - 2);
            const char* a1 = cA + (size_t)(t + 1) * kstep;
            const char* a2 = last ? nA : cA + (size_t)(t + 2) * kstep; const char* b2 = last ? nB : cB + (size_t)(t + 2) * kstep;
            const char* a3 = a2 + kstep; const char* b3 = b2 + kstep;
            if (last && has_next) S.a_ready(nxt);
            if constexpr (SP2) {
            PG8_LDB(B0, 0, 0); PG8_LDB(B1, 0, 1); PG8_SCHED; PG8_LDA(At, 0, 0); PG8_STAGE(PG8_SA(1, 1), a1 + hstepA, voffA);
            PG8_WAIT_V(8); PG8_WAIT_L(0); PG8_BAR; PG8_MMA(0, 0, At, B0); PG8_MMA(0, 1, At, B1); PG8_BAR; PG8_SCHED;
            PG8_LDA(At, 0, 1); PG8_STAGE(PG8_SB(0, 0), b2, voffB); PG8_STAGE(PG8_SB(0, 1), b2 + hstepB, voffB); PG8_STAGE(PG8_SA(0, 0), a2, voffA);
            PG8_WAIT_V(8); PG8_WAIT_L(0); PG8_BAR; PG8_MMA(1, 0, At, B0); PG8_MMA(1, 1, At, B1); PG8_BAR; PG8_SCHED;
            PG8_LDB(B0, 1, 0); PG8_LDB(B1, 1, 1); PG8_SCHED; PG8_LDA(At, 1, 0); PG8_STAGE(PG8_SA(0, 1), a2 + hstepA, voffA);
            PG8_WAIT_V(8); PG8_WAIT_L(0); PG8_BAR; PG8_MMA(0, 0, At, B0); PG8_MMA(0, 1, At, B1); PG8_BAR; PG8_SCHED;
            PG8_LDA(At, 1, 1); PG8_STAGE(PG8_SB(1, 0), b3, voffB); PG8_STAGE(PG8_SB(1, 1), b3 + hstepB, voffB); PG8_STAGE(PG8_SA(1, 0), a3, voffA);
            PG8_WAIT_V(8); PG8_WAIT_L(0); PG8_BAR; PG8_MMA(1, 0, At, B0); PG8_MMA(1, 1, At, B1); PG8_BAR; PG8_SCHED;
            } else {
            PG8_LDB(B0, 0, 0); PG8_SCHED; PG8_LDA(At, 0, 0); PG8_STAGE(PG8_SA(1, 1), a1 + hstepA, voffA);
            PG8_WAIT_L(8); PG8_BAR; PG8_WAIT_L(0); PG8_MMA(0, 0, At, B0); PG8_BAR; PG8_SCHED;
            PG8_LDB(B1, 0, 1); PG8_STAGE(PG8_SB(0, 0), b2, voffB);
            PG8_BAR; PG8_WAIT_L(0); PG8_MMA(0, 1, At, B1); PG8_BAR;
            PG8_LDA(At, 0, 1); PG8_STAGE(PG8_SA(0, 0), a2, voffA);
            PG8_BAR; PG8_WAIT_L(0); PG8_MMA(1, 0, At, B0); PG8_BAR; PG8_SCHED;
            PG8_STAGE(PG8_SB(0, 1), b2 + hstepB, voffB);
            PG8_WAIT_V(6); PG8_BAR; PG8_MMA(1, 1, At, B1); PG8_BAR;
            PG8_LDB(B0, 1, 0); PG8_SCHED; PG8_LDA(At, 1, 0); PG8_STAGE(PG8_SA(0, 1), a2 + hstepA, voffA);
            PG8_WAIT_L(8); PG8_BAR; PG8_WAIT_L(0); PG8_MMA(0, 0, At, B0); PG8_BAR; PG8_SCHED;
            PG8_LDB(B1, 1, 1); PG8_STAGE(PG8_SB(1, 0), b3, voffB);
            PG8_BAR; PG8_WAIT_L(0); PG8_MMA(0, 1, At, B1); PG8_BAR;
            PG8_LDA(At, 1, 1); PG8_STAGE(PG8_SA(1, 0), a3, voffA);
            PG8_BAR; PG8_WAIT_L(0); PG8_MMA(1, 0, At, B0); PG8_BAR; PG8_SCHED;
            PG8_STAGE(PG8_SB(1, 1), b3 + hstepB, voffB);
            PG8_WAIT_V(6); PG8_BAR; PG8_MMA(1, 1, At, B1); PG8_BAR;
            }
        }
        if constexpr (ALIGN_EPI) { if (wr == 0) PG8_BAR; }
        if constexpr (!Epi::AFTER_DRAIN) { E(acc, cur, wr, wc, fr, fq); S.done(cur); }
        if (!has_next) break;
#pragma unroll
        for (int a = 0; a < 2; ++a)
#pragma unroll
            for (int b = 0; b < 2; ++b)
#pragma unroll
                for (int m = 0; m < 4; ++m)
#pragma unroll
                    for (int n = 0; n < 2; ++n) acc[a][b][m][n] = (f32x4){0.f, 0.f, 0.f, 0.f};
        cur = nxt; cA = nA; cB = nB; ++ui;
        if constexpr (ALIGN_EPI) { if (wr == 1) PG8_BAR; }
    }
    PG8_WAIT_V(0);
    if constexpr (!ALIGN_EPI) { if (wr == 0) PG8_BAR; }
    PG8_BAR;
#undef PG8_SA
#undef PG8_SB
#undef PG8_STAGE
#undef PG8_LDA
#undef PG8_LDB
#undef PG8_MMA
#undef PG8_WAIT_V
#undef PG8_WAIT_L
#undef PG8_BAR
#undef PG8_SCHED
}
}

constexpr int NWAVES = 8;
constexpr int BATCH = 4, SEQ = 8192, D = 1024, DEPTH = 2, T = BATCH * SEQ;
constexpr int W_IN = 10768, BRW = 512;
constexpr float EPS = 1e-6f;
constexpr int GA0 = 0, GB0 = 1024, GC0 = 2560, GD0 = 5120, GG0 = 6656, NW1 = 10752;
__host__ __device__ __forceinline__ int orig_col(int j) { return j < 2560 ? j : (j < 5120 ? j + 8 : (j < 6656 ? j + 16 : j + 16)); }

constexpr size_t MiB = 1u << 20;
constexpr size_t WS_CTL = 0, CTL_ZERO_BYTES = 1 * MiB;
constexpr size_t WS_SMALL = 1 * MiB;
constexpr size_t WS_STATE = 3 * MiB;
constexpr size_t WS_W1 = 16 * MiB;
constexpr size_t WS_WB = 37 * MiB;
constexpr size_t WS_WO = 41 * MiB;
constexpr size_t WS_HN = 48 * MiB;
constexpr size_t WS_Y = 112 * MiB;
constexpr size_t WS_P = 240 * MiB;
constexpr size_t WS_END = 496 * MiB;

constexpr int LDS_BYTES = 147456;

#define LAS __attribute__((address_space(3)))
typedef unsigned short bf16;
typedef unsigned v4u __attribute__((ext_vector_type(4)));
typedef unsigned v2u __attribute__((ext_vector_type(2)));
typedef float f32x4 __attribute__((ext_vector_type(4)));
#define LDS_WAIT() asm volatile("s_waitcnt lgkmcnt(0)" ::: "memory")

__device__ __forceinline__ unsigned f2bf(float f) { unsigned u = __builtin_bit_cast(unsigned, f); return (u + 0x7fffu + ((u >> 16) & 1u)) >> 16; }
__device__ __forceinline__ unsigned pk2(float lo, float hi) { return f2bf(lo) | (f2bf(hi) << 16); }
__device__ __forceinline__ float bf2f(bf16 b) { return __uint_as_float(((unsigned)b) << 16); }
__device__ __forceinline__ float sigmoidf_(float x) { return 1.0f / (1.0f + expf(-x)); }
__device__ __forceinline__ float siluf_(float x) { return x / (1.0f + expf(-x)); }
__device__ __forceinline__ float softplusf_(float x) { return x > 0.f ? x + log1pf(expf(-x)) : log1pf(expf(x)); }
__device__ __forceinline__ float wave_sum(float v) {
#pragma unroll
    for (int o = 1; o < 64; o <<= 1) v += __shfl_xor(v, o);
    return v;
}

struct Args {
    const float* in[23]; float* out; unsigned char* ws; int ph_lo, ph_hi;
};
typedef const float* cfp_t;
typedef __attribute__((address_space(4))) const cfp_t* InTab;
struct Frame {
    LAS unsigned char* lds;
    int tid, lane, wave, G, bid;
    InTab in; float* out; unsigned char* ws;
};
enum { I_X = 0, I_NORMG, I_WIN, I_ACW, I_ACB, I_AGAW, I_AGAB, I_AGXW, I_AGXB, I_ALAM, I_BCW, I_BCB, I_BDTB, I_BALOG, I_BDSKIP, I_BNORMG, I_CIB, I_CFB, I_CNORMG, I_DNORMG, I_WBR, I_WOUT, I_FNG };

__device__ __forceinline__ void transpose_item(const float* W, int ldw, bf16* WT, int ldo, LAS float* scr, int k0, int lane) {
#pragma unroll 8
    for (int i = 0; i < 32; ++i) { const int kk = 2 * i + (lane >> 5); scr[kk * 33 + (lane & 31)] = W[(size_t)(k0 + kk) * ldw + (lane & 31)]; }
    LDS_WAIT(); asm volatile("" ::: "memory");
    const int c = lane & 7;
#pragma unroll
    for (int j = 0; j < 4; ++j) { const int n = (lane >> 3) + 8 * j; const LAS float* s = scr + (8 * c) * 33 + n;
        v4u o; o.x = pk2(s[0 * 33], s[1 * 33]); o.y = pk2(s[2 * 33], s[3 * 33]); o.z = pk2(s[4 * 33], s[5 * 33]); o.w = pk2(s[6 * 33], s[7 * 33]);
        *(v4u*)(WT + (size_t)n * ldo + k0 + 8 * c) = o; }
    LDS_WAIT(); asm volatile("" ::: "memory");
}
__device__ __forceinline__ void phase_weights(Frame& F, int layer) {
    LAS float* scr = (LAS float*)(F.lds + 65536 + F.wave * 8704);
    const int gw = F.bid * NWAVES + F.wave, NGW = F.G * NWAVES;
    const float* win = F.in[I_WIN] + (size_t)layer * D * W_IN;
    const float* wbr = F.in[I_WBR] + (size_t)layer * 4 * BRW * D;
    const float* wout = F.in[I_WOUT] + (size_t)layer * D * D;
    bf16* W1 = (bf16*)(F.ws + WS_W1); bf16* WB = (bf16*)(F.ws + WS_WB); bf16* WO = (bf16*)(F.ws + WS_WO);
    constexpr int I1 = (D / 64) * (NW1 / 32), IB = 4 * (BRW / 64) * (D / 32), IO = (D / 64) * (D / 32);
    for (int it = gw; it < I1 + IB + IO; it += NGW) {
        int r = it;
        if (r < I1) { const int nb = r % (NW1 / 32), kb = r / (NW1 / 32); const int n0 = nb * 32;
            transpose_item(win + orig_col(n0), W_IN, W1 + (size_t)n0 * D, D, scr, kb * 64, F.lane); continue; }
        r -= I1;
        if (r < IB) { const int n = r / ((BRW / 64) * (D / 32)); const int r2 = r % ((BRW / 64) * (D / 32)); const int nb = r2 % (D / 32), kb = r2 / (D / 32);
            transpose_item(wbr + (size_t)n * BRW * D + nb * 32, D, WB + (size_t)(nb * 32) * 2048 + n * BRW, 2048, scr, kb * 64, F.lane); continue; }
        r -= IB;
        { const int nb = r % (D / 32), kb = r / (D / 32);
          transpose_item(wout + nb * 32, D, WO + (size_t)(nb * 32) * D, D, scr, kb * 64, F.lane); }
    }
}
__device__ __forceinline__ void phase_prep(Frame& F, int layer, const float* xin) {
    LAS float* tab = (LAS float*)F.lds;
    const float* win = F.in[I_WIN] + (size_t)layer * D * W_IN;
    const float* ng = F.in[I_NORMG] + (size_t)layer * D;
    for (int e = F.tid; e < 16 * D; e += NWAVES * 64) { const int k = e >> 4, c = e & 15; const int col = c < 8 ? 2560 + c : 5120 + c;
        tab[c * D + k] = win[(size_t)k * W_IN + col] * ng[k]; }
    __syncthreads();
    bf16* hn = (bf16*)(F.ws + WS_HN); float* small = (float*)(F.ws + WS_SMALL);
    const int gw = F.bid * NWAVES + F.wave, NGW = F.G * NWAVES;
    f32x4 gv[4];
#pragma unroll
    for (int j = 0; j < 4; ++j) gv[j] = *((const f32x4*)ng + F.lane + 64 * j);
    for (int row = gw; row < T; row += NGW) {
        const f32x4* xr = (const f32x4*)(xin + (size_t)row * D) + F.lane;
        f32x4 v[4]; float s = 0.f;
#pragma unroll
        for (int j = 0; j < 4; ++j) { v[j] = xr[64 * j]; s += (v[j].x * v[j].x + v[j].y * v[j].y) + (v[j].z * v[j].z + v[j].w * v[j].w); }
        const float rs = 1.0f / sqrtf(wave_sum(s) * (1.f / D) + EPS);
        unsigned long long* o8 = (unsigned long long*)(hn + (size_t)row * D) + F.lane;
#pragma unroll
        for (int j = 0; j < 4; ++j) { const f32x4 h = v[j] * rs * gv[j];
            o8[64 * j] = (unsigned long long)pk2(h.x, h.y) | ((unsigned long long)pk2(h.z, h.w) << 32); }
        float myv = 0.f;
#pragma unroll 2
        for (int c = 0; c < 16; ++c) { float a = 0.f;
#pragma unroll
            for (int j = 0; j < 4; ++j) { const f32x4 w = *((const LAS f32x4*)(tab + c * D) + F.lane + 64 * j); a += (v[j].x * w.x + v[j].y * w.y) + (v[j].z * w.z + v[j].w * w.w); }
            a = wave_sum(a) * rs; if (F.lane == c) myv = a; }
        if (F.lane < 16) small[(size_t)row * 16 + F.lane] = myv;
    }
    __syncthreads();
}

__device__ __forceinline__ void phase_naive_a(Frame& F, int layer) {
    const bf16* P = (const bf16*)(F.ws + WS_P); bf16* Y = (bf16*)(F.ws + WS_Y);
    const int gw = F.bid * NWAVES + F.wave, NGW = F.G * NWAVES;
    for (int task = gw; task < BATCH * 8; task += NGW) {
        const int b = task >> 3, h = task & 7, j = F.lane, ch = h * 64 + j;
        const float* wa = F.in[I_AGAW] + ((size_t)layer * 8 + h) * 64 * 64; const float* wx = F.in[I_AGXW] + ((size_t)layer * 8 + h) * 64 * 64;
        float war[64], wxr[64];
#pragma unroll
        for (int i = 0; i < 64; ++i) { war[i] = wa[i * 64 + j]; wxr[i] = wx[i * 64 + j]; }
        const float ba = F.in[I_AGAB][layer * BRW + ch], bx = F.in[I_AGXB][layer * BRW + ch];
        const float lamsp = softplusf_(-F.in[I_ALAM][layer * BRW + ch]);
        float cw[4];
#pragma unroll
        for (int k = 0; k < 4; ++k) cw[k] = F.in[I_ACW][((size_t)layer * 4 + k) * BRW + ch];
        const float cb = F.in[I_ACB][layer * BRW + ch];
        float u1 = 0.f, u2 = 0.f, u3 = 0.f, hs = 0.f;
        for (int t = 0; t < SEQ; ++t) {
            const size_t row = (size_t)b * SEQ + t;
            const float u0 = bf2f(P[row * 1024 + ch]), z = bf2f(P[row * 1024 + 512 + ch]);
            const float xc = cb + cw[3] * u0 + cw[2] * u1 + cw[1] * u2 + cw[0] * u3;
            u3 = u2; u2 = u1; u1 = u0;
            float rp = ba, ip = bx;
#pragma unroll
            for (int i = 0; i < 64; ++i) { const float v = __uint_as_float(__builtin_amdgcn_readlane(__float_as_uint(xc), i)); rp += v * war[i]; ip += v * wxr[i]; }
            const float r = sigmoidf_(rp), ig = sigmoidf_(ip);
            const float log_a = -8.0f * r * lamsp; const float a = expf(log_a);
            const float drive = sqrtf(-expm1f(2.0f * log_a)) * (ig * xc);
            hs = a * hs + drive;
            Y[row * 2048 + ch] = (bf16)f2bf(hs * siluf_(z));
        }
    }
}
__device__ __forceinline__ void phase_naive_b(Frame& F, int layer, float* ytmp) {
    const bf16* P = (const bf16*)(F.ws + WS_P); const float* small = (const float*)(F.ws + WS_SMALL);
    const int gw = F.bid * NWAVES + F.wave, NGW = F.G * NWAVES;
    for (int task = gw; task < BATCH * 8 * 64; task += NGW) {
        const int b = task >> 9, head = (task >> 6) & 7, p = task & 63, g = head >> 2;
        int chn[5]; chn[0] = head * 64 + p; chn[1] = 512 + g * 128 + F.lane; chn[2] = chn[1] + 64; chn[3] = 768 + g * 128 + F.lane; chn[4] = chn[3] + 64;
        float cw[5][4], cb[5], w1[5], w2[5], w3[5];
#pragma unroll
        for (int c = 0; c < 5; ++c) {
#pragma unroll
            for (int k = 0; k < 4; ++k) cw[c][k] = F.in[I_BCW][((size_t)layer * 4 + k) * 1024 + chn[c]];
            cb[c] = F.in[I_BCB][layer * 1024 + chn[c]]; w1[c] = w2[c] = w3[c] = 0.f; }
        const float dtb = F.in[I_BDTB][layer * 8 + head], Aneg = -expf(F.in[I_BALOG][layer * 8 + head]), Dsk = F.in[I_BDSKIP][layer * 8 + head];
        float h0 = 0.f, h1 = 0.f;
        for (int t = 0; t < SEQ; ++t) {
            const size_t row = (size_t)b * SEQ + t;
            float val[5];
#pragma unroll
            for (int c = 0; c < 5; ++c) { const float u0 = bf2f(P[row * 1536 + chn[c]]);
                const float xc = cb[c] + cw[c][3] * u0 + cw[c][2] * w1[c] + cw[c][1] * w2[c] + cw[c][0] * w3[c];
                w3[c] = w2[c]; w2[c] = w1[c]; w1[c] = u0; val[c] = siluf_(xc); }
            const float dt = softplusf_(small[row * 16 + head] + dtb);
            const float dA = expf(Aneg * dt), xdt = val[0] * dt;
            h0 = dA * h0 + xdt * val[1]; h1 = dA * h1 + xdt * val[2];
            const float y = wave_sum(val[3] * h0 + val[4] * h1) + Dsk * val[0];
            if (F.lane == 0) ytmp[row * 512 + head * 64 + p] = y;
        }
    }
}
__device__ __forceinline__ void phase_post_b(Frame& F, int layer, const float* ytmp) {
    const bf16* P = (const bf16*)(F.ws + WS_P); bf16* Y = (bf16*)(F.ws + WS_Y);
    const int gw = F.bid * NWAVES + F.wave, NGW = F.G * NWAVES;
    const float* ng = F.in[I_BNORMG] + layer * BRW;
    for (int row = gw; row < T; row += NGW) {
        float v[8]; float s = 0.f;
#pragma unroll
        for (int e = 0; e < 8; ++e) { const int ch = F.lane * 8 + e; v[e] = ytmp[(size_t)row * 512 + ch] * siluf_(bf2f(P[(size_t)row * 1536 + 1024 + ch])); s += v[e] * v[e]; }
        const float rs = 1.0f / sqrtf(wave_sum(s) * (1.f / 512.f) + EPS);
#pragma unroll
        for (int e = 0; e < 8; ++e) { const int ch = F.lane * 8 + e; Y[(size_t)row * 2048 + 512 + ch] = (bf16)f2bf(v[e] * rs * ng[ch]); }
    }
}
__device__ __forceinline__ void phase_naive_c(Frame& F, int layer, float* htmp) {
    const bf16* P = (const bf16*)(F.ws + WS_P); const float* small = (const float*)(F.ws + WS_SMALL);
    const int gw = F.bid * NWAVES + F.wave, NGW = F.G * NWAVES;
    for (int task = gw; task < BATCH * 4 * 128; task += NGW) {
        const int b = task >> 9, head = (task >> 7) & 3, dv = task & 127;
        const float ib = F.in[I_CIB][layer * 4 + head], fb = F.in[I_CFB][layer * 4 + head];
        float C0 = 0.f, C1 = 0.f, n0 = 0.f, n1 = 0.f, m = 0.f;
        const float ksc = 0.08838834764831845f;
        for (int t = 0; t < SEQ; ++t) {
            const size_t row = (size_t)b * SEQ + t; const bf16* pr = P + row * 2560;
            const float q0 = bf2f(pr[head * 128 + F.lane]), q1 = bf2f(pr[head * 128 + 64 + F.lane]);
            const float k0 = bf2f(pr[512 + head * 128 + F.lane]) * ksc, k1 = bf2f(pr[512 + head * 128 + 64 + F.lane]) * ksc;
            const float v = bf2f(pr[1024 + head * 128 + dv]);
            const float log_i = small[row * 16 + 8 + head] + ib, log_f = -softplusf_(-(small[row * 16 + 12 + head] + fb));
            const float m_new = fmaxf(log_f + m, log_i);
            const float fs = expf(log_f + m - m_new), is = expf(log_i - m_new);
            C0 = fs * C0 + is * v * k0; C1 = fs * C1 + is * v * k1; n0 = fs * n0 + is * k0; n1 = fs * n1 + is * k1;
            const float num = wave_sum(C0 * q0 + C1 * q1), den = wave_sum(n0 * q0 + n1 * q1);
            m = m_new;
            if (F.lane == 0) htmp[row * 512 + head * 128 + dv] = num / fmaxf(fabsf(den), expf(-m_new));
        }
    }
}
__device__ __forceinline__ void phase_post_cd(Frame& F, const float* htmp, const float* ng, int pld, int ocol, int zcol, int ycol) {
    const bf16* P = (const bf16*)(F.ws + WS_P); bf16* Y = (bf16*)(F.ws + WS_Y);
    const int gw = F.bid * NWAVES + F.wave, NGW = F.G * NWAVES;
    for (int row = gw; row < T; row += NGW) {
        float v[8]; float s = 0.f;
#pragma unroll
        for (int e = 0; e < 8; ++e) { const int ch = F.lane * 8 + e; float h = htmp[(size_t)row * 512 + ch];
            if (ocol >= 0) h *= sigmoidf_(bf2f(P[(size_t)row * pld + ocol + ch]));
            v[e] = h; s += h * h; }
        s += __shfl_xor(s, 1); s += __shfl_xor(s, 2); s += __shfl_xor(s, 4); s += __shfl_xor(s, 8);
        const float rs = 1.0f / sqrtf(s * (1.f / 128.f) + EPS);
#pragma unroll
        for (int e = 0; e < 8; ++e) { const int ch = F.lane * 8 + e; Y[(size_t)row * 2048 + ycol + ch] = (bf16)f2bf(v[e] * rs * ng[ch] * siluf_(bf2f(P[(size_t)row * pld + zcol + ch]))); }
    }
}
__device__ __forceinline__ void phase_naive_d(Frame& F, float* ytmp) {
    const bf16* P = (const bf16*)(F.ws + WS_P);
    const int gw = F.bid * NWAVES + F.wave, NGW = F.G * NWAVES;
    for (int task = gw; task < BATCH * 4 * 128; task += NGW) {
        const int b = task >> 9, head = (task >> 7) & 3, dv = task & 127;
        const float gamma = 1.0f - exp2f(-5.0f - (float)head);
        const float inv = powf(10000.0f, -(float)(F.lane & 31) / 32.0f);
        float R = 0.f;
        for (int t = 0; t < SEQ; ++t) {
            const size_t row = (size_t)b * SEQ + t; const bf16* pr = P + row * 1536;
            const float qr = bf2f(pr[head * 64 + F.lane]), kr = bf2f(pr[256 + head * 64 + F.lane]);
            const float ang = (float)t * inv;
            double a = (double)ang; a -= 6.283185307179586476925286766559 * rint(a * 0.15915494309189533576888376337251);
            const float ar = (float)a; const float cs = cosf(ar), sn = sinf(ar);
            const float qp = __shfl_xor(qr, 32), kp = __shfl_xor(kr, 32);
            const float q = F.lane < 32 ? qr * cs - qp * sn : qp * sn + qr * cs;
            const float k = (F.lane < 32 ? kr * cs - kp * sn : kp * sn + kr * cs) * 0.125f;
            const float v = bf2f(pr[512 + head * 128 + dv]);
            R = gamma * R + k * v;
            const float y = wave_sum(q * R);
            if (F.lane == 0) ytmp[row * 512 + head * 128 + dv] = y;
        }
    }
}
namespace gla {
typedef short bf16x8 __attribute__((ext_vector_type(8)));
constexpr int P64 = 144;
constexpr int NCHUNK = SEQ / 64;
template <int KIND> struct GC;
template <> struct GC<0> { static constexpr int DK = 128, DV = 64,  PLD = 1536, NH = 8, NCH = 8; };
template <> struct GC<1> { static constexpr int DK = 128, DV = 128, PLD = 2560, NH = 4, NCH = 8; };
template <> struct GC<2> { static constexpr int DK = 64,  DV = 128, PLD = 1536, NH = 4, NCH = 8; };
template <int KIND> struct Lay {
    using C = GC<KIND>;
    static constexpr int PK = C::DK * 2 + 16;
    static constexpr int Q = 0, KN = Q + 64 * PK, KUT = KN + 64 * PK, VT = KUT + C::DK * P64, XT = VT + C::DV * P64,
        PM = XT + (KIND == 0 ? C::DV * P64 : 0), ST = PM + 64 * P64, SC = ST + C::DV * PK, END = SC + 8192;
    static constexpr int NTK = C::DK / 16, NTV = C::DV / 16, NKB = C::DK / 32, TKW = 2, TVW = NTK * NTV / 16, NWV = NTV / TVW;
    static constexpr int NREG = TKW * TVW * 4, NREGX = NREG + (KIND == 1 ? 1 : 0), NEL = NREGX * 512;
    static constexpr int NSC = NCHUNK / C::NCH, NITEMS = BATCH * C::NH * NSC;
    static_assert(END <= LDS_BYTES, "LDS");
};
enum { S_ROWF = 0, S_COLF = 64, S_INTER = 128, S_U = 192, S_DT = 256, S_EINV = 320, S_QN = 448, S_RED = 512, S_NVEC = 768, S_MISC = 896, S_ROWSUM = 1024   };

__device__ __forceinline__ bf16x8 ldf(LAS const unsigned char* base, int pitch, int row, int kel) { return *(LAS const bf16x8*)(base + row * pitch + kel * 2); }
__device__ __forceinline__ v4u pack8(const float (&v)[8]) { v4u o; o.x = pk2(v[0], v[1]); o.y = pk2(v[2], v[3]); o.z = pk2(v[4], v[5]); o.w = pk2(v[6], v[7]); return o; }
__device__ __forceinline__ float bfround(float f) { return __uint_as_float(f2bf(f) << 16); }

template <int KIND, int PASS>
__device__ __forceinline__ void gla_item(Frame& F, int layer, int b, int head, int j, float* stbase, float* scbase, float* ytmp) {
    using C = GC<KIND>; using LY = Lay<KIND>;
    constexpr int DK = C::DK, DV = C::DV, PK = LY::PK, PLD = C::PLD, NKB = LY::NKB, TKW = LY::TKW, TVW = LY::TVW, NWV = LY::NWV, NM = LY::NTV / 2, NREG = LY::NREG, NREGX = LY::NREGX;
    LAS unsigned char* const lds = F.lds;
    LAS float* const sc = (LAS float*)(lds + LY::SC);
    const int tid = F.tid, lane = F.lane, w = F.wave, c = lane & 15, q = lane >> 4;
    const int wk = w / NWV, wv = w % NWV;
    const bf16* P = (const bf16*)(F.ws + WS_P);
    const float* small = (const float*)(F.ws + WS_SMALL);
    const int chain = b * C::NH + head, sl = chain * LY::NSC + j;
    float* const stp = stbase + (size_t)sl * LY::NEL + tid;
    f32x4 st[TKW][TVW];
    float nreg = 0.f, mp = 0.f, asum = 0.f;
    if (PASS == 3) {
#pragma unroll
        for (int a = 0; a < TKW; ++a)
#pragma unroll
            for (int bb = 0; bb < TVW; ++bb)
#pragma unroll
                for (int r = 0; r < 4; ++r) st[a][bb][r] = stp[(size_t)((a * TVW + bb) * 4 + r) * 512];
        if (KIND == 1) { nreg = stp[(size_t)NREG * 512]; mp = scbase[sl * 4 + 2]; }
    } else {
#pragma unroll
        for (int a = 0; a < TKW; ++a)
#pragma unroll
            for (int bb = 0; bb < TVW; ++bb) st[a][bb] = (f32x4){0.f, 0.f, 0.f, 0.f};
        if (KIND == 1) mp = -1e30f;
    }
    float dtb = 0.f, Aneg = 0.f, Dsk = 0.f, ib = 0.f, fb = 0.f, logg = 0.f, inv = 0.f;
    float cw0 = 0.f, cw1 = 0.f, cw2 = 0.f, cw3 = 0.f, cbs = 0.f, w1 = 0.f, w2 = 0.f, w3 = 0.f; int scol = 0;
    if (KIND == 0) {
        dtb = F.in[I_BDTB][layer * 8 + head]; Aneg = -expf(F.in[I_BALOG][layer * 8 + head]); Dsk = F.in[I_BDSKIP][layer * 8 + head];
        if (tid < 320) { const int g = head >> 2; scol = w < 2 ? 768 + g * 128 + tid : (w < 4 ? 512 + g * 128 + (tid - 128) : head * 64 + (tid - 256));
            const float* cwp = F.in[I_BCW] + (size_t)layer * 4 * 1024 + scol;
            cw0 = cwp[0]; cw1 = cwp[1024]; cw2 = cwp[2048]; cw3 = cwp[3072]; cbs = F.in[I_BCB][layer * 1024 + scol];
            const int cg0 = j * C::NCH;
            if (cg0 > 0) { const bf16* pr = P + ((size_t)b * SEQ + (size_t)cg0 * 64) * PLD + scol; w1 = bf2f(pr[-(ptrdiff_t)PLD]); w2 = bf2f(pr[-(ptrdiff_t)2 * PLD]); w3 = bf2f(pr[-(ptrdiff_t)3 * PLD]); } }
    }
    if (KIND == 1) { ib = F.in[I_CIB][layer * 4 + head]; fb = F.in[I_CFB][layer * 4 + head]; }
    if (KIND == 2) { logg = log1pf(-exp2f(-5.0f - (float)head)); inv = powf(10000.0f, -(float)(tid & 31) / 32.0f); }

    for (int ci = 0; ci < C::NCH; ++ci) {
        const int cg = j * C::NCH + ci; const size_t row0 = (size_t)b * SEQ + (size_t)cg * 64;
        if (w == 0) {
            float a = 0.f, li = 0.f, dtv = 0.f;
            if (KIND == 0) { dtv = softplusf_(small[(row0 + lane) * 16 + head] + dtb); a = Aneg * dtv; }
            if (KIND == 1) { li = small[(row0 + lane) * 16 + 8 + head] + ib; a = -softplusf_(-(small[(row0 + lane) * 16 + 12 + head] + fb)); }
            if (KIND == 2) a = logg;
            float acs = a;
#pragma unroll
            for (int o = 1; o < 64; o <<= 1) { const float t = __shfl_up(acs, o); if (lane >= o) acs += t; }
            const float a63 = __shfl(acs, 63);
            float mrow = 0.f, mn = 0.f;
            if (KIND == 1) { float cm = li - acs;
#pragma unroll
                for (int o = 1; o < 64; o <<= 1) { const float t = __shfl_up(cm, o); if (lane >= o) cm = fmaxf(cm, t); }
                mrow = acs + fmaxf(mp, cm); mn = __shfl(mrow, 63); }
            sc[S_ROWF + lane] = acs - mrow; sc[S_COLF + lane] = li - acs;
            sc[S_INTER + lane] = expf(acs + mp - mrow);
            sc[S_U + lane] = expf(a63 - acs + li - mn);
            if (KIND == 0) sc[S_DT + lane] = dtv;
            if (KIND == 1) sc[S_EINV + lane] = expf(-mrow);
            if (lane == 0) sc[S_MISC] = expf(a63 + mp - mn);
            if (KIND == 1) mp = mn;
            asum += a63;
        }
        __syncthreads();
        const float sdec = sc[S_MISC];
        if (KIND == 1) {
            if (tid < 384 && (PASS == 3 || w >= 2)) {
                const int kind = w >> 1, ch = tid & 127; const bf16* src = P + row0 * PLD + kind * 512 + head * 128 + ch;
                float nsum = 0.f;
#pragma unroll 2
                for (int g = 0; g < 8; ++g) {
                    bf16 r[8];
#pragma unroll
                    for (int e = 0; e < 8; ++e) r[e] = src[(size_t)(8 * g + e) * PLD];
                    if (kind == 0) {
#pragma unroll
                        for (int e = 0; e < 8; ++e) *(LAS bf16*)(lds + LY::Q + (8 * g + e) * PK + ch * 2) = r[e];
                    } else if (kind == 1) {
                        const f32x4 u0 = *(const LAS f32x4*)(sc + S_U + 8 * g), u1 = *(const LAS f32x4*)(sc + S_U + 8 * g + 4);
                        float ku[8];
#pragma unroll
                        for (int e = 0; e < 8; ++e) { const float kf = bf2f(r[e]) * 0.08838834764831845f;
                            if (PASS == 3) *(LAS bf16*)(lds + LY::KN + (8 * g + e) * PK + ch * 2) = (bf16)f2bf(kf);
                            ku[e] = kf * (e < 4 ? u0[e & 3] : u1[e & 3]); nsum += ku[e]; }
                        *(LAS v4u*)(lds + LY::KUT + ch * P64 + g * 16) = pack8(ku);
                    } else {
                        v4u o; o.x = r[0] | ((unsigned)r[1] << 16); o.y = r[2] | ((unsigned)r[3] << 16); o.z = r[4] | ((unsigned)r[5] << 16); o.w = r[6] | ((unsigned)r[7] << 16);
                        *(LAS v4u*)(lds + LY::VT + ch * P64 + g * 16) = o;
                    }
                }
                if (kind == 1) { if (PASS == 3) sc[S_NVEC + ch] = nreg; nreg = sdec * nreg + nsum; }
            }
        }
        if (KIND == 2) {
            if (tid < 64) {
                const int jj = tid & 31; const bool isK = tid >= 32;
                if (PASS == 3 || isK) {
                    const bf16* src = P + row0 * PLD + (isK ? 256 : 0) + head * 64 + jj;
                    LAS unsigned char* nat = lds + (isK ? LY::KN : LY::Q);
#pragma unroll 1
                    for (int g = 0; g < 8; ++g) {
                        const f32x4 u0 = *(const LAS f32x4*)(sc + S_U + 8 * g), u1 = *(const LAS f32x4*)(sc + S_U + 8 * g + 4);
                        float k1[8], k2[8];
#pragma unroll
                        for (int e = 0; e < 8; ++e) { const int l = 8 * g + e;
                            const float x1 = bf2f(src[(size_t)l * PLD]), x2 = bf2f(src[(size_t)l * PLD + 32]);
                            const float ang = (float)(cg * 64 + l) * inv;
                            double ad = (double)ang; ad -= 6.283185307179586476925286766559 * rint(ad * 0.15915494309189533576888376337251);
                            const float ar = (float)ad; const float cs = cosf(ar), sn = sinf(ar);
                            float o1 = x1 * cs - x2 * sn, o2 = x1 * sn + x2 * cs;
                            if (isK) { o1 *= 0.125f; o2 *= 0.125f; }
                            if (PASS == 3) { *(LAS bf16*)(nat + l * PK + jj * 2) = (bf16)f2bf(o1); *(LAS bf16*)(nat + l * PK + (jj + 32) * 2) = (bf16)f2bf(o2); }
                            const float uu = e < 4 ? u0[e & 3] : u1[e & 3]; k1[e] = o1 * uu; k2[e] = o2 * uu; }
                        if (isK) { *(LAS v4u*)(lds + LY::KUT + jj * P64 + g * 16) = pack8(k1); *(LAS v4u*)(lds + LY::KUT + (jj + 32) * P64 + g * 16) = pack8(k2); }
                    }
                }
            } else if (tid < 192) {
                const int ch = tid - 64; const bf16* src = P + row0 * PLD + 512 + head * 128 + ch;
#pragma unroll 2
                for (int g = 0; g < 8; ++g) {
                    bf16 r[8];
#pragma unroll
                    for (int e = 0; e < 8; ++e) r[e] = src[(size_t)(8 * g + e) * PLD];
                    v4u o; o.x = r[0] | ((unsigned)r[1] << 16); o.y = r[2] | ((unsigned)r[3] << 16); o.z = r[4] | ((unsigned)r[5] << 16); o.w = r[6] | ((unsigned)r[7] << 16);
                    *(LAS v4u*)(lds + LY::VT + ch * P64 + g * 16) = o;
                }
            }
        }
        if (KIND == 0) {
            if (tid < 320 && (PASS == 3 || w >= 2)) {
                const int role = w < 2 ? 0 : (w < 4 ? 1 : 2), ch = role == 0 ? tid : (role == 1 ? tid - 128 : tid - 256);
                const bf16* src = P + row0 * PLD + scol;
#pragma unroll 2
                for (int g = 0; g < 8; ++g) {
                    const f32x4 u0 = *(const LAS f32x4*)(sc + (role == 2 ? S_DT : S_U) + 8 * g), u1 = *(const LAS f32x4*)(sc + (role == 2 ? S_DT : S_U) + 8 * g + 4);
                    float va[8], vb[8];
#pragma unroll
                    for (int e = 0; e < 8; ++e) { const float x0 = bf2f(src[(size_t)(8 * g + e) * PLD]);
                        const float xc = cbs + cw3 * x0 + cw2 * w1 + cw1 * w2 + cw0 * w3; w3 = w2; w2 = w1; w1 = x0;
                        const float val = siluf_(xc); va[e] = val; vb[e] = val * (e < 4 ? u0[e & 3] : u1[e & 3]);
                        if (role == 0) *(LAS bf16*)(lds + LY::Q + (8 * g + e) * PK + ch * 2) = (bf16)f2bf(val);
                        if (role == 1 && PASS == 3) *(LAS bf16*)(lds + LY::KN + (8 * g + e) * PK + ch * 2) = (bf16)f2bf(val); }
                    if (role == 1) *(LAS v4u*)(lds + LY::KUT + ch * P64 + g * 16) = pack8(vb);
                    if (role == 2) { *(LAS v4u*)(lds + LY::VT + ch * P64 + g * 16) = pack8(vb); if (PASS == 3) *(LAS v4u*)(lds + LY::XT + ch * P64 + g * 16) = pack8(va); }
                }
            }
        }
        __syncthreads();
        f32x4 aD[NM], aI[NM];
        if (PASS == 3) {
            { const int ts = w >> 1, tl0 = 2 * (w & 1);
              f32x4 sacc[2] = {(f32x4){0.f, 0.f, 0.f, 0.f}, (f32x4){0.f, 0.f, 0.f, 0.f}};
#pragma unroll
              for (int kb = 0; kb < NKB; ++kb) { const bf16x8 xf = ldf(lds + LY::KN, PK, ts * 16 + c, kb * 32 + q * 8);
#pragma unroll
                  for (int i = 0; i < 2; ++i) { const bf16x8 yf = ldf(lds + LY::Q, PK, (tl0 + i) * 16 + c, kb * 32 + q * 8); sacc[i] = __builtin_amdgcn_mfma_f32_16x16x32_bf16(xf, yf, sacc[i], 0, 0, 0); } }
              const f32x4 cf = *(const LAS f32x4*)(sc + S_COLF + ts * 16 + 4 * q);
#pragma unroll
              for (int i = 0; i < 2; ++i) { const int l = (tl0 + i) * 16 + c; const float rf = sc[S_ROWF + l];
                  float p[4];
#pragma unroll
                  for (int r = 0; r < 4; ++r) { const int s = ts * 16 + 4 * q + r; const float wgt = (s <= l) ? __expf(rf + cf[r]) : 0.f; p[r] = sacc[i][r] * wgt; }
                  v2u o; o.x = pk2(p[0], p[1]); o.y = pk2(p[2], p[3]);
                  *(LAS v2u*)(lds + LY::PM + l * P64 + (ts * 16 + 4 * q) * 2) = o;
                  if (KIND == 1) { float ps = (bfround(p[0]) + bfround(p[1])) + (bfround(p[2]) + bfround(p[3])); ps += __shfl_xor(ps, 16); ps += __shfl_xor(ps, 32);
                      if (q == 0) sc[S_ROWSUM + ts * 64 + l] = ps; } } }
#pragma unroll
            for (int a = 0; a < TKW; ++a)
#pragma unroll
                for (int bb = 0; bb < TVW; ++bb) { const int dv = (wv * TVW + bb) * 16 + c, dk0 = (wk * TKW + a) * 16 + 4 * q;
                    v2u o; o.x = pk2(st[a][bb][0], st[a][bb][1]); o.y = pk2(st[a][bb][2], st[a][bb][3]);
                    *(LAS v2u*)(lds + LY::ST + dv * PK + dk0 * 2) = o; }
            if (KIND == 1) { const int l = tid >> 3, part = tid & 7; float a = 0.f;
                const v4u qa = *(const LAS v4u*)(lds + LY::Q + l * PK + part * 32), qb = *(const LAS v4u*)(lds + LY::Q + l * PK + part * 32 + 16);
                const unsigned qw[8] = {qa.x, qa.y, qa.z, qa.w, qb.x, qb.y, qb.z, qb.w};
#pragma unroll
                for (int i = 0; i < 8; ++i) a += pg8::bf_lo(qw[i]) * sc[S_NVEC + part * 16 + 2 * i] + pg8::bf_hi(qw[i]) * sc[S_NVEC + part * 16 + 2 * i + 1];
                a += __shfl_xor(a, 1); a += __shfl_xor(a, 2); a += __shfl_xor(a, 4);
                if (part == 0) sc[S_QN + l] = a; }
            __syncthreads();
            { const int n = w & 3, mh = w >> 2;
#pragma unroll
              for (int mm = 0; mm < NM; ++mm) { aD[mm] = (f32x4){0.f, 0.f, 0.f, 0.f}; aI[mm] = (f32x4){0.f, 0.f, 0.f, 0.f}; }
#pragma unroll
              for (int kb = 0; kb < 2; ++kb) { const bf16x8 yf = ldf(lds + LY::PM, P64, n * 16 + c, kb * 32 + q * 8);
#pragma unroll
                  for (int mm = 0; mm < NM; ++mm) { const bf16x8 xf = ldf(lds + LY::VT, P64, (mh * NM + mm) * 16 + c, kb * 32 + q * 8); aD[mm] = __builtin_amdgcn_mfma_f32_16x16x32_bf16(xf, yf, aD[mm], 0, 0, 0); } }
#pragma unroll
              for (int kb = 0; kb < NKB; ++kb) { const bf16x8 yf = ldf(lds + LY::Q, PK, n * 16 + c, kb * 32 + q * 8);
#pragma unroll
                  for (int mm = 0; mm < NM; ++mm) { const bf16x8 xf = ldf(lds + LY::ST, PK, (mh * NM + mm) * 16 + c, kb * 32 + q * 8); aI[mm] = __builtin_amdgcn_mfma_f32_16x16x32_bf16(xf, yf, aI[mm], 0, 0, 0); } } }
        }
#pragma unroll
        for (int a = 0; a < TKW; ++a)
#pragma unroll
            for (int bb = 0; bb < TVW; ++bb) st[a][bb] *= sdec;
#pragma unroll
        for (int kb = 0; kb < 2; ++kb) { bf16x8 xf[TKW];
#pragma unroll
            for (int a = 0; a < TKW; ++a) xf[a] = ldf(lds + LY::KUT, P64, (wk * TKW + a) * 16 + c, kb * 32 + q * 8);
#pragma unroll
            for (int bb = 0; bb < TVW; ++bb) { const bf16x8 yf = ldf(lds + LY::VT, P64, (wv * TVW + bb) * 16 + c, kb * 32 + q * 8);
#pragma unroll
                for (int a = 0; a < TKW; ++a) st[a][bb] = __builtin_amdgcn_mfma_f32_16x16x32_bf16(xf[a], yf, st[a][bb], 0, 0, 0); } }
        if (PASS == 3) {
            const int n = w & 3, mh = w >> 2, l = n * 16 + c; const float inter = sc[S_INTER + l];
            const size_t grow = row0 + l;
            if (KIND == 0) {
#pragma unroll
                for (int mm = 0; mm < NM; ++mm) { const int dv0 = (mh * NM + mm) * 16 + 4 * q;
                    f32x4 o;
#pragma unroll
                    for (int r = 0; r < 4; ++r) { const float xv = bf2f(*(const LAS bf16*)(lds + LY::XT + (dv0 + r) * P64 + l * 2));
                        o[r] = aD[mm][r] + inter * aI[mm][r] + Dsk * xv; }
                    *(f32x4*)(ytmp + grow * 512 + head * 64 + dv0) = o; }
                __syncthreads();
            } else {
                float dinv = 1.0f;
                if (KIND == 1) { const float den = ((sc[S_ROWSUM + l] + sc[S_ROWSUM + 64 + l]) + (sc[S_ROWSUM + 128 + l] + sc[S_ROWSUM + 192 + l])) + inter * sc[S_QN + l]; dinv = 1.0f / fmaxf(fabsf(den), sc[S_EINV + l]); }
                float hv[NM][4]; float ssq = 0.f;
#pragma unroll
                for (int mm = 0; mm < NM; ++mm) { const int dv0 = (mh * NM + mm) * 16 + 4 * q;
                    float og[4] = {1.f, 1.f, 1.f, 1.f};
                    if (KIND == 1) { const v2u ow = *(const v2u*)(P + grow * PLD + 1536 + head * 128 + dv0);
                        og[0] = sigmoidf_(pg8::bf_lo(ow.x)); og[1] = sigmoidf_(pg8::bf_hi(ow.x)); og[2] = sigmoidf_(pg8::bf_lo(ow.y)); og[3] = sigmoidf_(pg8::bf_hi(ow.y)); }
#pragma unroll
                    for (int r = 0; r < 4; ++r) { hv[mm][r] = (aD[mm][r] + inter * aI[mm][r]) * dinv * og[r]; ssq += hv[mm][r] * hv[mm][r]; } }
                ssq += __shfl_xor(ssq, 16); ssq += __shfl_xor(ssq, 32);
                const int par = ci & 1;
                if (q == 0) sc[S_RED + par * 128 + mh * 64 + l] = ssq;
                __syncthreads();
                const float tot = sc[S_RED + par * 128 + l] + sc[S_RED + par * 128 + 64 + l];
                const float rs = 1.0f / sqrtf(tot * (1.f / 128.f) + EPS);
                const float* ng = F.in[KIND == 1 ? I_CNORMG : I_DNORMG] + layer * BRW + head * 128;
                const int zcol = KIND == 1 ? 2048 : 1024, ycol = KIND == 1 ? 1024 : 1536;
                bf16* Y = (bf16*)(F.ws + WS_Y);
#pragma unroll
                for (int mm = 0; mm < NM; ++mm) { const int dv0 = (mh * NM + mm) * 16 + 4 * q;
                    const v2u zw = *(const v2u*)(P + grow * PLD + zcol + head * 128 + dv0);
                    const f32x4 gv = *(const f32x4*)(ng + dv0);
                    const float o0 = hv[mm][0] * rs * gv[0] * siluf_(pg8::bf_lo(zw.x)), o1 = hv[mm][1] * rs * gv[1] * siluf_(pg8::bf_hi(zw.x));
                    const float o2 = hv[mm][2] * rs * gv[2] * siluf_(pg8::bf_lo(zw.y)), o3 = hv[mm][3] * rs * gv[3] * siluf_(pg8::bf_hi(zw.y));
                    v2u o; o.x = pk2(o0, o1); o.y = pk2(o2, o3);
                    *(v2u*)(Y + grow * 2048 + ycol + head * 128 + dv0) = o; }
            }
        } else {
            __syncthreads();
        }
    }
    if (PASS == 1) {
#pragma unroll
        for (int a = 0; a < TKW; ++a)
#pragma unroll
            for (int bb = 0; bb < TVW; ++bb)
#pragma unroll
                for (int r = 0; r < 4; ++r) stp[(size_t)((a * TVW + bb) * 4 + r) * 512] = st[a][bb][r];
        if (KIND == 1) stp[(size_t)NREG * 512] = nreg;
        if (tid == 0) { scbase[sl * 4 + 0] = asum; scbase[sl * 4 + 1] = mp; }
    }
}
template <int KIND, int PASS>
__device__ __forceinline__ void phase_gla(Frame& F, int layer, float* stbase, float* scbase, float* ytmp) {
    using C = GC<KIND>; using LY = Lay<KIND>;
    for (int it = F.bid; it < LY::NITEMS; it += F.G) {
        const int j = it % LY::NSC, head = (it / LY::NSC) % C::NH, b = it / (LY::NSC * C::NH);
        gla_item<KIND, PASS>(F, layer, b, head, j, stbase, scbase, ytmp);
    }
}
template <int KIND>
__device__ __forceinline__ void phase_scan(Frame& F, float* stbase, float* scbase) {
    using C = GC<KIND>; using LY = Lay<KIND>;
    const int total = BATCH * C::NH * LY::NEL;
    for (int idx = F.bid * (NWAVES * 64) + F.tid; idx < total; idx += F.G * NWAVES * 64) {
        const int chain = idx / LY::NEL, e = idx % LY::NEL;
        float start = 0.f, m = 0.f;
        for (int j = 0; j < LY::NSC; ++j) { const int sl = chain * LY::NSC + j; const float A = scbase[sl * 4];
            float fo, fl;
            if (KIND == 1) { const float ml = scbase[sl * 4 + 1], mnew = fmaxf(A + m, ml); fo = expf(A + m - mnew); fl = expf(ml - mnew); if (e == 0) scbase[sl * 4 + 2] = m; m = mnew; }
            else { fo = expf(A); fl = 1.f; }
            const float loc = stbase[(size_t)sl * LY::NEL + e]; stbase[(size_t)sl * LY::NEL + e] = start; start = fo * start + fl * loc; }
    }
}
}

namespace rg {
using gla::ldf; using gla::pack8; using gla::P64; using gla::bf16x8;
constexpr int NCH = 8, NSC = gla::NCHUNK / NCH, NITEMS = BATCH * 8 * NSC;
constexpr int PLD = 1024, PCOL = 0;
constexpr int L_WA = 0, L_WX = 9216, L_XB = 18432, L_XF = 27648, L_A = L_XF + 16384, L_D = L_A + 17408, L_END = L_D + 17408;
static_assert(L_END <= LDS_BYTES, "LDS");
template <int PASS>
__device__ __forceinline__ void item(Frame& F, int layer, int b, int hb, int j, float* stA) {
    LAS unsigned char* const lds = F.lds;
    const int tid = F.tid, lane = F.lane, w = F.wave, c = lane & 15, q = lane >> 4;
    const bf16* P = (const bf16*)(F.ws + WS_P); bf16* Y = (bf16*)(F.ws + WS_Y);
    float* slot = stA + (size_t)(((b * 8 + hb) * NSC + j) * 128);
    __syncthreads();
    { const float* wa = F.in[I_AGAW] + ((size_t)layer * 8 + hb) * 4096; const float* wx = F.in[I_AGXW] + ((size_t)layer * 8 + hb) * 4096;
      const int jo = tid & 63, i0 = (tid >> 6) * 8; float va[8], vx[8];
#pragma unroll
      for (int e = 0; e < 8; ++e) { va[e] = wa[(i0 + e) * 64 + jo]; vx[e] = wx[(i0 + e) * 64 + jo]; }
      *(LAS v4u*)(lds + L_WA + jo * P64 + i0 * 2) = pack8(va); *(LAS v4u*)(lds + L_WX + jo * P64 + i0 * 2) = pack8(vx); }
    float cw0 = 0.f, cw1 = 0.f, cw2 = 0.f, cw3 = 0.f, cbs = 0.f;
    if (tid < 256) { const int chg = hb * 64 + (tid & 63); const float* cwp = F.in[I_ACW] + (size_t)layer * 4 * BRW + chg;
        cw0 = cwp[0]; cw1 = cwp[BRW]; cw2 = cwp[2 * BRW]; cw3 = cwp[3 * BRW]; cbs = F.in[I_ACB][layer * BRW + chg]; }
    float ba[2], bx[2], sp[2];
#pragma unroll
    for (int i2 = 0; i2 < 2; ++i2) { const int chg = hb * 64 + (2 * (w & 1) + i2) * 16 + c;
        ba[i2] = F.in[I_AGAB][layer * BRW + chg]; bx[i2] = F.in[I_AGXB][layer * BRW + chg]; sp[i2] = softplusf_(-F.in[I_ALAM][layer * BRW + chg]); }
    float hs = 0.f, ap = 1.f;
    if (PASS == 3 && tid < 64) hs = slot[64 + tid];
    for (int ci = 0; ci < NCH; ++ci) {
        const int cg = j * NCH + ci; const size_t row0 = (size_t)b * SEQ + (size_t)cg * 64;
        if (tid < 256) {
            const int ch = tid & 63, lq = tid >> 6; const bf16* src = P + (row0 + lq * 16) * PLD + PCOL + hb * 64 + ch;
            float x1 = 0.f, x2 = 0.f, x3 = 0.f;
            if (cg * 64 + lq * 16 > 0) { x1 = bf2f(src[-(ptrdiff_t)PLD]); x2 = bf2f(src[-(ptrdiff_t)2 * PLD]); x3 = bf2f(src[-(ptrdiff_t)3 * PLD]); }
#pragma unroll
            for (int e = 0; e < 16; ++e) { const float x0 = bf2f(src[(size_t)e * PLD]);
                const float xc = cbs + cw3 * x0 + cw2 * x1 + cw1 * x2 + cw0 * x3; x3 = x2; x2 = x1; x1 = x0;
                const int l = lq * 16 + e;
                *(LAS bf16*)(lds + L_XB + l * P64 + ch * 2) = (bf16)f2bf(xc); *(LAS float*)(lds + L_XF + (l * 64 + ch) * 4) = xc; }
        }
        __syncthreads();
        { const int lt = w >> 1, jt0 = 2 * (w & 1);
          f32x4 ra[2] = {(f32x4){0.f, 0.f, 0.f, 0.f}, (f32x4){0.f, 0.f, 0.f, 0.f}}, ia[2] = {(f32x4){0.f, 0.f, 0.f, 0.f}, (f32x4){0.f, 0.f, 0.f, 0.f}};
#pragma unroll
          for (int kb = 0; kb < 2; ++kb) { const bf16x8 xf = ldf(lds + L_XB, P64, lt * 16 + c, kb * 32 + q * 8);
#pragma unroll
              for (int i2 = 0; i2 < 2; ++i2) { const bf16x8 ya = ldf(lds + L_WA, P64, (jt0 + i2) * 16 + c, kb * 32 + q * 8), yx = ldf(lds + L_WX, P64, (jt0 + i2) * 16 + c, kb * 32 + q * 8);
                  ra[i2] = __builtin_amdgcn_mfma_f32_16x16x32_bf16(xf, ya, ra[i2], 0, 0, 0); ia[i2] = __builtin_amdgcn_mfma_f32_16x16x32_bf16(xf, yx, ia[i2], 0, 0, 0); } }
#pragma unroll
          for (int i2 = 0; i2 < 2; ++i2)
#pragma unroll
              for (int r = 0; r < 4; ++r) { const int l = lt * 16 + 4 * q + r, jj = (jt0 + i2) * 16 + c;
                  const float rr = sigmoidf_(ra[i2][r] + ba[i2]), ig = sigmoidf_(ia[i2][r] + bx[i2]);
                  const float la = -8.0f * rr * sp[i2]; const float a = expf(la);
                  const float dr = sqrtf(-expm1f(2.0f * la)) * (ig * *(const LAS float*)(lds + L_XF + (l * 64 + jj) * 4));
                  *(LAS float*)(lds + L_A + (l * 68 + jj) * 4) = a; *(LAS float*)(lds + L_D + (l * 68 + jj) * 4) = dr; } }
        __syncthreads();
        if (w == 0) {
            const int ch = lane;
#pragma unroll 8
            for (int l = 0; l < 64; ++l) { const float a = *(const LAS float*)(lds + L_A + (l * 68 + ch) * 4), d = *(const LAS float*)(lds + L_D + (l * 68 + ch) * 4);
                hs = a * hs + d;
                if (PASS == 1) ap *= a;
                else { const float z = bf2f(P[(row0 + l) * PLD + PCOL + 512 + hb * 64 + ch]); Y[(row0 + l) * 2048 + hb * 64 + ch] = (bf16)f2bf(hs * siluf_(z)); } }
        }
    }
    if (PASS == 1 && tid < 64) { slot[tid] = ap; slot[64 + tid] = hs; }
}
template <int PASS>
__device__ __forceinline__ void phase(Frame& F, int layer, float* stA) {
    for (int it = F.bid; it < NITEMS; it += F.G) { const int j = it % NSC, hb = (it / NSC) & 7, b = it / (NSC * 8); item<PASS>(F, layer, b, hb, j, stA); }
}
__device__ __forceinline__ void phase_scan(Frame& F, float* stA) {
    for (int idx = F.bid * (NWAVES * 64) + F.tid; idx < BATCH * BRW; idx += F.G * NWAVES * 64) {
        const int b = idx >> 9, chx = idx & 511, hb = chx >> 6, ch = chx & 63; float start = 0.f;
        for (int j = 0; j < NSC; ++j) { float* s = stA + (size_t)(((b * 8 + hb) * NSC + j) * 128); const float ap = s[ch], hl = s[64 + ch]; s[64 + ch] = start; start = ap * start + hl; }
    }
}
}

__device__ __forceinline__ void phase_final(Frame& F) {
    const int gw = F.bid * NWAVES + F.wave, NGW = F.G * NWAVES;
    const float* ng = F.in[I_FNG];
    f32x4 gv[4];
#pragma unroll
    for (int j = 0; j < 4; ++j) gv[j] = *((const f32x4*)ng + F.lane + 64 * j);
    for (int row = gw; row < T; row += NGW) {
        f32x4* xr = (f32x4*)(F.out + (size_t)row * D) + F.lane;
        f32x4 v[4]; float s = 0.f;
#pragma unroll
        for (int j = 0; j < 4; ++j) { v[j] = xr[64 * j]; s += (v[j].x * v[j].x + v[j].y * v[j].y) + (v[j].z * v[j].z + v[j].w * v[j].w); }
        const float rs = 1.0f / sqrtf(wave_sum(s) * (1.f / D) + EPS);
#pragma unroll
        for (int j = 0; j < 4; ++j) xr[64 * j] = v[j] * rs * gv[j];
    }
}

#ifndef NAIVE_B
#define NAIVE_B 0
#endif
#ifndef NAIVE_C
#define NAIVE_C 0
#endif
#ifndef NAIVE_D
#define NAIVE_D 0
#endif
constexpr int NPL = 27;
constexpr int NPH = DEPTH * NPL + 1;

__device__ __forceinline__ void gemm_in_group(Frame& F, int col0, int ncols) {
    pg8::Gemm g{(const pg8::bf16_t*)(F.ws + WS_HN), (const pg8::bf16_t*)(F.ws + WS_W1) + (size_t)col0 * D, T, ncols, D, D, D};
    pg8::StaticOrder S; S.init(T, ncols, F.G, F.bid);
    pg8::EpiBf16S E{(pg8::bf16_t*)(F.ws + WS_P), ncols, 0};
    pg8::gemm_phase<pg8::EpiBf16S, pg8::StaticOrder, true, true>(F.lds, g, S, E, F.tid);
}

template <int KSEL> __global__ void __launch_bounds__(NWAVES * 64, 2) fwd(Args args) {
    extern __shared__ __attribute__((aligned(16))) unsigned char lds[];
    Frame F;
    F.lds = (LAS unsigned char*)lds;
    F.tid = threadIdx.x; F.lane = F.tid & 63; F.wave = __builtin_amdgcn_readfirstlane(F.tid >> 6);
    F.G = gridDim.x; F.bid = blockIdx.x;
    F.in = (InTab)__builtin_amdgcn_kernarg_segment_ptr(); F.out = args.out; F.ws = args.ws;
    float* tmp32 = (float*)(F.ws + WS_P + 160 * MiB);
    float* stbase = (float*)(F.ws + WS_P + 224 * MiB);
    float* scbase = (float*)(F.ws + WS_STATE);

    for (int ph = args.ph_lo; ph < args.ph_hi; ++ph) {
        if (KSEL < 0 && ph > args.ph_lo) cooperative_groups::this_grid().sync();
        if (KSEL == NPL || (KSEL < 0 && ph == NPH - 1)) { phase_final(F); continue; }
        int layer = ph / NPL; const int k = KSEL >= 0 ? KSEL : ph % NPL;
        if (KSEL < 0) {
            int t_ = threadIdx.x; unsigned char* w_ = args.ws; float* o_ = args.out; InTab i_ = (InTab)__builtin_amdgcn_kernarg_segment_ptr();
            asm volatile("" : "+v"(t_), "+s"(w_), "+s"(o_), "+s"(layer), "+s"(i_));
            F.in = i_; F.tid = t_; F.lane = t_ & 63; F.wave = __builtin_amdgcn_readfirstlane(t_ >> 6); F.ws = w_; F.out = o_;
            tmp32 = (float*)(F.ws + WS_P + 160 * MiB); stbase = (float*)(F.ws + WS_P + 224 * MiB); scbase = (float*)(F.ws + WS_STATE);
        }
        const float* xin = layer == 0 ? F.in[I_X] : F.out;
        switch (k) {
        case 0: phase_prep(F, layer, xin); phase_weights(F, layer); break;
        case 1: gemm_in_group(F, GA0, 1024); break;
        case 2: rg::phase<1>(F, layer, stbase); break;
        case 3: rg::phase_scan(F, stbase); break;
        case 4: rg::phase<3>(F, layer, stbase); break;
        case 5: gemm_in_group(F, GB0, 1536); break;
        case 6: if (NAIVE_B) phase_naive_b(F, layer, tmp32); else gla::phase_gla<0, 1>(F, layer, stbase, scbase, tmp32); break;
        case 7: if (!NAIVE_B) gla::phase_scan<0>(F, stbase, scbase); break;
        case 8: if (!NAIVE_B) gla::phase_gla<0, 3>(F, layer, stbase, scbase, tmp32); break;
        case 9: phase_post_b(F, layer, tmp32); break;
        case 10: gemm_in_group(F, GC0, 2560); break;
        case 11: if (NAIVE_C) phase_naive_c(F, layer, tmp32); else gla::phase_gla<1, 1>(F, layer, stbase, scbase, tmp32); break;
        case 12: if (NAIVE_C) phase_post_cd(F, tmp32, F.in[I_CNORMG] + layer * BRW, 2560, 1536, 2048, 1024); else gla::phase_scan<1>(F, stbase, scbase); break;
        case 13: if (!NAIVE_C) gla::phase_gla<1, 3>(F, layer, stbase, scbase, tmp32); break;
        case 14: gemm_in_group(F, GD0, 1536); break;
        case 15: if (NAIVE_D) phase_naive_d(F, tmp32); else gla::phase_gla<2, 1>(F, layer, stbase, scbase, tmp32); break;
        case 16: if (NAIVE_D) phase_post_cd(F, tmp32, F.in[I_DNORMG] + layer * BRW, 1536, -1, 1024, 1536); else gla::phase_scan<2>(F, stbase, scbase); break;
        case 17: if (!NAIVE_D) gla::phase_gla<2, 3>(F, layer, stbase, scbase, tmp32); break;
        case 18: case 20: case 22: case 24: {
            const int n = (k - 18) / 2;
            pg8::Gemm g{(const pg8::bf16_t*)(F.ws + WS_HN), (const pg8::bf16_t*)(F.ws + WS_W1) + (size_t)(GG0 + n * 1024) * D, T, 1024, D, D, D};
            pg8::StaticOrder S; S.init(T, 1024, F.G, F.bid);
            pg8::EpiBf16S E{(pg8::bf16_t*)(F.ws + WS_P), 1024, 1};
            pg8::gemm_phase<pg8::EpiBf16S, pg8::StaticOrder, true, true>(F.lds, g, S, E, F.tid);
        } break;
        case 19: case 21: case 23: case 25: {
            const int n = (k - 19) / 2;
            pg8::Gemm g{(const pg8::bf16_t*)(F.ws + WS_Y) + n * BRW, (const pg8::bf16_t*)(F.ws + WS_WB) + n * BRW, T, D, BRW, 2048, 2048};
            pg8::StaticOrder S; S.init(T, D, F.G, F.bid);
            pg8::EpiMergeRMW E{(const pg8::bf16_t*)(F.ws + WS_P), 1024, (float*)(F.ws + WS_P + 64 * MiB), (pg8::bf16_t*)(F.ws + WS_HN), 1024, n == 0 ? 0 : (n == 3 ? 2 : 1)};
            pg8::gemm_phase<pg8::EpiMergeRMW, pg8::StaticOrder, true, true>(F.lds, g, S, E, F.tid);
        } break;
        case 26: {
            pg8::Gemm g{(const pg8::bf16_t*)(F.ws + WS_HN), (const pg8::bf16_t*)(F.ws + WS_WO), T, D, D, D, D};
            pg8::StaticOrder S; S.init(T, D, F.G, F.bid);
            pg8::EpiResid E{xin, F.out, D};
            pg8::gemm_phase<pg8::EpiResid, pg8::StaticOrder, true, true>(F.lds, g, S, E, F.tid);
        } break;
        }
    }
}

extern "C" void kernel_launch(void* const* d_in, const int* in_sizes, int n_in, void* d_out, int out_size, void* d_ws, size_t ws_size, hipStream_t stream) {
    static int grid = 0;
    if (grid == 0) {
        if (n_in != 23 || in_sizes[0] != T * D || out_size != T * D || ws_size < WS_END) { fprintf(stderr, "kernel_launch: unexpected shapes (n_in %d, in0 %d, out %d, ws %zu)\n", n_in, n_in > 0 ? in_sizes[0] : -1, out_size, ws_size); grid = -1; return; }
        int dev = 0, cus = 0, per_cu = 0;
        if (hipGetDevice(&dev) != hipSuccess || hipDeviceGetAttribute(&cus, hipDeviceAttributeMultiprocessorCount, dev) != hipSuccess) { grid = -1; return; }
        if (hipFuncSetAttribute((const void*)fwd<-1>, hipFuncAttributeMaxDynamicSharedMemorySize, LDS_BYTES) != hipSuccess) { fprintf(stderr, "kernel_launch: hipFuncSetAttribute failed\n"); grid = -1; return; }
        if (hipOccupancyMaxActiveBlocksPerMultiprocessor(&per_cu, (const void*)fwd<-1>, NWAVES * 64, LDS_BYTES) != hipSuccess || per_cu < 1) { fprintf(stderr, "kernel_launch: occupancy query says %d blocks per CU\n", per_cu); grid = -1; return; }
        grid = cus;
    }
    if (grid < 0) return;
    Args a{};
    for (int i = 0; i < 23; ++i) a.in[i] = (const float*)d_in[i];
    a.out = (float*)d_out; a.ws = (unsigned char*)d_ws; a.ph_lo = 0; a.ph_hi = NPH;
    void* kargs[] = {&a};
    hipError_t e = hipLaunchCooperativeKernel((const void*)fwd<-1>, dim3(grid), dim3(NWAVES * 64), kargs, LDS_BYTES, stream);
    if (e != hipSuccess) fprintf(stderr, "kernel_launch: cooperative launch failed: %s (grid %d)\n", hipGetErrorString(e), grid);
}
```

```cpp
#include <hip/hip_runtime.h>
#include <hip/hip_cooperative_groups.h>
#include <cstdio>
#include <cstdint>

namespace pg8 {
#define PG8_LAS __attribute__((address_space(3)))
typedef unsigned short bf16_t;
typedef short bf16x8 __attribute__((ext_vector_type(8)));
typedef float f32x4 __attribute__((ext_vector_type(4)));
typedef unsigned u32x4 __attribute__((ext_vector_type(4)));
typedef unsigned u32x2 __attribute__((ext_vector_type(2)));
constexpr int BM = 256, BK = 64, HALF = 128, HTB = HALF * BK * 2  , STAGE_BYTES = 8 * HTB, NXCD = 8, WGM = 8;

__host__ __device__ __forceinline__ int lds_byte(int r, int c) { const int st = (r >> 4) * 2 + (c >> 5), rr = r & 15, cc = c & 31, ob = rr * 64 + cc * 2; return st * 1024 + (ob ^ (((ob >> 9) & 1) << 5)); }
__host__ __device__ __forceinline__ void stage_rc(int b, int& R, int& C) { const int st = b / 1024, sb = b % 1024, swz = sb ^ (((sb >> 9) & 1) << 5); R = (st >> 1) * 16 + swz / 64; C = (st & 1) * 32 + (swz % 64) / 2; }
__host__ __device__ __forceinline__ int perm32(int rho) { const int n = rho >> 4, i = rho & 15; return 8 * (i >> 2) + 4 * n + (i & 3); }

struct Unit { int pm, pn; };
struct Gemm { const bf16_t* A; const bf16_t* Bt; int M, N, K, lda, ldb; };

struct StaticOrder {
    int nM, nN, nwg, G, c;
    __host__ __device__ void init(int M, int N, int G_, int c_) { nM = M / BM; nN = N / BM; nwg = nM * nN; G = G_; c = c_; }
    __host__ __device__ bool next(int i, Unit& u) const {
        const long L = (long)i * G + c; if (L >= nwg) return false;
        int wgid = (int)L; { const int q = nwg / NXCD, r = nwg % NXCD, xcd = wgid % NXCD, off = wgid / NXCD; wgid = (xcd < r ? xcd * (q + 1) : r * (q + 1) + (xcd - r) * q) + off; }
        const int nig = WGM * nN, gid = wgid / nig, fm = gid * WGM, gsz = (nM - fm) < WGM ? (nM - fm) : WGM;
        u.pm = fm + ((wgid % nig) % gsz); u.pn = (wgid % nig) / gsz; return true;
    }
    __device__ __forceinline__ void a_ready(const Unit&) const {}
    __device__ __forceinline__ void done(const Unit&) const {}
};

__device__ __forceinline__ unsigned cvt_pk_bf16(float lo, float hi) { unsigned r; asm volatile("v_cvt_pk_bf16_f32 %0, %1, %2" : "=v"(r) : "v"(lo), "v"(hi)); return r; }
__device__ __forceinline__ float bf_lo(unsigned w) { return __uint_as_float(w << 16); }
__device__ __forceinline__ float bf_hi(unsigned w) { return __uint_as_float(w & 0xffff0000u); }
__device__ __forceinline__ float sigmoid_f(float x) { return 1.0f / (1.0f + __expf(-x)); }

struct EpiBf16S {
    static constexpr bool PERM = true, AFTER_DRAIN = false;
    bf16_t* O; int ldc; int sig;
    __device__ __forceinline__ void operator()(const f32x4 (&acc)[2][2][4][2], const Unit& u, int wr, int wc, int fr, int fq) const {
        const int row0 = u.pm * BM + wr * 64 + fr; const int col0 = u.pn * BM + wc * 32 + 8 * fq;
#pragma unroll
        for (int ai = 0; ai < 2; ++ai)
#pragma unroll
            for (int m = 0; m < 4; ++m) { bf16_t* rowp = O + (size_t)(row0 + ai * HALF + m * 16) * ldc + col0;
#pragma unroll
                for (int bj = 0; bj < 2; ++bj) { f32x4 v0 = acc[ai][bj][m][0], v1 = acc[ai][bj][m][1];
                    if (sig) {
#pragma unroll
                        for (int j = 0; j < 4; ++j) { v0[j] = sigmoid_f(v0[j]); v1[j] = sigmoid_f(v1[j]); } }
                    u32x4 w; w.x = cvt_pk_bf16(v0[0], v0[1]); w.y = cvt_pk_bf16(v0[2], v0[3]); w.z = cvt_pk_bf16(v1[0], v1[1]); w.w = cvt_pk_bf16(v1[2], v1[3]);
                    *(u32x4*)(rowp + bj * HALF) = w; } }
    }
};
struct EpiMergeRMW {
    static constexpr bool PERM = false, AFTER_DRAIN = false;
    const bf16_t* G; int ldg; float* M32; bf16_t* Mb; int ldc; int mode;
    __device__ __forceinline__ void operator()(const f32x4 (&acc)[2][2][4][2], const Unit& u, int wr, int wc, int fr, int fq) const {
        const int row0 = u.pm * BM + wr * 64 + fr, col0 = u.pn * BM + wc * 32 + 4 * fq;
#pragma unroll
        for (int ai = 0; ai < 2; ++ai)
#pragma unroll
            for (int m = 0; m < 4; ++m) { const size_t row = (size_t)(row0 + ai * HALF + m * 16);
#pragma unroll
                for (int bj = 0; bj < 2; ++bj)
#pragma unroll
                    for (int n = 0; n < 2; ++n) { const int c = col0 + bj * HALF + n * 16;
                        const u32x2 gw = *(const u32x2*)(G + row * ldg + c);
                        f32x4 g; g[0] = bf_lo(gw.x); g[1] = bf_hi(gw.x); g[2] = bf_lo(gw.y); g[3] = bf_hi(gw.y);
                        f32x4 v = acc[ai][bj][m][n] * g;
                        if (mode >= 1) v += *(const f32x4*)(M32 + row * ldc + c);
                        if (mode < 2) *(f32x4*)(M32 + row * ldc + c) = v;
                        else { u32x2 w; w.x = cvt_pk_bf16(v[0], v[1]); w.y = cvt_pk_bf16(v[2], v[3]); *(u32x2*)(Mb + row * ldc + c) = w; } } }
    }
};
struct EpiResid {
    static constexpr bool PERM = false, AFTER_DRAIN = false;
    const float* xin; float* out; int ldc;
    __device__ __forceinline__ void operator()(const f32x4 (&acc)[2][2][4][2], const Unit& u, int wr, int wc, int fr, int fq) const {
        const int row0 = u.pm * BM + wr * 64 + fr, col0 = u.pn * BM + wc * 32 + 4 * fq;
#pragma unroll
        for (int ai = 0; ai < 2; ++ai)
#pragma unroll
            for (int m = 0; m < 4; ++m) { const size_t off = (size_t)(row0 + ai * HALF + m * 16) * ldc + col0;
#pragma unroll
                for (int bj = 0; bj < 2; ++bj)
#pragma unroll
                    for (int n = 0; n < 2; ++n) { const f32x4 xs = *(const f32x4*)(xin + off + bj * HALF + n * 16); *(f32x4*)(out + off + bj * HALF + n * 16) = xs + acc[ai][bj][m][n]; } }
    }
};

template <class Epi, class Sched, bool ALIGN_EPI = false, bool SP2 = false>
__device__ __forceinline__ void gemm_phase(PG8_LAS unsigned char* lds, const Gemm g, const Sched& S, const Epi& E, const int tid) {
    const int wid = __builtin_amdgcn_readfirstlane(tid >> 6), lane = tid & 63, wr = wid >> 2, wc = wid & 3, fr = lane & 15, fq = lane >> 4;
    const int K = g.K, nt = K / BK;
    unsigned voffA[2], voffB[2];
#pragma unroll
    for (int i = 0; i < 2; ++i) { int R, C; stage_rc(tid * 16 + i * 8192, R, C); const int Rb = Epi::PERM ? ((R & ~31) + perm32(R & 31)) : R;
        voffA[i] = (unsigned)(R * g.lda + C) * 2u; voffB[i] = (unsigned)(Rb * g.ldb + C) * 2u; }
    const size_t kstep = (size_t)(BK * 2);
    const size_t hstepA = (size_t)HALF * g.lda * 2, hstepB = (size_t)HALF * g.ldb * 2;
    const size_t tstepA = 2 * hstepA, tstepB = 2 * hstepB;
    const unsigned ldsw = (unsigned)wid * 1024u;
    const int aoff = lds_byte(wr * 64 + fr, fq * 8), boff = lds_byte(wc * 32 + fr, fq * 8);
#define PG8_SA(b, h) (((b) * 2 + (h)) * HTB)
#define PG8_SB(b, h) ((4 + (b) * 2 + (h)) * HTB)
#define PG8_STAGE(bufoff, gbase, voff) do { _Pragma("unroll") for (int _i = 0; _i < 2; ++_i) \
        __builtin_amdgcn_global_load_lds((const unsigned*)((const char*)(gbase) + (voff)[_i]), (PG8_LAS unsigned*)(lds + (bufoff) + ldsw + _i * 8192), 16, 0, 0); } while (0)
#define PG8_LDA(dst, b, h) do { _Pragma("unroll") for (int m = 0; m < 4; ++m) _Pragma("unroll") for (int k = 0; k < 2; ++k) dst[m][k] = *(const PG8_LAS bf16x8*)(lds + PG8_SA(b, h) + aoff + m * 2048 + k * 1024); } while (0)
#define PG8_LDB(dst, b, h) do { _Pragma("unroll") for (int n = 0; n < 2; ++n) _Pragma("unroll") for (int k = 0; k < 2; ++k) dst[n][k] = *(const PG8_LAS bf16x8*)(lds + PG8_SB(b, h) + boff + n * 2048 + k * 1024); } while (0)
#define PG8_MMA(ai, bj, At, Bt) do { __builtin_amdgcn_s_setprio(1); _Pragma("unroll") for (int m = 0; m < 4; ++m) _Pragma("unroll") for (int n = 0; n < 2; ++n) _Pragma("unroll") for (int k = 0; k < 2; ++k) \
        acc[ai][bj][m][n] = __builtin_amdgcn_mfma_f32_16x16x32_bf16(Bt[n][k], At[m][k], acc[ai][bj][m][n], 0, 0, 0); __builtin_amdgcn_s_setprio(0); } while (0)
#define PG8_WAIT_V(n) asm volatile("s_waitcnt vmcnt(" #n ")" ::: "memory")
#define PG8_WAIT_L(n) asm volatile("s_waitcnt lgkmcnt(" #n ")" ::: "memory")
#define PG8_BAR __builtin_amdgcn_s_barrier()
#define PG8_SCHED __builtin_amdgcn_sched_barrier(0)
    Unit cur, nxt; int ui = 0;
    if (!S.next(0, cur)) return;
    f32x4 acc[2][2][4][2];
#pragma unroll
    for (int a = 0; a < 2; ++a)
#pragma unroll
        for (int b = 0; b < 2; ++b)
#pragma unroll
            for (int m = 0; m < 4; ++m)
#pragma unroll
                for (int n = 0; n < 2; ++n) acc[a][b][m][n] = (f32x4){0.f, 0.f, 0.f, 0.f};
    bf16x8 At[4][2], B0[2][2], B1[2][2];
    const char* cA = (const char*)g.A + (size_t)cur.pm * tstepA; const char* cB = (const char*)g.Bt + (size_t)cur.pn * tstepB;
    S.a_ready(cur);
    if constexpr (SP2) {
        PG8_STAGE(PG8_SB(0, 0), cB, voffB); PG8_STAGE(PG8_SB(0, 1), cB + hstepB, voffB); PG8_STAGE(PG8_SA(0, 0), cA, voffA); PG8_STAGE(PG8_SA(0, 1), cA + hstepA, voffA);
        if (wr == 1) PG8_BAR;
        PG8_WAIT_V(2); PG8_BAR;
        PG8_STAGE(PG8_SB(1, 0), cB + kstep, voffB); PG8_STAGE(PG8_SA(1, 0), cA + kstep, voffA); PG8_STAGE(PG8_SB(1, 1), cB + hstepB + kstep, voffB);
        PG8_WAIT_V(6); PG8_BAR;
    } else {
        PG8_STAGE(PG8_SB(0, 0), cB, voffB); PG8_STAGE(PG8_SA(0, 0), cA, voffA); PG8_STAGE(PG8_SB(0, 1), cB + hstepB, voffB); PG8_STAGE(PG8_SA(0, 1), cA + hstepA, voffA);
        if (wr == 1) PG8_BAR;
        PG8_WAIT_V(4); PG8_BAR;
        PG8_STAGE(PG8_SB(1, 0), cB + kstep, voffB); PG8_STAGE(PG8_SA(1, 0), cA + kstep, voffA); PG8_STAGE(PG8_SB(1, 1), cB + hstepB + kstep, voffB);
        PG8_WAIT_V(6); PG8_BAR;
    }
    for (;;) {
        const bool has_next = S.next(ui + 1, nxt);
        const char* nA = has_next ? (const char*)g.A + (size_t)nxt.pm * tstepA : cA; const char* nB = has_next ? (const char*)g.Bt + (size_t)nxt.pn * tstepB : cB;
        for (int t = 0; t < nt; t += 2) {
            const bool last = (t == nt - 2);
            const char* a1 = cA + (size_t)(t + 1) * kstep;
            const char* a2 = last ? nA : cA + (size_t)(t + 2) * kstep; const char* b2 = last ? nB : cB + (size_t)(t + 2) * kstep;
            const char* a3 = a2 + kstep; const char* b3 = b2 + kstep;
            if (last && has_next) S.a_ready(nxt);
            if constexpr (SP2) {
            PG8_LDB(B0, 0, 0); PG8_LDB(B1, 0, 1); PG8_SCHED; PG8_LDA(At, 0, 0); PG8_STAGE(PG8_SA(1, 1), a1 + hstepA, voffA);
            PG8_WAIT_V(8); PG8_WAIT_L(0); PG8_BAR; PG8_MMA(0, 0, At, B0); PG8_MMA(0, 1, At, B1); PG8_BAR; PG8_SCHED;
            PG8_LDA(At, 0, 1); PG8_STAGE(PG8_SB(0, 0), b2, voffB); PG8_STAGE(PG8_SB(0, 1), b2 + hstepB, voffB); PG8_STAGE(PG8_SA(0, 0), a2, voffA);
            PG8_WAIT_V(8); PG8_WAIT_L(0); PG8_BAR; PG8_MMA(1, 0, At, B0); PG8_MMA(1, 1, At, B1); PG8_BAR; PG8_SCHED;
            PG8_LDB(B0, 1, 0); PG8_LDB(B1, 1, 1); PG8_SCHED; PG8_LDA(At, 1, 0); PG8_STAGE(PG8_SA(0, 1), a2 + hstepA, voffA);
            PG8_WAIT_V(8); PG8_WAIT_L(0); PG8_BAR; PG8_MMA(0, 0, At, B0); PG8_MMA(0, 1, At, B1); PG8_BAR; PG8_SCHED;
            PG8_LDA(At, 1, 1); PG8_STAGE(PG8_SB(1, 0), b3, voffB); PG8_STAGE(PG8_SB(1, 1), b3 + hstepB, voffB); PG8_STAGE(PG8_SA(1, 0), a3, voffA);
            PG8_WAIT_V(8); PG8_WAIT_L(0); PG8_BAR; PG8_MMA(1, 0, At, B0); PG8_MMA(1, 1, At, B1); PG8_BAR; PG8_SCHED;
            } else {
            PG8_LDB(B0, 0, 0); PG8_SCHED; PG8_LDA(At, 0, 0); PG8_STAGE(PG8_SA(1, 1), a1 + hstepA, voffA);
            PG8_WAIT_L(8); PG8_BAR; PG8_WAIT_L(0); PG8_MMA(0, 0, At, B0); PG8_BAR; PG8_SCHED;
            PG8_LDB(B1, 0, 1); PG8_STAGE(PG8_SB(0, 0), b2, voffB);
            PG8_BAR; PG8_WAIT_L(0); PG8_MMA(0, 1, At, B1); PG8_BAR;
            PG8_LDA(At, 0, 1); PG8_STAGE(PG8_SA(0, 0), a2, voffA);
            PG8_BAR; PG8_WAIT_L(0); PG8_MMA(1, 0, At, B0); PG8_BAR; PG8_SCHED;
            PG8_STAGE(PG8_SB(0, 1), b2 + hstepB, voffB);
            PG8_WAIT_V(6); PG8_BAR; PG8_MMA(1, 1, At, B1); PG8_BAR;
            PG8_LDB(B0, 1, 0); PG8_SCHED; PG8_LDA(At, 1, 0); PG8_STAGE(PG8_SA(0, 1), a2 + hstepA, voffA);
            PG8_WAIT_L(8); PG8_BAR; PG8_WAIT_L(0); PG8_MMA(0, 0, At, B0); PG8_BAR; PG8_SCHED;
            PG8_LDB(B1, 1, 1); PG8_STAGE(PG8_SB(1, 0), b3, voffB);
            PG8_BAR; PG8_WAIT_L(0); PG8_MMA(0, 1, At, B1); PG8_BAR;
            PG8_LDA(At, 1, 1); PG8_STAGE(PG8_SA(1, 0), a3, voffA);
            PG8_BAR; PG8_WAIT_L(0); PG8_MMA(1, 0, At, B0); PG8_BAR; PG8_SCHED;
            PG8_STAGE(PG8_SB(1, 1), b3 + hstepB, voffB);
            PG8_WAIT_V(6); PG8_BAR; PG8_MMA(1, 1, At, B1); PG8_BAR;
            }
        }
        if constexpr (ALIGN_EPI) { if (wr == 0) PG8_BAR; }
        if constexpr (!Epi::AFTER_DRAIN) { E(acc, cur, wr, wc, fr, fq); S.done(cur); }
        if (!has_next) break;
#pragma unroll
        for (int a = 0; a < 2; ++a)
#pragma unroll
            for (int b = 0; b < 2; ++b)
#pragma unroll
                for (int m = 0; m < 4; ++m)
#pragma unroll
                    for (int n = 0; n < 2; ++n) acc[a][b][m][n] = (f32x4){0.f, 0.f, 0.f, 0.f};
        cur = nxt; cA = nA; cB = nB; ++ui;
        if constexpr (ALIGN_EPI) { if (wr == 1) PG8_BAR; }
    }
    PG8_WAIT_V(0);
    if constexpr (!ALIGN_EPI) { if (wr == 0) PG8_BAR; }
    PG8_BAR;
#undef PG8_SA
#undef PG8_SB
#undef PG8_STAGE
#undef PG8_LDA
#undef PG8_LDB
#undef PG8_MMA
#undef PG8_WAIT_V
#undef PG8_WAIT_L
#undef PG8_BAR
#undef PG8_SCHED
}
}

constexpr int NWAVES = 8;
constexpr int BATCH = 4, SEQ = 8192, D = 1024, DEPTH = 2, T = BATCH * SEQ;
constexpr int W_IN = 10768, BRW = 512;
constexpr float EPS = 1e-6f;
constexpr int GA0 = 0, GB0 = 1024, GC0 = 2560, GD0 = 5120, GG0 = 6656, NW1 = 10752;
__host__ __device__ __forceinline__ int orig_col(int j) { return j < 2560 ? j : (j < 5120 ? j + 8 : (j < 6656 ? j + 16 : j + 16)); }

constexpr size_t MiB = 1u << 20;
constexpr size_t WS_CTL = 0, CTL_ZERO_BYTES = 1 * MiB;
constexpr size_t WS_SMALL = 1 * MiB;
constexpr size_t WS_STATE = 3 * MiB;
constexpr size_t WS_W1 = 16 * MiB;
constexpr size_t WS_WB = 37 * MiB;
constexpr size_t WS_WO = 41 * MiB;
constexpr size_t WS_HN = 48 * MiB;
constexpr size_t WS_Y = 112 * MiB;
constexpr size_t WS_P = 240 * MiB;
constexpr size_t WS_END = 496 * MiB;

constexpr int LDS_BYTES = 147456;

#define LAS __attribute__((address_space(3)))
typedef unsigned short bf16;
typedef unsigned v4u __attribute__((ext_vector_type(4)));
typedef unsigned v2u __attribute__((ext_vector_type(2)));
typedef float f32x4 __attribute__((ext_vector_type(4)));
#define LDS_WAIT() asm volatile("s_waitcnt lgkmcnt(0)" ::: "memory")

__device__ __forceinline__ unsigned f2bf(float f) { unsigned u = __builtin_bit_cast(unsigned, f); return (u + 0x7fffu + ((u >> 16) & 1u)) >> 16; }
__device__ __forceinline__ unsigned pk2(float lo, float hi) { return f2bf(lo) | (f2bf(hi) << 16); }
__device__ __forceinline__ float bf2f(bf16 b) { return __uint_as_float(((unsigned)b) << 16); }
__device__ __forceinline__ float sigmoidf_(float x) { return 1.0f / (1.0f + expf(-x)); }
__device__ __forceinline__ float siluf_(float x) { return x / (1.0f + expf(-x)); }
__device__ __forceinline__ float softplusf_(float x) { return x > 0.f ? x + log1pf(expf(-x)) : log1pf(expf(x)); }
__device__ __forceinline__ float wave_sum(float v) {
#pragma unroll
    for (int o = 1; o < 64; o <<= 1) v += __shfl_xor(v, o);
    return v;
}


#define XB_TMO      128
#define XB_XCNT(j)  (256  + 64 * (j))
#define XB_XSUB(j)  (1280 + 64 * (j))
#define XB_XGEN(j)  (2304 + 64 * (j))
#define XB_TOP      3328
#define XB_TOPGEN   3392
#define XCD_BAR_WORDS 3456
#define XB_SPIN_CAP (1u << 18)
__device__ __forceinline__ unsigned xb_ld(unsigned* p)              { return __hip_atomic_load(p, __ATOMIC_RELAXED, __HIP_MEMORY_SCOPE_AGENT); }
__device__ __forceinline__ unsigned xb_add(unsigned* p, unsigned v) { return __hip_atomic_fetch_add(p, v, __ATOMIC_RELAXED, __HIP_MEMORY_SCOPE_AGENT); }
__device__ __forceinline__ unsigned xb_xcc_id() { return (unsigned)__builtin_amdgcn_s_getreg((3 << 11) | 20) & 0xFu; }
#define XB_SPIN(cond, bar) do { unsigned _sp = 0; while (cond) { __builtin_amdgcn_s_sleep(1); \
    if ((++_sp & 255u) == 0u) { if (xb_ld(&(bar)[XB_TMO])) break; if (_sp > XB_SPIN_CAP) { atomicAdd(&(bar)[XB_TMO], 1u); break; } } } } while (0)
struct XcdBarrier { unsigned* bar; unsigned x; volatile LAS unsigned* st; };
__device__ __forceinline__ XcdBarrier xcd_barrier_post(unsigned* bar, volatile LAS unsigned* st) {
    XcdBarrier b; b.bar = bar; b.x = xb_xcc_id(); b.st = st;
    if (threadIdx.x == 0) (void)xb_add(&bar[XB_XCNT(b.x)], 1u);
    return b;
}
__device__ __forceinline__ void xcd_barrier_complete(unsigned* bar, unsigned x, unsigned& nloc, unsigned& nx) {
    const unsigned G = gridDim.x * gridDim.y * gridDim.z;
    unsigned sum, cnt, mine, sp = 0u;
    for (;;) {
        sum = 0u; cnt = 0u; mine = 0u;
#pragma unroll
        for (unsigned j = 0; j < 16; ++j) { const unsigned c = xb_ld(&bar[XB_XCNT(j)]); sum += c; cnt += (c > 0u) ? 1u : 0u; mine = (j == x) ? c : mine; }
        if (sum == G) break;
        __builtin_amdgcn_s_sleep(1);
        if ((++sp & 255u) == 0u) { if (xb_ld(&bar[XB_TMO])) break; if (sp > XB_SPIN_CAP) { atomicAdd(&bar[XB_TMO], 1u); break; } }
    }
    nloc = mine > 0u ? mine : 1u; nx = cnt > 0u ? cnt : 1u;
}
__device__ __forceinline__ void xcd_barrier(const XcdBarrier& b) {
    asm volatile("s_waitcnt vmcnt(0)" ::: "memory");
    __syncthreads();
    if (threadIdx.x == 0) {
        unsigned* bar = b.bar;
        __builtin_amdgcn_s_waitcnt(0);
        unsigned nloc = b.st[0], nx = b.st[1];
        if (nloc == 0u) { xcd_barrier_complete(bar, b.x, nloc, nx); b.st[0] = nloc; b.st[1] = nx; }
        const unsigned old = xb_add(&bar[XB_XSUB(b.x)], 1u);
        const unsigned gen = old / nloc;
        if (old + 1u == (gen + 1u) * nloc) {
            __builtin_amdgcn_fence(__ATOMIC_RELEASE, "agent");
            asm volatile("s_waitcnt vmcnt(0)" ::: "memory");
            const unsigned og = xb_add(&bar[XB_TOP], 1u);
            const unsigned tg = og / nx;
            if (og + 1u == (tg + 1u) * nx) xb_add(&bar[XB_TOPGEN], 1u);
            else XB_SPIN(xb_ld(&bar[XB_TOPGEN]) == tg, bar);
            __builtin_amdgcn_fence(__ATOMIC_ACQUIRE, "agent");
            xb_add(&bar[XB_XGEN(b.x)], 1u);
            asm volatile("s_waitcnt vmcnt(0)" ::: "memory");
        } else {
            XB_SPIN(xb_ld(&bar[XB_XGEN(b.x)]) == gen, bar);
            __builtin_amdgcn_fence(__ATOMIC_ACQUIRE, "agent");
            asm volatile("s_waitcnt vmcnt(0)" ::: "memory");
        }
    }
    __syncthreads();
}

struct Args {
    const float* in[23]; float* out; unsigned char* ws; int ph_lo, ph_hi;
};
typedef const float* cfp_t;
typedef __attribute__((address_space(4))) const cfp_t* InTab;
struct Frame {
    LAS unsigned char* lds;
    int tid, lane, wave, G, bid;
    InTab in; float* out; unsigned char* ws;
};
enum { I_X = 0, I_NORMG, I_WIN, I_ACW, I_ACB, I_AGAW, I_AGAB, I_AGXW, I_AGXB, I_ALAM, I_BCW, I_BCB, I_BDTB, I_BALOG, I_BDSKIP, I_BNORMG, I_CIB, I_CFB, I_CNORMG, I_DNORMG, I_WBR, I_WOUT, I_FNG };

__device__ __forceinline__ void transpose_item(const float* W, int ldw, bf16* WT, int ldo, LAS float* scr, int k0, int lane) {
#pragma unroll 8
    for (int i = 0; i < 32; ++i) { const int kk = 2 * i + (lane >> 5); scr[kk * 33 + (lane & 31)] = W[(size_t)(k0 + kk) * ldw + (lane & 31)]; }
    LDS_WAIT(); asm volatile("" ::: "memory");
    const int c = lane & 7;
#pragma unroll
    for (int j = 0; j < 4; ++j) { const int n = (lane >> 3) + 8 * j; const LAS float* s = scr + (8 * c) * 33 + n;
        v4u o; o.x = pk2(s[0 * 33], s[1 * 33]); o.y = pk2(s[2 * 33], s[3 * 33]); o.z = pk2(s[4 * 33], s[5 * 33]); o.w = pk2(s[6 * 33], s[7 * 33]);
        *(v4u*)(WT + (size_t)n * ldo + k0 + 8 * c) = o; }
    LDS_WAIT(); asm volatile("" ::: "memory");
}
__device__ __forceinline__ void phase_weights(Frame& F, int layer) {
    LAS float* scr = (LAS float*)(F.lds + 65536 + F.wave * 8704);
    const int gw = F.bid * NWAVES + F.wave, NGW = F.G * NWAVES;
    const float* win = F.in[I_WIN] + (size_t)layer * D * W_IN;
    const float* wbr = F.in[I_WBR] + (size_t)layer * 4 * BRW * D;
    const float* wout = F.in[I_WOUT] + (size_t)layer * D * D;
    bf16* W1 = (bf16*)(F.ws + WS_W1); bf16* WB = (bf16*)(F.ws + WS_WB); bf16* WO = (bf16*)(F.ws + WS_WO);
    constexpr int I1 = (D / 64) * (NW1 / 32), IB = 4 * (BRW / 64) * (D / 32), IO = (D / 64) * (D / 32);
    for (int it = gw; it < I1 + IB + IO; it += NGW) {
        int r = it;
        if (r < I1) { const int nb = r % (NW1 / 32), kb = r / (NW1 / 32); const int n0 = nb * 32;
            transpose_item(win + orig_col(n0), W_IN, W1 + (size_t)n0 * D, D, scr, kb * 64, F.lane); continue; }
        r -= I1;
        if (r < IB) { const int n = r / ((BRW / 64) * (D / 32)); const int r2 = r % ((BRW / 64) * (D / 32)); const int nb = r2 % (D / 32), kb = r2 / (D / 32);
            transpose_item(wbr + (size_t)n * BRW * D + nb * 32, D, WB + (size_t)(nb * 32) * 2048 + n * BRW, 2048, scr, kb * 64, F.lane); continue; }
        r -= IB;
        { const int nb = r % (D / 32), kb = r / (D / 32);
          transpose_item(wout + nb * 32, D, WO + (size_t)(nb * 32) * D, D, scr, kb * 64, F.lane); }
    }
}
__device__ __forceinline__ void phase_prep(Frame& F, int layer, const float* xin) {
    LAS float* tab = (LAS float*)F.lds;
    const float* win = F.in[I_WIN] + (size_t)layer * D * W_IN;
    const float* ng = F.in[I_NORMG] + (size_t)layer * D;
    for (int e = F.tid; e < 16 * D; e += NWAVES * 64) { const int k = e >> 4, c = e & 15; const int col = c < 8 ? 2560 + c : 5120 + c;
        tab[c * D + k] = win[(size_t)k * W_IN + col] * ng[k]; }
    __syncthreads();
    bf16* hn = (bf16*)(F.ws + WS_HN); float* small = (float*)(F.ws + WS_SMALL);
    const int gw = F.bid * NWAVES + F.wave, NGW = F.G * NWAVES;
    f32x4 gv[4];
#pragma unroll
    for (int j = 0; j < 4; ++j) gv[j] = *((const f32x4*)ng + F.lane + 64 * j);
    for (int row = gw; row < T; row += NGW) {
        const f32x4* xr = (const f32x4*)(xin + (size_t)row * D) + F.lane;
        f32x4 v[4]; float s = 0.f;
#pragma unroll
        for (int j = 0; j < 4; ++j) { v[j] = xr[64 * j]; s += (v[j].x * v[j].x + v[j].y * v[j].y) + (v[j].z * v[j].z + v[j].w * v[j].w); }
        const float rs = 1.0f / sqrtf(wave_sum(s) * (1.f / D) + EPS);
        unsigned long long* o8 = (unsigned long long*)(hn + (size_t)row * D) + F.lane;
#pragma unroll
        for (int j = 0; j < 4; ++j) { const f32x4 h = v[j] * rs * gv[j];
            o8[64 * j] = (unsigned long long)pk2(h.x, h.y) | ((unsigned long long)pk2(h.z, h.w) << 32); }
        float myv = 0.f;
#pragma unroll 2
        for (int c = 0; c < 16; ++c) { float a = 0.f;
#pragma unroll
            for (int j = 0; j < 4; ++j) { const f32x4 w = *((const LAS f32x4*)(tab + c * D) + F.lane + 64 * j); a += (v[j].x * w.x + v[j].y * w.y) + (v[j].z * w.z + v[j].w * w.w); }
            a = wave_sum(a) * rs; if (F.lane == c) myv = a; }
        if (F.lane < 16) small[(size_t)row * 16 + F.lane] = myv;
    }
    __syncthreads();
}

__device__ __forceinline__ void phase_naive_a(Frame& F, int layer) {
    const bf16* P = (const bf16*)(F.ws + WS_P); bf16* Y = (bf16*)(F.ws + WS_Y);
    const int gw = F.bid * NWAVES + F.wave, NGW = F.G * NWAVES;
    for (int task = gw; task < BATCH * 8; task += NGW) {
        const int b = task >> 3, h = task & 7, j = F.lane, ch = h * 64 + j;
        const float* wa = F.in[I_AGAW] + ((size_t)layer * 8 + h) * 64 * 64; const float* wx = F.in[I_AGXW] + ((size_t)layer * 8 + h) * 64 * 64;
        float war[64], wxr[64];
#pragma unroll
        for (int i = 0; i < 64; ++i) { war[i] = wa[i * 64 + j]; wxr[i] = wx[i * 64 + j]; }
        const float ba = F.in[I_AGAB][layer * BRW + ch], bx = F.in[I_AGXB][layer * BRW + ch];
        const float lamsp = softplusf_(-F.in[I_ALAM][layer * BRW + ch]);
        float cw[4];
#pragma unroll
        for (int k = 0; k < 4; ++k) cw[k] = F.in[I_ACW][((size_t)layer * 4 + k) * BRW + ch];
        const float cb = F.in[I_ACB][layer * BRW + ch];
        float u1 = 0.f, u2 = 0.f, u3 = 0.f, hs = 0.f;
        for (int t = 0; t < SEQ; ++t) {
            const size_t row = (size_t)b * SEQ + t;
            const float u0 = bf2f(P[row * 1024 + ch]), z = bf2f(P[row * 1024 + 512 + ch]);
            const float xc = cb + cw[3] * u0 + cw[2] * u1 + cw[1] * u2 + cw[0] * u3;
            u3 = u2; u2 = u1; u1 = u0;
            float rp = ba, ip = bx;
#pragma unroll
            for (int i = 0; i < 64; ++i) { const float v = __uint_as_float(__builtin_amdgcn_readlane(__float_as_uint(xc), i)); rp += v * war[i]; ip += v * wxr[i]; }
            const float r = sigmoidf_(rp), ig = sigmoidf_(ip);
            const float log_a = -8.0f * r * lamsp; const float a = expf(log_a);
            const float drive = sqrtf(-expm1f(2.0f * log_a)) * (ig * xc);
            hs = a * hs + drive;
            Y[row * 2048 + ch] = (bf16)f2bf(hs * siluf_(z));
        }
    }
}
__device__ __forceinline__ void phase_naive_b(Frame& F, int layer, float* ytmp) {
    const bf16* P = (const bf16*)(F.ws + WS_P); const float* small = (const float*)(F.ws + WS_SMALL);
    const int gw = F.bid * NWAVES + F.wave, NGW = F.G * NWAVES;
    for (int task = gw; task < BATCH * 8 * 64; task += NGW) {
        const int b = task >> 9, head = (task >> 6) & 7, p = task & 63, g = head >> 2;
        int chn[5]; chn[0] = head * 64 + p; chn[1] = 512 + g * 128 + F.lane; chn[2] = chn[1] + 64; chn[3] = 768 + g * 128 + F.lane; chn[4] = chn[3] + 64;
        float cw[5][4], cb[5], w1[5], w2[5], w3[5];
#pragma unroll
        for (int c = 0; c < 5; ++c) {
#pragma unroll
            for (int k = 0; k < 4; ++k) cw[c][k] = F.in[I_BCW][((size_t)layer * 4 + k) * 1024 + chn[c]];
            cb[c] = F.in[I_BCB][layer * 1024 + chn[c]]; w1[c] = w2[c] = w3[c] = 0.f; }
        const float dtb = F.in[I_BDTB][layer * 8 + head], Aneg = -expf(F.in[I_BALOG][layer * 8 + head]), Dsk = F.in[I_BDSKIP][layer * 8 + head];
        float h0 = 0.f, h1 = 0.f;
        for (int t = 0; t < SEQ; ++t) {
            const size_t row = (size_t)b * SEQ + t;
            float val[5];
#pragma unroll
            for (int c = 0; c < 5; ++c) { const float u0 = bf2f(P[row * 1536 + chn[c]]);
                const float xc = cb[c] + cw[c][3] * u0 + cw[c][2] * w1[c] + cw[c][1] * w2[c] + cw[c][0] * w3[c];
                w3[c] = w2[c]; w2[c] = w1[c]; w1[c] = u0; val[c] = siluf_(xc); }
            const float dt = softplusf_(small[row * 16 + head] + dtb);
            const float dA = expf(Aneg * dt), xdt = val[0] * dt;
            h0 = dA * h0 + xdt * val[1]; h1 = dA * h1 + xdt * val[2];
            const float y = wave_sum(val[3] * h0 + val[4] * h1) + Dsk * val[0];
            if (F.lane == 0) ytmp[row * 512 + head * 64 + p] = y;
        }
    }
}
__device__ __forceinline__ void phase_post_b(Frame& F, int layer, const float* ytmp) {
    const bf16* P = (const bf16*)(F.ws + WS_P); bf16* Y = (bf16*)(F.ws + WS_Y);
    const int gw = F.bid * NWAVES + F.wave, NGW = F.G * NWAVES;
    const float* ng = F.in[I_BNORMG] + layer * BRW;
    for (int row = gw; row < T; row += NGW) {
        float v[8]; float s = 0.f;
#pragma unroll
        for (int e = 0; e < 8; ++e) { const int ch = F.lane * 8 + e; v[e] = ytmp[(size_t)row * 512 + ch] * siluf_(bf2f(P[(size_t)row * 1536 + 1024 + ch])); s += v[e] * v[e]; }
        const float rs = 1.0f / sqrtf(wave_sum(s) * (1.f / 512.f) + EPS);
#pragma unroll
        for (int e = 0; e < 8; ++e) { const int ch = F.lane * 8 + e; Y[(size_t)row * 2048 + 512 + ch] = (bf16)f2bf(v[e] * rs * ng[ch]); }
    }
}
__device__ __forceinline__ void phase_naive_c(Frame& F, int layer, float* htmp) {
    const bf16* P = (const bf16*)(F.ws + WS_P); const float* small = (const float*)(F.ws + WS_SMALL);
    const int gw = F.bid * NWAVES + F.wave, NGW = F.G * NWAVES;
    for (int task = gw; task < BATCH * 4 * 128; task += NGW) {
        const int b = task >> 9, head = (task >> 7) & 3, dv = task & 127;
        const float ib = F.in[I_CIB][layer * 4 + head], fb = F.in[I_CFB][layer * 4 + head];
        float C0 = 0.f, C1 = 0.f, n0 = 0.f, n1 = 0.f, m = 0.f;
        const float ksc = 0.08838834764831845f;
        for (int t = 0; t < SEQ; ++t) {
            const size_t row = (size_t)b * SEQ + t; const bf16* pr = P + row * 2560;
            const float q0 = bf2f(pr[head * 128 + F.lane]), q1 = bf2f(pr[head * 128 + 64 + F.lane]);
            const float k0 = bf2f(pr[512 + head * 128 + F.lane]) * ksc, k1 = bf2f(pr[512 + head * 128 + 64 + F.lane]) * ksc;
            const float v = bf2f(pr[1024 + head * 128 + dv]);
            const float log_i = small[row * 16 + 8 + head] + ib, log_f = -softplusf_(-(small[row * 16 + 12 + head] + fb));
            const float m_new = fmaxf(log_f + m, log_i);
            const float fs = expf(log_f + m - m_new), is = expf(log_i - m_new);
            C0 = fs * C0 + is * v * k0; C1 = fs * C1 + is * v * k1; n0 = fs * n0 + is * k0; n1 = fs * n1 + is * k1;
            const float num = wave_sum(C0 * q0 + C1 * q1), den = wave_sum(n0 * q0 + n1 * q1);
            m = m_new;
            if (F.lane == 0) htmp[row * 512 + head * 128 + dv] = num / fmaxf(fabsf(den), expf(-m_new));
        }
    }
}
__device__ __forceinline__ void phase_post_cd(Frame& F, const float* htmp, const float* ng, int pld, int ocol, int zcol, int ycol) {
    const bf16* P = (const bf16*)(F.ws + WS_P); bf16* Y = (bf16*)(F.ws + WS_Y);
    const int gw = F.bid * NWAVES + F.wave, NGW = F.G * NWAVES;
    for (int row = gw; row < T; row += NGW) {
        float v[8]; float s = 0.f;
#pragma unroll
        for (int e = 0; e < 8; ++e) { const int ch = F.lane * 8 + e; float h = htmp[(size_t)row * 512 + ch];
            if (ocol >= 0) h *= sigmoidf_(bf2f(P[(size_t)row * pld + ocol + ch]));
            v[e] = h; s += h * h; }
        s += __shfl_xor(s, 1); s += __shfl_xor(s, 2); s += __shfl_xor(s, 4); s += __shfl_xor(s, 8);
        const float rs = 1.0f / sqrtf(s * (1.f / 128.f) + EPS);
#pragma unroll
        for (int e = 0; e < 8; ++e) { const int ch = F.lane * 8 + e; Y[(size_t)row * 2048 + ycol + ch] = (bf16)f2bf(v[e] * rs * ng[ch] * siluf_(bf2f(P[(size_t)row * pld + zcol + ch]))); }
    }
}
__device__ __forceinline__ void phase_naive_d(Frame& F, float* ytmp) {
    const bf16* P = (const bf16*)(F.ws + WS_P);
    const int gw = F.bid * NWAVES + F.wave, NGW = F.G * NWAVES;
    for (int task = gw; task < BATCH * 4 * 128; task += NGW) {
        const int b = task >> 9, head = (task >> 7) & 3, dv = task & 127;
        const float gamma = 1.0f - exp2f(-5.0f - (float)head);
        const float inv = powf(10000.0f, -(float)(F.lane & 31) / 32.0f);
        float R = 0.f;
        for (int t = 0; t < SEQ; ++t) {
            const size_t row = (size_t)b * SEQ + t; const bf16* pr = P + row * 1536;
            const float qr = bf2f(pr[head * 64 + F.lane]), kr = bf2f(pr[256 + head * 64 + F.lane]);
            const float ang = (float)t * inv;
            double a = (double)ang; a -= 6.283185307179586476925286766559 * rint(a * 0.15915494309189533576888376337251);
            const float ar = (float)a; const float cs = cosf(ar), sn = sinf(ar);
            const float qp = __shfl_xor(qr, 32), kp = __shfl_xor(kr, 32);
            const float q = F.lane < 32 ? qr * cs - qp * sn : qp * sn + qr * cs;
            const float k = (F.lane < 32 ? kr * cs - kp * sn : kp * sn + kr * cs) * 0.125f;
            const float v = bf2f(pr[512 + head * 128 + dv]);
            R = gamma * R + k * v;
            const float y = wave_sum(q * R);
            if (F.lane == 0) ytmp[row * 512 + head * 128 + dv] = y;
        }
    }
}
namespace gla {
typedef short bf16x8 __attribute__((ext_vector_type(8)));
constexpr int P64 = 144;
constexpr int NCHUNK = SEQ / 64;
template <int KIND> struct GC;
template <> struct GC<0> { static constexpr int DK = 128, DV = 64,  PLD = 1536, NH = 8, NCH = 8; };
template <> struct GC<1> { static constexpr int DK = 128, DV = 128, PLD = 2560, NH = 4, NCH = 8; };
template <> struct GC<2> { static constexpr int DK = 64,  DV = 128, PLD = 1536, NH = 4, NCH = 8; };
template <int KIND> struct Lay {
    using C = GC<KIND>;
    static constexpr int PK = C::DK * 2 + 16;
    static constexpr int Q = 0, KN = Q + 64 * PK, KUT = KN + 64 * PK, VT = KUT + C::DK * P64, XT = VT + C::DV * P64,
        PM = XT + (KIND == 0 ? C::DV * P64 : 0), ST = PM + 64 * P64, SC = ST + C::DV * PK, END = SC + 8192;
    static constexpr int NTK = C::DK / 16, NTV = C::DV / 16, NKB = C::DK / 32, TKW = 2, TVW = NTK * NTV / 16, NWV = NTV / TVW;
    static constexpr int NREG = TKW * TVW * 4, NREGX = NREG + (KIND == 1 ? 1 : 0), NEL = NREGX * 512;
    static constexpr int NSC = NCHUNK / C::NCH, NITEMS = BATCH * C::NH * NSC;
    static_assert(END <= LDS_BYTES, "LDS");
};
enum { S_ROWF = 0, S_COLF = 64, S_INTER = 128, S_U = 192, S_DT = 256, S_EINV = 320, S_QN = 448, S_RED = 512, S_NVEC = 768, S_MISC = 896, S_ROWSUM = 1024   };

__device__ __forceinline__ bf16x8 ldf(LAS const unsigned char* base, int pitch, int row, int kel) { return *(LAS const bf16x8*)(base + row * pitch + kel * 2); }
__device__ __forceinline__ v4u pack8(const float (&v)[8]) { v4u o; o.x = pk2(v[0], v[1]); o.y = pk2(v[2], v[3]); o.z = pk2(v[4], v[5]); o.w = pk2(v[6], v[7]); return o; }
__device__ __forceinline__ float bfround(float f) { return __uint_as_float(f2bf(f) << 16); }

template <int KIND, int PASS>
__device__ __forceinline__ void gla_item(Frame& F, int layer, int b, int head, int j, float* stbase, float* scbase, float* ytmp) {
    using C = GC<KIND>; using LY = Lay<KIND>;
    constexpr int DK = C::DK, DV = C::DV, PK = LY::PK, PLD = C::PLD, NKB = LY::NKB, TKW = LY::TKW, TVW = LY::TVW, NWV = LY::NWV, NM = LY::NTV / 2, NREG = LY::NREG, NREGX = LY::NREGX;
    LAS unsigned char* const lds = F.lds;
    LAS float* const sc = (LAS float*)(lds + LY::SC);
    const int tid = F.tid, lane = F.lane, w = F.wave, c = lane & 15, q = lane >> 4;
    const int wk = w / NWV, wv = w % NWV;
    const bf16* P = (const bf16*)(F.ws + WS_P);
    const float* small = (const float*)(F.ws + WS_SMALL);
    const int chain = b * C::NH + head, sl = chain * LY::NSC + j;
    float* const stp = stbase + (size_t)sl * LY::NEL + tid;
    f32x4 st[TKW][TVW];
    float nreg = 0.f, mp = 0.f, asum = 0.f;
    if (PASS == 3) {
#pragma unroll
        for (int a = 0; a < TKW; ++a)
#pragma unroll
            for (int bb = 0; bb < TVW; ++bb)
#pragma unroll
                for (int r = 0; r < 4; ++r) st[a][bb][r] = stp[(size_t)((a * TVW + bb) * 4 + r) * 512];
        if (KIND == 1) { nreg = stp[(size_t)NREG * 512]; mp = scbase[sl * 4 + 2]; }
    } else {
#pragma unroll
        for (int a = 0; a < TKW; ++a)
#pragma unroll
            for (int bb = 0; bb < TVW; ++bb) st[a][bb] = (f32x4){0.f, 0.f, 0.f, 0.f};
        if (KIND == 1) mp = -1e30f;
    }
    float dtb = 0.f, Aneg = 0.f, Dsk = 0.f, ib = 0.f, fb = 0.f, logg = 0.f, inv = 0.f;
    float cw0 = 0.f, cw1 = 0.f, cw2 = 0.f, cw3 = 0.f, cbs = 0.f, w1 = 0.f, w2 = 0.f, w3 = 0.f; int scol = 0;
    if (KIND == 0) {
        dtb = F.in[I_BDTB][layer * 8 + head]; Aneg = -expf(F.in[I_BALOG][layer * 8 + head]); Dsk = F.in[I_BDSKIP][layer * 8 + head];
        if (tid < 320) { const int g = head >> 2; scol = w < 2 ? 768 + g * 128 + tid : (w < 4 ? 512 + g * 128 + (tid - 128) : head * 64 + (tid - 256));
            const float* cwp = F.in[I_BCW] + (size_t)layer * 4 * 1024 + scol;
            cw0 = cwp[0]; cw1 = cwp[1024]; cw2 = cwp[2048]; cw3 = cwp[3072]; cbs = F.in[I_BCB][layer * 1024 + scol];
            const int cg0 = j * C::NCH;
            if (cg0 > 0) { const bf16* pr = P + ((size_t)b * SEQ + (size_t)cg0 * 64) * PLD + scol; w1 = bf2f(pr[-(ptrdiff_t)PLD]); w2 = bf2f(pr[-(ptrdiff_t)2 * PLD]); w3 = bf2f(pr[-(ptrdiff_t)3 * PLD]); } }
    }
    if (KIND == 1) { ib = F.in[I_CIB][layer * 4 + head]; fb = F.in[I_CFB][layer * 4 + head]; }
    if (KIND == 2) { logg = log1pf(-exp2f(-5.0f - (float)head)); inv = powf(10000.0f, -(float)(tid & 31) / 32.0f); }

    for (int ci = 0; ci < C::NCH; ++ci) {
        const int cg = j * C::NCH + ci; const size_t row0 = (size_t)b * SEQ + (size_t)cg * 64;
        if (w == 0) {
            float a = 0.f, li = 0.f, dtv = 0.f;
            if (KIND == 0) { dtv = softplusf_(small[(row0 + lane) * 16 + head] + dtb); a = Aneg * dtv; }
            if (KIND == 1) { li = small[(row0 + lane) * 16 + 8 + head] + ib; a = -softplusf_(-(small[(row0 + lane) * 16 + 12 + head] + fb)); }
            if (KIND == 2) a = logg;
            float acs = a;
#pragma unroll
            for (int o = 1; o < 64; o <<= 1) { const float t = __shfl_up(acs, o); if (lane >= o) acs += t; }
            const float a63 = __shfl(acs, 63);
            float mrow = 0.f, mn = 0.f;
            if (KIND == 1) { float cm = li - acs;
#pragma unroll
                for (int o = 1; o < 64; o <<= 1) { const float t = __shfl_up(cm, o); if (lane >= o) cm = fmaxf(cm, t); }
                mrow = acs + fmaxf(mp, cm); mn = __shfl(mrow, 63); }
            sc[S_ROWF + lane] = acs - mrow; sc[S_COLF + lane] = li - acs;
            sc[S_INTER + lane] = expf(acs + mp - mrow);
            sc[S_U + lane] = expf(a63 - acs + li - mn);
            if (KIND == 0) sc[S_DT + lane] = dtv;
            if (KIND == 1) sc[S_EINV + lane] = expf(-mrow);
            if (lane == 0) sc[S_MISC] = expf(a63 + mp - mn);
            if (KIND == 1) mp = mn;
            asum += a63;
        }
        __syncthreads();
        const float sdec = sc[S_MISC];
        if (KIND == 1) {
            if (tid < 384 && (PASS == 3 || w >= 2)) {
                const int kind = w >> 1, ch = tid & 127; const bf16* src = P + row0 * PLD + kind * 512 + head * 128 + ch;
                float nsum = 0.f;
#pragma unroll 2
                for (int g = 0; g < 8; ++g) {
                    bf16 r[8];
#pragma unroll
                    for (int e = 0; e < 8; ++e) r[e] = src[(size_t)(8 * g + e) * PLD];
                    if (kind == 0) {
#pragma unroll
                        for (int e = 0; e < 8; ++e) *(LAS bf16*)(lds + LY::Q + (8 * g + e) * PK + ch * 2) = r[e];
                    } else if (kind == 1) {
                        const f32x4 u0 = *(const LAS f32x4*)(sc + S_U + 8 * g), u1 = *(const LAS f32x4*)(sc + S_U + 8 * g + 4);
                        float ku[8];
#pragma unroll
                        for (int e = 0; e < 8; ++e) { const float kf = bf2f(r[e]) * 0.08838834764831845f;
                            if (PASS == 3) *(LAS bf16*)(lds + LY::KN + (8 * g + e) * PK + ch * 2) = (bf16)f2bf(kf);
                            ku[e] = kf * (e < 4 ? u0[e & 3] : u1[e & 3]); nsum += ku[e]; }
                        *(LAS v4u*)(lds + LY::KUT + ch * P64 + g * 16) = pack8(ku);
                    } else {
                        v4u o; o.x = r[0] | ((unsigned)r[1] << 16); o.y = r[2] | ((unsigned)r[3] << 16); o.z = r[4] | ((unsigned)r[5] << 16); o.w = r[6] | ((unsigned)r[7] << 16);
                        *(LAS v4u*)(lds + LY::VT + ch * P64 + g * 16) = o;
                    }
                }
                if (kind == 1) { if (PASS == 3) sc[S_NVEC + ch] = nreg; nreg = sdec * nreg + nsum; }
            }
        }
        if (KIND == 2) {
            if (tid < 64) {
                const int jj = tid & 31; const bool isK = tid >= 32;
                if (PASS == 3 || isK) {
                    const bf16* src = P + row0 * PLD + (isK ? 256 : 0) + head * 64 + jj;
                    LAS unsigned char* nat = lds + (isK ? LY::KN : LY::Q);
#pragma unroll 1
                    for (int g = 0; g < 8; ++g) {
                        const f32x4 u0 = *(const LAS f32x4*)(sc + S_U + 8 * g), u1 = *(const LAS f32x4*)(sc + S_U + 8 * g + 4);
                        float k1[8], k2[8];
#pragma unroll
                        for (int e = 0; e < 8; ++e) { const int l = 8 * g + e;
                            const float x1 = bf2f(src[(size_t)l * PLD]), x2 = bf2f(src[(size_t)l * PLD + 32]);
                            const float ang = (float)(cg * 64 + l) * inv;
                            double ad = (double)ang; ad -= 6.283185307179586476925286766559 * rint(ad * 0.15915494309189533576888376337251);
                            const float ar = (float)ad; const float cs = cosf(ar), sn = sinf(ar);
                            float o1 = x1 * cs - x2 * sn, o2 = x1 * sn + x2 * cs;
                            if (isK) { o1 *= 0.125f; o2 *= 0.125f; }
                            if (PASS == 3) { *(LAS bf16*)(nat + l * PK + jj * 2) = (bf16)f2bf(o1); *(LAS bf16*)(nat + l * PK + (jj + 32) * 2) = (bf16)f2bf(o2); }
                            const float uu = e < 4 ? u0[e & 3] : u1[e & 3]; k1[e] = o1 * uu; k2[e] = o2 * uu; }
                        if (isK) { *(LAS v4u*)(lds + LY::KUT + jj * P64 + g * 16) = pack8(k1); *(LAS v4u*)(lds + LY::KUT + (jj + 32) * P64 + g * 16) = pack8(k2); }
                    }
                }
            } else if (tid < 192) {
                const int ch = tid - 64; const bf16* src = P + row0 * PLD + 512 + head * 128 + ch;
#pragma unroll 2
                for (int g = 0; g < 8; ++g) {
                    bf16 r[8];
#pragma unroll
                    for (int e = 0; e < 8; ++e) r[e] = src[(size_t)(8 * g + e) * PLD];
                    v4u o; o.x = r[0] | ((unsigned)r[1] << 16); o.y = r[2] | ((unsigned)r[3] << 16); o.z = r[4] | ((unsigned)r[5] << 16); o.w = r[6] | ((unsigned)r[7] << 16);
                    *(LAS v4u*)(lds + LY::VT + ch * P64 + g * 16) = o;
                }
            }
        }
        if (KIND == 0) {
            if (tid < 320 && (PASS == 3 || w >= 2)) {
                const int role = w < 2 ? 0 : (w < 4 ? 1 : 2), ch = role == 0 ? tid : (role == 1 ? tid - 128 : tid - 256);
                const bf16* src = P + row0 * PLD + scol;
#pragma unroll 2
                for (int g = 0; g < 8; ++g) {
                    const f32x4 u0 = *(const LAS f32x4*)(sc + (role == 2 ? S_DT : S_U) + 8 * g), u1 = *(const LAS f32x4*)(sc + (role == 2 ? S_DT : S_U) + 8 * g + 4);
                    float va[8], vb[8];
#pragma unroll
                    for (int e = 0; e < 8; ++e) { const float x0 = bf2f(src[(size_t)(8 * g + e) * PLD]);
                        const float xc = cbs + cw3 * x0 + cw2 * w1 + cw1 * w2 + cw0 * w3; w3 = w2; w2 = w1; w1 = x0;
                        const float val = siluf_(xc); va[e] = val; vb[e] = val * (e < 4 ? u0[e & 3] : u1[e & 3]);
                        if (role == 0) *(LAS bf16*)(lds + LY::Q + (8 * g + e) * PK + ch * 2) = (bf16)f2bf(val);
                        if (role == 1 && PASS == 3) *(LAS bf16*)(lds + LY::KN + (8 * g + e) * PK + ch * 2) = (bf16)f2bf(val); }
                    if (role == 1) *(LAS v4u*)(lds + LY::KUT + ch * P64 + g * 16) = pack8(vb);
                    if (role == 2) { *(LAS v4u*)(lds + LY::VT + ch * P64 + g * 16) = pack8(vb); if (PASS == 3) *(LAS v4u*)(lds + LY::XT + ch * P64 + g * 16) = pack8(va); }
                }
            }
        }
        __syncthreads();
        f32x4 aD[NM], aI[NM];
        if (PASS == 3) {
            { const int ts = w >> 1, tl0 = 2 * (w & 1);
              f32x4 sacc[2] = {(f32x4){0.f, 0.f, 0.f, 0.f}, (f32x4){0.f, 0.f, 0.f, 0.f}};
#pragma unroll
              for (int kb = 0; kb < NKB; ++kb) { const bf16x8 xf = ldf(lds + LY::KN, PK, ts * 16 + c, kb * 32 + q * 8);
#pragma unroll
                  for (int i = 0; i < 2; ++i) { const bf16x8 yf = ldf(lds + LY::Q, PK, (tl0 + i) * 16 + c, kb * 32 + q * 8); sacc[i] = __builtin_amdgcn_mfma_f32_16x16x32_bf16(xf, yf, sacc[i], 0, 0, 0); } }
              const f32x4 cf = *(const LAS f32x4*)(sc + S_COLF + ts * 16 + 4 * q);
#pragma unroll
              for (int i = 0; i < 2; ++i) { const int l = (tl0 + i) * 16 + c; const float rf = sc[S_ROWF + l];
                  float p[4];
#pragma unroll
                  for (int r = 0; r < 4; ++r) { const int s = ts * 16 + 4 * q + r; const float wgt = (s <= l) ? __expf(rf + cf[r]) : 0.f; p[r] = sacc[i][r] * wgt; }
                  v2u o; o.x = pk2(p[0], p[1]); o.y = pk2(p[2], p[3]);
                  *(LAS v2u*)(lds + LY::PM + l * P64 + (ts * 16 + 4 * q) * 2) = o;
                  if (KIND == 1) { float ps = (bfround(p[0]) + bfround(p[1])) + (bfround(p[2]) + bfround(p[3])); ps += __shfl_xor(ps, 16); ps += __shfl_xor(ps, 32);
                      if (q == 0) sc[S_ROWSUM + ts * 64 + l] = ps; } } }
#pragma unroll
            for (int a = 0; a < TKW; ++a)
#pragma unroll
                for (int bb = 0; bb < TVW; ++bb) { const int dv = (wv * TVW + bb) * 16 + c, dk0 = (wk * TKW + a) * 16 + 4 * q;
                    v2u o; o.x = pk2(st[a][bb][0], st[a][bb][1]); o.y = pk2(st[a][bb][2], st[a][bb][3]);
                    *(LAS v2u*)(lds + LY::ST + dv * PK + dk0 * 2) = o; }
            if (KIND == 1) { const int l = tid >> 3, part = tid & 7; float a = 0.f;
                const v4u qa = *(const LAS v4u*)(lds + LY::Q + l * PK + part * 32), qb = *(const LAS v4u*)(lds + LY::Q + l * PK + part * 32 + 16);
                const unsigned qw[8] = {qa.x, qa.y, qa.z, qa.w, qb.x, qb.y, qb.z, qb.w};
#pragma unroll
                for (int i = 0; i < 8; ++i) a += pg8::bf_lo(qw[i]) * sc[S_NVEC + part * 16 + 2 * i] + pg8::bf_hi(qw[i]) * sc[S_NVEC + part * 16 + 2 * i + 1];
                a += __shfl_xor(a, 1); a += __shfl_xor(a, 2); a += __shfl_xor(a, 4);
                if (part == 0) sc[S_QN + l] = a; }
            __syncthreads();
            { const int n = w & 3, mh = w >> 2;
#pragma unroll
              for (int mm = 0; mm < NM; ++mm) { aD[mm] = (f32x4){0.f, 0.f, 0.f, 0.f}; aI[mm] = (f32x4){0.f, 0.f, 0.f, 0.f}; }
#pragma unroll
              for (int kb = 0; kb < 2; ++kb) { const bf16x8 yf = ldf(lds + LY::PM, P64, n * 16 + c, kb * 32 + q * 8);
#pragma unroll
                  for (int mm = 0; mm < NM; ++mm) { const bf16x8 xf = ldf(lds + LY::VT, P64, (mh * NM + mm) * 16 + c, kb * 32 + q * 8); aD[mm] = __builtin_amdgcn_mfma_f32_16x16x32_bf16(xf, yf, aD[mm], 0, 0, 0); } }
#pragma unroll
              for (int kb = 0; kb < NKB; ++kb) { const bf16x8 yf = ldf(lds + LY::Q, PK, n * 16 + c, kb * 32 + q * 8);
#pragma unroll
                  for (int mm = 0; mm < NM; ++mm) { const bf16x8 xf = ldf(lds + LY::ST, PK, (mh * NM + mm) * 16 + c, kb * 32 + q * 8); aI[mm] = __builtin_amdgcn_mfma_f32_16x16x32_bf16(xf, yf, aI[mm], 0, 0, 0); } } }
        }
#pragma unroll
        for (int a = 0; a < TKW; ++a)
#pragma unroll
            for (int bb = 0; bb < TVW; ++bb) st[a][bb] *= sdec;
#pragma unroll
        for (int kb = 0; kb < 2; ++kb) { bf16x8 xf[TKW];
#pragma unroll
            for (int a = 0; a < TKW; ++a) xf[a] = ldf(lds + LY::KUT, P64, (wk * TKW + a) * 16 + c, kb * 32 + q * 8);
#pragma unroll
            for (int bb = 0; bb < TVW; ++bb) { const bf16x8 yf = ldf(lds + LY::VT, P64, (wv * TVW + bb) * 16 + c, kb * 32 + q * 8);
#pragma unroll
                for (int a = 0; a < TKW; ++a) st[a][bb] = __builtin_amdgcn_mfma_f32_16x16x32_bf16(xf[a], yf, st[a][bb], 0, 0, 0); } }
        if (PASS == 3) {
            const int n = w & 3, mh = w >> 2, l = n * 16 + c; const float inter = sc[S_INTER + l];
            const size_t grow = row0 + l;
            if (KIND == 0) {
#pragma unroll
                for (int mm = 0; mm < NM; ++mm) { const int dv0 = (mh * NM + mm) * 16 + 4 * q;
                    f32x4 o;
#pragma unroll
                    for (int r = 0; r < 4; ++r) { const float xv = bf2f(*(const LAS bf16*)(lds + LY::XT + (dv0 + r) * P64 + l * 2));
                        o[r] = aD[mm][r] + inter * aI[mm][r] + Dsk * xv; }
                    *(f32x4*)(ytmp + grow * 512 + head * 64 + dv0) = o; }
                __syncthreads();
            } else {
                float dinv = 1.0f;
                if (KIND == 1) { const float den = ((sc[S_ROWSUM + l] + sc[S_ROWSUM + 64 + l]) + (sc[S_ROWSUM + 128 + l] + sc[S_ROWSUM + 192 + l])) + inter * sc[S_QN + l]; dinv = 1.0f / fmaxf(fabsf(den), sc[S_EINV + l]); }
                float hv[NM][4]; float ssq = 0.f;
#pragma unroll
                for (int mm = 0; mm < NM; ++mm) { const int dv0 = (mh * NM + mm) * 16 + 4 * q;
                    float og[4] = {1.f, 1.f, 1.f, 1.f};
                    if (KIND == 1) { const v2u ow = *(const v2u*)(P + grow * PLD + 1536 + head * 128 + dv0);
                        og[0] = sigmoidf_(pg8::bf_lo(ow.x)); og[1] = sigmoidf_(pg8::bf_hi(ow.x)); og[2] = sigmoidf_(pg8::bf_lo(ow.y)); og[3] = sigmoidf_(pg8::bf_hi(ow.y)); }
#pragma unroll
                    for (int r = 0; r < 4; ++r) { hv[mm][r] = (aD[mm][r] + inter * aI[mm][r]) * dinv * og[r]; ssq += hv[mm][r] * hv[mm][r]; } }
                ssq += __shfl_xor(ssq, 16); ssq += __shfl_xor(ssq, 32);
                const int par = ci & 1;
                if (q == 0) sc[S_RED + par * 128 + mh * 64 + l] = ssq;
                __syncthreads();
                const float tot = sc[S_RED + par * 128 + l] + sc[S_RED + par * 128 + 64 + l];
                const float rs = 1.0f / sqrtf(tot * (1.f / 128.f) + EPS);
                const float* ng = F.in[KIND == 1 ? I_CNORMG : I_DNORMG] + layer * BRW + head * 128;
                const int zcol = KIND == 1 ? 2048 : 1024, ycol = KIND == 1 ? 1024 : 1536;
                bf16* Y = (bf16*)(F.ws + WS_Y);
#pragma unroll
                for (int mm = 0; mm < NM; ++mm) { const int dv0 = (mh * NM + mm) * 16 + 4 * q;
                    const v2u zw = *(const v2u*)(P + grow * PLD + zcol + head * 128 + dv0);
                    const f32x4 gv = *(const f32x4*)(ng + dv0);
                    const float o0 = hv[mm][0] * rs * gv[0] * siluf_(pg8::bf_lo(zw.x)), o1 = hv[mm][1] * rs * gv[1] * siluf_(pg8::bf_hi(zw.x));
                    const float o2 = hv[mm][2] * rs * gv[2] * siluf_(pg8::bf_lo(zw.y)), o3 = hv[mm][3] * rs * gv[3] * siluf_(pg8::bf_hi(zw.y));
                    v2u o; o.x = pk2(o0, o1); o.y = pk2(o2, o3);
                    *(v2u*)(Y + grow * 2048 + ycol + head * 128 + dv0) = o; }
            }
        } else {
            __syncthreads();
        }
    }
    if (PASS == 1) {
#pragma unroll
        for (int a = 0; a < TKW; ++a)
#pragma unroll
            for (int bb = 0; bb < TVW; ++bb)
#pragma unroll
                for (int r = 0; r < 4; ++r) stp[(size_t)((a * TVW + bb) * 4 + r) * 512] = st[a][bb][r];
        if (KIND == 1) stp[(size_t)NREG * 512] = nreg;
        if (tid == 0) { scbase[sl * 4 + 0] = asum; scbase[sl * 4 + 1] = mp; }
    }
}
template <int KIND, int PASS>
__device__ __forceinline__ void phase_gla(Frame& F, int layer, float* stbase, float* scbase, float* ytmp) {
    using C = GC<KIND>; using LY = Lay<KIND>;
    for (int it = F.bid; it < LY::NITEMS; it += F.G) {
        const int j = it % LY::NSC, head = (it / LY::NSC) % C::NH, b = it / (LY::NSC * C::NH);
        gla_item<KIND, PASS>(F, layer, b, head, j, stbase, scbase, ytmp);
    }
}
template <int KIND>
__device__ __forceinline__ void phase_scan(Frame& F, float* stbase, float* scbase) {
    using C = GC<KIND>; using LY = Lay<KIND>;
    const int total = BATCH * C::NH * LY::NEL;
    for (int idx = F.bid * (NWAVES * 64) + F.tid; idx < total; idx += F.G * NWAVES * 64) {
        const int chain = idx / LY::NEL, e = idx % LY::NEL;
        float start = 0.f, m = 0.f;
        for (int j = 0; j < LY::NSC; ++j) { const int sl = chain * LY::NSC + j; const float A = scbase[sl * 4];
            float fo, fl;
            if (KIND == 1) { const float ml = scbase[sl * 4 + 1], mnew = fmaxf(A + m, ml); fo = expf(A + m - mnew); fl = expf(ml - mnew); if (e == 0) scbase[sl * 4 + 2] = m; m = mnew; }
            else { fo = expf(A); fl = 1.f; }
            const float loc = stbase[(size_t)sl * LY::NEL + e]; stbase[(size_t)sl * LY::NEL + e] = start; start = fo * start + fl * loc; }
    }
}
}

namespace rg {
using gla::ldf; using gla::pack8; using gla::P64; using gla::bf16x8;
constexpr int NCH = 8, NSC = gla::NCHUNK / NCH, NITEMS = BATCH * 8 * NSC;
constexpr int PLD = 1024, PCOL = 0;
constexpr int L_WA = 0, L_WX = 9216, L_XB = 18432, L_XF = 27648, L_A = L_XF + 16384, L_D = L_A + 17408, L_END = L_D + 17408;
static_assert(L_END <= LDS_BYTES, "LDS");
template <int PASS>
__device__ __forceinline__ void item(Frame& F, int layer, int b, int hb, int j, float* stA) {
    LAS unsigned char* const lds = F.lds;
    const int tid = F.tid, lane = F.lane, w = F.wave, c = lane & 15, q = lane >> 4;
    const bf16* P = (const bf16*)(F.ws + WS_P); bf16* Y = (bf16*)(F.ws + WS_Y);
    float* slot = stA + (size_t)(((b * 8 + hb) * NSC + j) * 128);
    __syncthreads();
    { const float* wa = F.in[I_AGAW] + ((size_t)layer * 8 + hb) * 4096; const float* wx = F.in[I_AGXW] + ((size_t)layer * 8 + hb) * 4096;
      const int jo = tid & 63, i0 = (tid >> 6) * 8; float va[8], vx[8];
#pragma unroll
      for (int e = 0; e < 8; ++e) { va[e] = wa[(i0 + e) * 64 + jo]; vx[e] = wx[(i0 + e) * 64 + jo]; }
      *(LAS v4u*)(lds + L_WA + jo * P64 + i0 * 2) = pack8(va); *(LAS v4u*)(lds + L_WX + jo * P64 + i0 * 2) = pack8(vx); }
    float cw0 = 0.f, cw1 = 0.f, cw2 = 0.f, cw3 = 0.f, cbs = 0.f;
    if (tid < 256) { const int chg = hb * 64 + (tid & 63); const float* cwp = F.in[I_ACW] + (size_t)layer * 4 * BRW + chg;
        cw0 = cwp[0]; cw1 = cwp[BRW]; cw2 = cwp[2 * BRW]; cw3 = cwp[3 * BRW]; cbs = F.in[I_ACB][layer * BRW + chg]; }
    float ba[2], bx[2], sp[2];
#pragma unroll
    for (int i2 = 0; i2 < 2; ++i2) { const int chg = hb * 64 + (2 * (w & 1) + i2) * 16 + c;
        ba[i2] = F.in[I_AGAB][layer * BRW + chg]; bx[i2] = F.in[I_AGXB][layer * BRW + chg]; sp[i2] = softplusf_(-F.in[I_ALAM][layer * BRW + chg]); }
    float hs = 0.f, ap = 1.f;
    if (PASS == 3 && tid < 64) hs = slot[64 + tid];
    for (int ci = 0; ci < NCH; ++ci) {
        const int cg = j * NCH + ci; const size_t row0 = (size_t)b * SEQ + (size_t)cg * 64;
        if (tid < 256) {
            const int ch = tid & 63, lq = tid >> 6; const bf16* src = P + (row0 + lq * 16) * PLD + PCOL + hb * 64 + ch;
            float x1 = 0.f, x2 = 0.f, x3 = 0.f;
            if (cg * 64 + lq * 16 > 0) { x1 = bf2f(src[-(ptrdiff_t)PLD]); x2 = bf2f(src[-(ptrdiff_t)2 * PLD]); x3 = bf2f(src[-(ptrdiff_t)3 * PLD]); }
#pragma unroll
            for (int e = 0; e < 16; ++e) { const float x0 = bf2f(src[(size_t)e * PLD]);
                const float xc = cbs + cw3 * x0 + cw2 * x1 + cw1 * x2 + cw0 * x3; x3 = x2; x2 = x1; x1 = x0;
                const int l = lq * 16 + e;
                *(LAS bf16*)(lds + L_XB + l * P64 + ch * 2) = (bf16)f2bf(xc); *(LAS float*)(lds + L_XF + (l * 64 + ch) * 4) = xc; }
        }
        __syncthreads();
        { const int lt = w >> 1, jt0 = 2 * (w & 1);
          f32x4 ra[2] = {(f32x4){0.f, 0.f, 0.f, 0.f}, (f32x4){0.f, 0.f, 0.f, 0.f}}, ia[2] = {(f32x4){0.f, 0.f, 0.f, 0.f}, (f32x4){0.f, 0.f, 0.f, 0.f}};
#pragma unroll
          for (int kb = 0; kb < 2; ++kb) { const bf16x8 xf = ldf(lds + L_XB, P64, lt * 16 + c, kb * 32 + q * 8);
#pragma unroll
              for (int i2 = 0; i2 < 2; ++i2) { const bf16x8 ya = ldf(lds + L_WA, P64, (jt0 + i2) * 16 + c, kb * 32 + q * 8), yx = ldf(lds + L_WX, P64, (jt0 + i2) * 16 + c, kb * 32 + q * 8);
                  ra[i2] = __builtin_amdgcn_mfma_f32_16x16x32_bf16(xf, ya, ra[i2], 0, 0, 0); ia[i2] = __builtin_amdgcn_mfma_f32_16x16x32_bf16(xf, yx, ia[i2], 0, 0, 0); } }
#pragma unroll
          for (int i2 = 0; i2 < 2; ++i2)
#pragma unroll
              for (int r = 0; r < 4; ++r) { const int l = lt * 16 + 4 * q + r, jj = (jt0 + i2) * 16 + c;
                  const float rr = sigmoidf_(ra[i2][r] + ba[i2]), ig = sigmoidf_(ia[i2][r] + bx[i2]);
                  const float la = -8.0f * rr * sp[i2]; const float a = expf(la);
                  const float dr = sqrtf(-expm1f(2.0f * la)) * (ig * *(const LAS float*)(lds + L_XF + (l * 64 + jj) * 4));
                  *(LAS float*)(lds + L_A + (l * 68 + jj) * 4) = a; *(LAS float*)(lds + L_D + (l * 68 + jj) * 4) = dr; } }
        __syncthreads();
        if (w == 0) {
            const int ch = lane;
#pragma unroll 8
            for (int l = 0; l < 64; ++l) { const float a = *(const LAS float*)(lds + L_A + (l * 68 + ch) * 4), d = *(const LAS float*)(lds + L_D + (l * 68 + ch) * 4);
                hs = a * hs + d;
                if (PASS == 1) ap *= a;
                else { const float z = bf2f(P[(row0 + l) * PLD + PCOL + 512 + hb * 64 + ch]); Y[(row0 + l) * 2048 + hb * 64 + ch] = (bf16)f2bf(hs * siluf_(z)); } }
        }
    }
    if (PASS == 1 && tid < 64) { slot[tid] = ap; slot[64 + tid] = hs; }
}
template <int PASS>
__device__ __forceinline__ void phase(Frame& F, int layer, float* stA) {
    for (int it = F.bid; it < NITEMS; it += F.G) { const int j = it % NSC, hb = (it / NSC) & 7, b = it / (NSC * 8); item<PASS>(F, layer, b, hb, j, stA); }
}
__device__ __forceinline__ void phase_scan(Frame& F, float* stA) {
    for (int idx = F.bid * (NWAVES * 64) + F.tid; idx < BATCH * BRW; idx += F.G * NWAVES * 64) {
        const int b = idx >> 9, chx = idx & 511, hb = chx >> 6, ch = chx & 63; float start = 0.f;
        for (int j = 0; j < NSC; ++j) { float* s = stA + (size_t)(((b * 8 + hb) * NSC + j) * 128); const float ap = s[ch], hl = s[64 + ch]; s[64 + ch] = start; start = ap * start + hl; }
    }
}
}

__device__ __forceinline__ void phase_final(Frame& F) {
    const int gw = F.bid * NWAVES + F.wave, NGW = F.G * NWAVES;
    const float* ng = F.in[I_FNG];
    f32x4 gv[4];
#pragma unroll
    for (int j = 0; j < 4; ++j) gv[j] = *((const f32x4*)ng + F.lane + 64 * j);
    for (int row = gw; row < T; row += NGW) {
        f32x4* xr = (f32x4*)(F.out + (size_t)row * D) + F.lane;
        f32x4 v[4]; float s = 0.f;
#pragma unroll
        for (int j = 0; j < 4; ++j) { v[j] = xr[64 * j]; s += (v[j].x * v[j].x + v[j].y * v[j].y) + (v[j].z * v[j].z + v[j].w * v[j].w); }
        const float rs = 1.0f / sqrtf(wave_sum(s) * (1.f / D) + EPS);
#pragma unroll
        for (int j = 0; j < 4; ++j) xr[64 * j] = v[j] * rs * gv[j];
    }
}

#ifndef NAIVE_B
#define NAIVE_B 0
#endif
#ifndef NAIVE_C
#define NAIVE_C 0
#endif
#ifndef NAIVE_D
#define NAIVE_D 0
#endif
constexpr int NPL = 27;
constexpr int NPH = DEPTH * NPL + 1;

__device__ __forceinline__ void gemm_in_group(Frame& F, int col0, int ncols) {
    pg8::Gemm g{(const pg8::bf16_t*)(F.ws + WS_HN), (const pg8::bf16_t*)(F.ws + WS_W1) + (size_t)col0 * D, T, ncols, D, D, D};
    pg8::StaticOrder S; S.init(T, ncols, F.G, F.bid);
    pg8::EpiBf16S E{(pg8::bf16_t*)(F.ws + WS_P), ncols, 0};
    pg8::gemm_phase<pg8::EpiBf16S, pg8::StaticOrder, true, true>(F.lds, g, S, E, F.tid);
}

template <int KSEL> __global__ void __launch_bounds__(NWAVES * 64, 2) fwd(Args args) {
    extern __shared__ __attribute__((aligned(16))) unsigned char lds[];
    Frame F;
    F.lds = (LAS unsigned char*)lds;
    F.tid = threadIdx.x; F.lane = F.tid & 63; F.wave = __builtin_amdgcn_readfirstlane(F.tid >> 6);
    F.G = gridDim.x; F.bid = blockIdx.x;
    F.in = (InTab)__builtin_amdgcn_kernarg_segment_ptr(); F.out = args.out; F.ws = args.ws;
    volatile LAS unsigned* bst = (volatile LAS unsigned*)(F.lds + LDS_BYTES - 64);
    if (F.tid < 16) bst[F.tid] = 0u;
    __syncthreads();
    XcdBarrier xbar; xbar.bar = (unsigned*)(F.ws + WS_CTL) + 4096; xbar.x = 0; xbar.st = bst;
    if (KSEL < 0) xbar = xcd_barrier_post((unsigned*)(F.ws + WS_CTL) + 4096, bst);
    float* tmp32 = (float*)(F.ws + WS_P + 160 * MiB);
    float* stbase = (float*)(F.ws + WS_P + 224 * MiB);
    float* scbase = (float*)(F.ws + WS_STATE);

    for (int ph = args.ph_lo; ph < args.ph_hi; ++ph) {
        if (KSEL < 0 && ph > args.ph_lo) { if (ph == args.ph_lo + 1) cooperative_groups::this_grid().sync(); else xcd_barrier(xbar); }
        if (KSEL == NPL || (KSEL < 0 && ph == NPH - 1)) { phase_final(F); continue; }
        int layer = ph / NPL; const int k = KSEL >= 0 ? KSEL : ph % NPL;
        if (KSEL < 0) {
            int t_ = threadIdx.x; unsigned char* w_ = args.ws; float* o_ = args.out; InTab i_ = (InTab)__builtin_amdgcn_kernarg_segment_ptr();
            asm volatile("" : "+v"(t_), "+s"(w_), "+s"(o_), "+s"(layer), "+s"(i_));
            F.in = i_; F.tid = t_; F.lane = t_ & 63; F.wave = __builtin_amdgcn_readfirstlane(t_ >> 6); F.ws = w_; F.out = o_;
            tmp32 = (float*)(F.ws + WS_P + 160 * MiB); stbase = (float*)(F.ws + WS_P + 224 * MiB); scbase = (float*)(F.ws + WS_STATE);
        }
        const float* xin = layer == 0 ? F.in[I_X] : F.out;
        switch (k) {
        case 0: phase_prep(F, layer, xin); phase_weights(F, layer); break;
        case 1: gemm_in_group(F, GA0, 1024); break;
        case 2: rg::phase<1>(F, layer, stbase); break;
        case 3: rg::phase_scan(F, stbase); break;
        case 4: rg::phase<3>(F, layer, stbase); break;
        case 5: gemm_in_group(F, GB0, 1536); break;
        case 6: if (NAIVE_B) phase_naive_b(F, layer, tmp32); else gla::phase_gla<0, 1>(F, layer, stbase, scbase, tmp32); break;
        case 7: if (!NAIVE_B) gla::phase_scan<0>(F, stbase, scbase); break;
        case 8: if (!NAIVE_B) gla::phase_gla<0, 3>(F, layer, stbase, scbase, tmp32); break;
        case 9: phase_post_b(F, layer, tmp32); break;
        case 10: gemm_in_group(F, GC0, 2560); break;
        case 11: if (NAIVE_C) phase_naive_c(F, layer, tmp32); else gla::phase_gla<1, 1>(F, layer, stbase, scbase, tmp32); break;
        case 12: if (NAIVE_C) phase_post_cd(F, tmp32, F.in[I_CNORMG] + layer * BRW, 2560, 1536, 2048, 1024); else gla::phase_scan<1>(F, stbase, scbase); break;
        case 13: if (!NAIVE_C) gla::phase_gla<1, 3>(F, layer, stbase, scbase, tmp32); break;
        case 14: gemm_in_group(F, GD0, 1536); break;
        case 15: if (NAIVE_D) phase_naive_d(F, tmp32); else gla::phase_gla<2, 1>(F, layer, stbase, scbase, tmp32); break;
        case 16: if (NAIVE_D) phase_post_cd(F, tmp32, F.in[I_DNORMG] + layer * BRW, 1536, -1, 1024, 1536); else gla::phase_scan<2>(F, stbase, scbase); break;
        case 17: if (!NAIVE_D) gla::phase_gla<2, 3>(F, layer, stbase, scbase, tmp32); break;
        case 18: case 20: case 22: case 24: {
            const int n = (k - 18) / 2;
            pg8::Gemm g{(const pg8::bf16_t*)(F.ws + WS_HN), (const pg8::bf16_t*)(F.ws + WS_W1) + (size_t)(GG0 + n * 1024) * D, T, 1024, D, D, D};
            pg8::StaticOrder S; S.init(T, 1024, F.G, F.bid);
            pg8::EpiBf16S E{(pg8::bf16_t*)(F.ws + WS_P), 1024, 1};
            pg8::gemm_phase<pg8::EpiBf16S, pg8::StaticOrder, true, true>(F.lds, g, S, E, F.tid);
        } break;
        case 19: case 21: case 23: case 25: {
            const int n = (k - 19) / 2;
            pg8::Gemm g{(const pg8::bf16_t*)(F.ws + WS_Y) + n * BRW, (const pg8::bf16_t*)(F.ws + WS_WB) + n * BRW, T, D, BRW, 2048, 2048};
            pg8::StaticOrder S; S.init(T, D, F.G, F.bid);
            pg8::EpiMergeRMW E{(const pg8::bf16_t*)(F.ws + WS_P), 1024, (float*)(F.ws + WS_P + 64 * MiB), (pg8::bf16_t*)(F.ws + WS_HN), 1024, n == 0 ? 0 : (n == 3 ? 2 : 1)};
            pg8::gemm_phase<pg8::EpiMergeRMW, pg8::StaticOrder, true, true>(F.lds, g, S, E, F.tid);
        } break;
        case 26: {
            pg8::Gemm g{(const pg8::bf16_t*)(F.ws + WS_HN), (const pg8::bf16_t*)(F.ws + WS_WO), T, D, D, D, D};
            pg8::StaticOrder S; S.init(T, D, F.G, F.bid);
            pg8::EpiResid E{xin, F.out, D};
            pg8::gemm_phase<pg8::EpiResid, pg8::StaticOrder, true, true>(F.lds, g, S, E, F.tid);
        } break;
        }
    }
}

extern "C" void kernel_launch(void* const* d_in, const int* in_sizes, int n_in, void* d_out, int out_size, void* d_ws, size_t ws_size, hipStream_t stream) {
    static int grid = 0;
    if (grid == 0) {
        if (n_in != 23 || in_sizes[0] != T * D || out_size != T * D || ws_size < WS_END) { fprintf(stderr, "kernel_launch: unexpected shapes (n_in %d, in0 %d, out %d, ws %zu)\n", n_in, n_in > 0 ? in_sizes[0] : -1, out_size, ws_size); grid = -1; return; }
        int dev = 0, cus = 0, per_cu = 0;
        if (hipGetDevice(&dev) != hipSuccess || hipDeviceGetAttribute(&cus, hipDeviceAttributeMultiprocessorCount, dev) != hipSuccess) { grid = -1; return; }
        if (hipFuncSetAttribute((const void*)fwd<-1>, hipFuncAttributeMaxDynamicSharedMemorySize, LDS_BYTES) != hipSuccess) { fprintf(stderr, "kernel_launch: hipFuncSetAttribute failed\n"); grid = -1; return; }
        if (hipOccupancyMaxActiveBlocksPerMultiprocessor(&per_cu, (const void*)fwd<-1>, NWAVES * 64, LDS_BYTES) != hipSuccess || per_cu < 1) { fprintf(stderr, "kernel_launch: occupancy query says %d blocks per CU\n", per_cu); grid = -1; return; }
        grid = cus;
    }
    if (grid < 0) return;
    Args a{};
    for (int i = 0; i < 23; ++i) a.in[i] = (const float*)d_in[i];
    a.out = (float*)d_out; a.ws = (unsigned char*)d_ws; a.ph_lo = 0; a.ph_hi = NPH;
    if (hipMemsetAsync((char*)d_ws + WS_CTL, 0, CTL_ZERO_BYTES, stream) != hipSuccess) { fprintf(stderr, "kernel_launch: memset failed\n"); return; }
    void* kargs[] = {&a};
    hipError_t e = hipLaunchCooperativeKernel((const void*)fwd<-1>, dim3(grid), dim3(NWAVES * 64), kargs, LDS_BYTES, stream);
    if (e != hipSuccess) fprintf(stderr, "kernel_launch: cooperative launch failed: %s (grid %d)\n", hipGetErrorString(e), grid);
}
```

```cpp
#include <hip/hip_runtime.h>
#include <hip/hip_cooperative_groups.h>
#include <cstdio>
#include <cstdint>

namespace pg8 {
#define PG8_LAS __attribute__((address_space(3)))
typedef unsigned short bf16_t;
typedef short bf16x8 __attribute__((ext_vector_type(8)));
typedef float f32x4 __attribute__((ext_vector_type(4)));
typedef unsigned u32x4 __attribute__((ext_vector_type(4)));
typedef unsigned u32x2 __attribute__((ext_vector_type(2)));
constexpr int BM = 256, BK = 64, HALF = 128, HTB = HALF * BK * 2  , STAGE_BYTES = 8 * HTB, NXCD = 8, WGM = 8;

__host__ __device__ __forceinline__ int lds_byte(int r, int c) { const int st = (r >> 4) * 2 + (c >> 5), rr = r & 15, cc = c & 31, ob = rr * 64 + cc * 2; return st * 1024 + (ob ^ (((ob >> 9) & 1) << 5)); }
__host__ __device__ __forceinline__ void stage_rc(int b, int& R, int& C) { const int st = b / 1024, sb = b % 1024, swz = sb ^ (((sb >> 9) & 1) << 5); R = (st >> 1) * 16 + swz / 64; C = (st & 1) * 32 + (swz % 64) / 2; }
__host__ __device__ __forceinline__ int perm32(int rho) { const int n = rho >> 4, i = rho & 15; return 8 * (i >> 2) + 4 * n + (i & 3); }

struct Unit { int pm, pn, ks; };
struct Gemm { const bf16_t* A; const bf16_t* Bt; int M, N, K, lda, ldb, kseg; };

struct StaticOrder {
    int nM, nN, nwg, G, c;
    __host__ __device__ void init(int M, int N, int G_, int c_) { nM = M / BM; nN = N / BM; nwg = nM * nN; G = G_; c = c_; }
    __host__ __device__ bool next(int i, Unit& u) const {
        const long L = (long)i * G + c; if (L >= nwg) return false;
        int wgid = (int)L; { const int q = nwg / NXCD, r = nwg % NXCD, xcd = wgid % NXCD, off = wgid / NXCD; wgid = (xcd < r ? xcd * (q + 1) : r * (q + 1) + (xcd - r) * q) + off; }
        const int nig = WGM * nN, gid = wgid / nig, fm = gid * WGM, gsz = (nM - fm) < WGM ? (nM - fm) : WGM;
        u.pm = fm + ((wgid % nig) % gsz); u.pn = (wgid % nig) / gsz; u.ks = 0; return true;
    }
    __device__ __forceinline__ void a_ready(const Unit&) const {}
    __device__ __forceinline__ void done(const Unit&) const {}
};


template <int NSEG> struct SegOrder : StaticOrder {
    __host__ __device__ bool next(int i, Unit& u) const { if (!StaticOrder::next(i / NSEG, u)) return false; u.ks = i % NSEG; return true; }
};

__device__ __forceinline__ unsigned cvt_pk_bf16(float lo, float hi) { unsigned r; asm volatile("v_cvt_pk_bf16_f32 %0, %1, %2" : "=v"(r) : "v"(lo), "v"(hi)); return r; }
__device__ __forceinline__ float bf_lo(unsigned w) { return __uint_as_float(w << 16); }
__device__ __forceinline__ float bf_hi(unsigned w) { return __uint_as_float(w & 0xffff0000u); }
__device__ __forceinline__ float sigmoid_f(float x) { return 1.0f / (1.0f + __expf(-x)); }

struct EpiBf16S {
    static constexpr bool PERM = true, AFTER_DRAIN = false, KEEP = false;
    bf16_t* O; int ldc; int sig;
    __device__ __forceinline__ void operator()(const f32x4 (&acc)[2][2][4][2], const Unit& u, int wr, int wc, int fr, int fq) const {
        const int row0 = u.pm * BM + wr * 64 + fr; const int col0 = u.pn * BM + wc * 32 + 8 * fq;
#pragma unroll
        for (int ai = 0; ai < 2; ++ai)
#pragma unroll
            for (int m = 0; m < 4; ++m) { bf16_t* rowp = O + (size_t)(row0 + ai * HALF + m * 16) * ldc + col0;
#pragma unroll
                for (int bj = 0; bj < 2; ++bj) { f32x4 v0 = acc[ai][bj][m][0], v1 = acc[ai][bj][m][1];
                    if (sig) {
#pragma unroll
                        for (int j = 0; j < 4; ++j) { v0[j] = sigmoid_f(v0[j]); v1[j] = sigmoid_f(v1[j]); } }
                    u32x4 w; w.x = cvt_pk_bf16(v0[0], v0[1]); w.y = cvt_pk_bf16(v0[2], v0[3]); w.z = cvt_pk_bf16(v1[0], v1[1]); w.w = cvt_pk_bf16(v1[2], v1[3]);
                    *(u32x4*)(rowp + bj * HALF) = w; } }
    }
};
struct EpiGates {
    static constexpr bool PERM = false, AFTER_DRAIN = false, KEEP = false;
    bf16_t* GR; const float* ssqB;
    __device__ __forceinline__ void operator()(const f32x4 (&acc)[2][2][4][2], const Unit& u, int wr, int wc, int fr, int fq) const {
        const int row0 = u.pm * BM + wr * 64 + fr, d0 = u.pn * 64 + wc * 16 + 4 * fq;
#pragma unroll
        for (int ai = 0; ai < 2; ++ai)
#pragma unroll
            for (int m = 0; m < 4; ++m) { const size_t row = (size_t)(row0 + ai * HALF + m * 16);
                const f32x4 s0 = *(const f32x4*)(ssqB + row * 8), s1 = *(const f32x4*)(ssqB + row * 8 + 4);
                const float rsB = 1.0f / sqrtf((((s0[0] + s0[1]) + (s0[2] + s0[3])) + ((s1[0] + s1[1]) + (s1[2] + s1[3]))) * (1.0f / 512.0f) + 1e-6f);
                float r0[4], r1[4], r2[4], r3[4];
#pragma unroll
                for (int e = 0; e < 4; ++e) {
                    const float g0 = sigmoid_f(fmaxf(acc[ai][0][m][0][e], -30.f)), g1 = sigmoid_f(fmaxf(acc[ai][0][m][1][e], -30.f)) * rsB;
                    const float g2 = sigmoid_f(fmaxf(acc[ai][1][m][0][e], -30.f)), g3 = sigmoid_f(fmaxf(acc[ai][1][m][1][e], -30.f));
                    r0[e] = g0 / g1; r1[e] = g1 / g2; r2[e] = g2 / g3; r3[e] = g3; }
                bf16_t* o = GR + row * 4096 + d0;
                u32x2 w; w.x = cvt_pk_bf16(r0[0], r0[1]); w.y = cvt_pk_bf16(r0[2], r0[3]); *(u32x2*)(o) = w;
                w.x = cvt_pk_bf16(r1[0], r1[1]); w.y = cvt_pk_bf16(r1[2], r1[3]); *(u32x2*)(o + 1024) = w;
                w.x = cvt_pk_bf16(r2[0], r2[1]); w.y = cvt_pk_bf16(r2[2], r2[3]); *(u32x2*)(o + 2048) = w;
                w.x = cvt_pk_bf16(r3[0], r3[1]); w.y = cvt_pk_bf16(r3[2], r3[3]); *(u32x2*)(o + 3072) = w; }
    }
};
struct EpiHorner {
    static constexpr bool PERM = false, AFTER_DRAIN = false, KEEP = true;
    const bf16_t* GR; bf16_t* Mb; int ldc;
    __device__ __forceinline__ void operator()(f32x4 (&acc)[2][2][4][2], const Unit& u, int wr, int wc, int fr, int fq) const {
        const int row0 = u.pm * BM + wr * 64 + fr, col0 = u.pn * BM + wc * 32 + 4 * fq;
#pragma unroll
        for (int ai = 0; ai < 2; ++ai)
#pragma unroll
            for (int m = 0; m < 4; ++m) { const size_t row = (size_t)(row0 + ai * HALF + m * 16);
#pragma unroll
                for (int bj = 0; bj < 2; ++bj)
#pragma unroll
                    for (int n = 0; n < 2; ++n) { const int c = col0 + bj * HALF + n * 16;
                        const u32x2 gw = *(const u32x2*)(GR + row * 4096 + u.ks * 1024 + c);
                        f32x4 g; g[0] = bf_lo(gw.x); g[1] = bf_hi(gw.x); g[2] = bf_lo(gw.y); g[3] = bf_hi(gw.y);
                        acc[ai][bj][m][n] *= g;
                        if (u.ks == 3) { u32x2 w; w.x = cvt_pk_bf16(acc[ai][bj][m][n][0], acc[ai][bj][m][n][1]); w.y = cvt_pk_bf16(acc[ai][bj][m][n][2], acc[ai][bj][m][n][3]); *(u32x2*)(Mb + row * ldc + c) = w; } } }
    }
};
struct EpiResid {
    static constexpr bool PERM = false, AFTER_DRAIN = false, KEEP = false;
    const float* xin; float* out; int ldc;
    __device__ __forceinline__ void operator()(const f32x4 (&acc)[2][2][4][2], const Unit& u, int wr, int wc, int fr, int fq) const {
        const int row0 = u.pm * BM + wr * 64 + fr, col0 = u.pn * BM + wc * 32 + 4 * fq;
#pragma unroll
        for (int ai = 0; ai < 2; ++ai)
#pragma unroll
            for (int m = 0; m < 4; ++m) { const size_t off = (size_t)(row0 + ai * HALF + m * 16) * ldc + col0;
#pragma unroll
                for (int bj = 0; bj < 2; ++bj)
#pragma unroll
                    for (int n = 0; n < 2; ++n) { const f32x4 xs = *(const f32x4*)(xin + off + bj * HALF + n * 16); *(f32x4*)(out + off + bj * HALF + n * 16) = xs + acc[ai][bj][m][n]; } }
    }
};

template <class Epi, class Sched, bool ALIGN_EPI = false, bool SP2 = false>
__device__ __forceinline__ void gemm_phase(PG8_LAS unsigned char* lds, const Gemm g, const Sched& S, const Epi& E, const int tid) {
    const int wid = __builtin_amdgcn_readfirstlane(tid >> 6), lane = tid & 63, wr = wid >> 2, wc = wid & 3, fr = lane & 15, fq = lane >> 4;
    const int K = g.K, nt = K / BK;
    unsigned voffA[2], voffB[2];
#pragma unroll
    for (int i = 0; i < 2; ++i) { int R, C; stage_rc(tid * 16 + i * 8192, R, C); const int Rb = Epi::PERM ? ((R & ~31) + perm32(R & 31)) : R;
        voffA[i] = (unsigned)(R * g.lda + C) * 2u; voffB[i] = (unsigned)(Rb * g.ldb + C) * 2u; }
    const size_t kstep = (size_t)(BK * 2);
    const size_t hstepA = (size_t)HALF * g.lda * 2, hstepB = (size_t)HALF * g.ldb * 2;
    const size_t tstepA = 2 * hstepA, tstepB = 2 * hstepB;
    const unsigned ldsw = (unsigned)wid * 1024u;
    const int aoff = lds_byte(wr * 64 + fr, fq * 8), boff = lds_byte(wc * 32 + fr, fq * 8);
#define PG8_SA(b, h) (((b) * 2 + (h)) * HTB)
#define PG8_SB(b, h) ((4 + (b) * 2 + (h)) * HTB)
#define PG8_STAGE(bufoff, gbase, voff) do { _Pragma("unroll") for (int _i = 0; _i < 2; ++_i) \
        __builtin_amdgcn_global_load_lds((const unsigned*)((const char*)(gbase) + (voff)[_i]), (PG8_LAS unsigned*)(lds + (bufoff) + ldsw + _i * 8192), 16, 0, 0); } while (0)
#define PG8_LDA(dst, b, h) do { _Pragma("unroll") for (int m = 0; m < 4; ++m) _Pragma("unroll") for (int k = 0; k < 2; ++k) dst[m][k] = *(const PG8_LAS bf16x8*)(lds + PG8_SA(b, h) + aoff + m * 2048 + k * 1024); } while (0)
#define PG8_LDB(dst, b, h) do { _Pragma("unroll") for (int n = 0; n < 2; ++n) _Pragma("unroll") for (int k = 0; k < 2; ++k) dst[n][k] = *(const PG8_LAS bf16x8*)(lds + PG8_SB(b, h) + boff + n * 2048 + k * 1024); } while (0)
#define PG8_MMA(ai, bj, At, Bt) do { __builtin_amdgcn_s_setprio(1); _Pragma("unroll") for (int m = 0; m < 4; ++m) _Pragma("unroll") for (int n = 0; n < 2; ++n) _Pragma("unroll") for (int k = 0; k < 2; ++k) \
        acc[ai][bj][m][n] = __builtin_amdgcn_mfma_f32_16x16x32_bf16(Bt[n][k], At[m][k], acc[ai][bj][m][n], 0, 0, 0); __builtin_amdgcn_s_setprio(0); } while (0)
#define PG8_WAIT_V(n) asm volatile("s_waitcnt vmcnt(" #n ")" ::: "memory")
#define PG8_WAIT_L(n) asm volatile("s_waitcnt lgkmcnt(" #n ")" ::: "memory")
#define PG8_BAR __builtin_amdgcn_s_barrier()
#define PG8_SCHED __builtin_amdgcn_sched_barrier(0)
    Unit cur, nxt; int ui = 0;
    if (!S.next(0, cur)) return;
    f32x4 acc[2][2][4][2];
#pragma unroll
    for (int a = 0; a < 2; ++a)
#pragma unroll
        for (int b = 0; b < 2; ++b)
#pragma unroll
            for (int m = 0; m < 4; ++m)
#pragma unroll
                for (int n = 0; n < 2; ++n) acc[a][b][m][n] = (f32x4){0.f, 0.f, 0.f, 0.f};
    bf16x8 At[4][2], B0[2][2], B1[2][2];
    const size_t sstep = (size_t)g.kseg * 2;
    const char* cA = (const char*)g.A + (size_t)cur.pm * tstepA + (size_t)cur.ks * sstep; const char* cB = (const char*)g.Bt + (size_t)cur.pn * tstepB + (size_t)cur.ks * sstep;
    S.a_ready(cur);
    if constexpr (SP2) {
        PG8_STAGE(PG8_SB(0, 0), cB, voffB); PG8_STAGE(PG8_SB(0, 1), cB + hstepB, voffB); PG8_STAGE(PG8_SA(0, 0), cA, voffA); PG8_STAGE(PG8_SA(0, 1), cA + hstepA, voffA);
        if (wr == 1) PG8_BAR;
        PG8_WAIT_V(2); PG8_BAR;
        PG8_STAGE(PG8_SB(1, 0), cB + kstep, voffB); PG8_STAGE(PG8_SA(1, 0), cA + kstep, voffA); PG8_STAGE(PG8_SB(1, 1), cB + hstepB + kstep, voffB);
        PG8_WAIT_V(6); PG8_BAR;
    } else {
        PG8_STAGE(PG8_SB(0, 0), cB, voffB); PG8_STAGE(PG8_SA(0, 0), cA, voffA); PG8_STAGE(PG8_SB(0, 1), cB + hstepB, voffB); PG8_STAGE(PG8_SA(0, 1), cA + hstepA, voffA);
        if (wr == 1) PG8_BAR;
        PG8_WAIT_V(4); PG8_BAR;
        PG8_STAGE(PG8_SB(1, 0), cB + kstep, voffB); PG8_STAGE(PG8_SA(1, 0), cA + kstep, voffA); PG8_STAGE(PG8_SB(1, 1), cB + hstepB + kstep, voffB);
        PG8_WAIT_V(6); PG8_BAR;
    }
    for (;;) {
        const bool has_next = S.next(ui + 1, nxt);
        const char* nA = has_next ? (const char*)g.A + (size_t)nxt.pm * tstepA + (size_t)nxt.ks * sstep : cA; const char* nB = has_next ? (const char*)g.Bt + (size_t)nxt.pn * tstepB + (size_t)nxt.ks * sstep : cB;
        for (int t = 0; t < nt; t += 2) {
            const bool last = (t == nt - 2);
            const char* a1 = cA + (size_t)(t + 1) * kstep;
            const char* a2 = last ? nA : cA + (size_t)(t + 2) * kstep; const char* b2 = last ? nB : cB + (size_t)(t + 2) * kstep;
            const char* a3 = a2 + kstep; const char* b3 = b2 + kstep;
            if (last && has_next) S.a_ready(nxt);
            if constexpr (SP2) {
            PG8_LDB(B0, 0, 0); PG8_LDB(B1, 0, 1); PG8_SCHED; PG8_LDA(At, 0, 0); PG8_STAGE(PG8_SA(1, 1), a1 + hstepA, voffA);
            PG8_WAIT_V(8); PG8_WAIT_L(0); PG8_BAR; PG8_MMA(0, 0, At, B0); PG8_MMA(0, 1, At, B1); PG8_BAR; PG8_SCHED;
            PG8_LDA(At, 0, 1); PG8_STAGE(PG8_SB(0, 0), b2, voffB); PG8_STAGE(PG8_SB(0, 1), b2 + hstepB, voffB); PG8_STAGE(PG8_SA(0, 0), a2, voffA);
            PG8_WAIT_V(8); PG8_WAIT_L(0); PG8_BAR; PG8_MMA(1, 0, At, B0); PG8_MMA(1, 1, At, B1); PG8_BAR; PG8_SCHED;
            PG8_LDB(B0, 1, 0); PG8_LDB(B1, 1, 1); PG8_SCHED; PG8_LDA(At, 1, 0); PG8_STAGE(PG8_SA(0, 1), a2 + hstepA, voffA);
            PG8_WAIT_V(8); PG8_WAIT_L(0); PG8_BAR; PG8_MMA(0, 0, At, B0); PG8_MMA(0, 1, At, B1); PG8_BAR; PG8_SCHED;
            PG8_LDA(At, 1, 1); PG8_STAGE(PG8_SB(1, 0), b3, voffB); PG8_STAGE(PG8_SB(1, 1), b3 + hstepB, voffB); PG8_STAGE(PG8_SA(1, 0), a3, voffA);
            PG8_WAIT_V(8); PG8_WAIT_L(0); PG8_BAR; PG8_MMA(1, 0, At, B0); PG8_MMA(1, 1, At, B1); PG8_BAR; PG8_SCHED;
            } else {
            PG8_LDB(B0, 0, 0); PG8_SCHED; PG8_LDA(At, 0, 0); PG8_STAGE(PG8_SA(1, 1), a1 + hstepA, voffA);
            PG8_WAIT_L(8); PG8_BAR; PG8_WAIT_L(0); PG8_MMA(0, 0, At, B0); PG8_BAR; PG8_SCHED;
            PG8_LDB(B1, 0, 1); PG8_STAGE(PG8_SB(0, 0), b2, voffB);
            PG8_BAR; PG8_WAIT_L(0); PG8_MMA(0, 1, At, B1); PG8_BAR;
            PG8_LDA(At, 0, 1); PG8_STAGE(PG8_SA(0, 0), a2, voffA);
            PG8_BAR; PG8_WAIT_L(0); PG8_MMA(1, 0, At, B0); PG8_BAR; PG8_SCHED;
            PG8_STAGE(PG8_SB(0, 1), b2 + hstepB, voffB);
            PG8_WAIT_V(6); PG8_BAR; PG8_MMA(1, 1, At, B1); PG8_BAR;
            PG8_LDB(B0, 1, 0); PG8_SCHED; PG8_LDA(At, 1, 0); PG8_STAGE(PG8_SA(0, 1), a2 + hstepA, voffA);
            PG8_WAIT_L(8); PG8_BAR; PG8_WAIT_L(0); PG8_MMA(0, 0, At, B0); PG8_BAR; PG8_SCHED;
            PG8_LDB(B1, 1, 1); PG8_STAGE(PG8_SB(1, 0), b3, voffB);
            PG8_BAR; PG8_WAIT_L(0); PG8_MMA(0, 1, At, B1); PG8_BAR;
            PG8_LDA(At, 1, 1); PG8_STAGE(PG8_SA(1, 0), a3, voffA);
            PG8_BAR; PG8_WAIT_L(0); PG8_MMA(1, 0, At, B0); PG8_BAR; PG8_SCHED;
            PG8_STAGE(PG8_SB(1, 1), b3 + hstepB, voffB);
            PG8_WAIT_V(6); PG8_BAR; PG8_MMA(1, 1, At, B1); PG8_BAR;
            }
        }
        if constexpr (ALIGN_EPI) { if (wr == 0) PG8_BAR; }
        if constexpr (!Epi::AFTER_DRAIN) { E(acc, cur, wr, wc, fr, fq); S.done(cur); }
        if (!has_next) break;
        if (!Epi::KEEP || nxt.ks == 0) {
#pragma unroll
        for (int a = 0; a < 2; ++a)
#pragma unroll
            for (int b = 0; b < 2; ++b)
#pragma unroll
                for (int m = 0; m < 4; ++m)
#pragma unroll
                    for (int n = 0; n < 2; ++n) acc[a][b][m][n] = (f32x4){0.f, 0.f, 0.f, 0.f};
        }
        cur = nxt; cA = nA; cB = nB; ++ui;
        if constexpr (ALIGN_EPI) { if (wr == 1) PG8_BAR; }
    }
    PG8_WAIT_V(0);
    if constexpr (!ALIGN_EPI) { if (wr == 0) PG8_BAR; }
    PG8_BAR;
#undef PG8_SA
#undef PG8_SB
#undef PG8_STAGE
#undef PG8_LDA
#undef PG8_LDB
#undef PG8_MMA
#undef PG8_WAIT_V
#undef PG8_WAIT_L
#undef PG8_BAR
#undef PG8_SCHED
}
}

constexpr int NWAVES = 8;
constexpr int BATCH = 4, SEQ = 8192, D = 1024, DEPTH = 2, T = BATCH * SEQ;
constexpr int W_IN = 10768, BRW = 512;
constexpr float EPS = 1e-6f;
constexpr int GA0 = 0, GB0 = 1024, GC0 = 2560, GD0 = 5120, GG0 = 6656, NW1 = 10752;
__host__ __device__ __forceinline__ int orig_col(int j) { return j < 2560 ? j : (j < 5120 ? j + 8 : (j < 6656 ? j + 16 : j + 16)); }

constexpr size_t MiB = 1u << 20;
constexpr size_t WS_CTL = 0, CTL_ZERO_BYTES = 1 * MiB;
constexpr size_t WS_SMALL = 1 * MiB;
constexpr size_t WS_SCB = 3 * MiB, WS_SCC = WS_SCB + 16384, WS_SCD = WS_SCB + 32768;
constexpr size_t WS_RGST = WS_SCB + 65536;
constexpr size_t WS_NC = WS_SCB + 512 * 1024;
constexpr size_t WS_SSQB = 4 * MiB;
constexpr size_t WS_STD = 5 * MiB;
constexpr size_t WS_W1 = 16 * MiB;
constexpr size_t WS_WB = 37 * MiB;
constexpr size_t WS_WO = 41 * MiB;
constexpr size_t WS_HN = 48 * MiB;
constexpr size_t WS_Y = 112 * MiB;
constexpr size_t WS_P = 240 * MiB;
constexpr size_t WS_STBC = 496 * MiB;
constexpr size_t WS_END = 512 * MiB;

constexpr int LDS_BYTES = 147456;

#define LAS __attribute__((address_space(3)))
typedef unsigned short bf16;
typedef unsigned v4u __attribute__((ext_vector_type(4)));
typedef unsigned v2u __attribute__((ext_vector_type(2)));
typedef float f32x4 __attribute__((ext_vector_type(4)));
#define LDS_WAIT() asm volatile("s_waitcnt lgkmcnt(0)" ::: "memory")

__device__ __forceinline__ unsigned f2bf(float f) { unsigned u = __builtin_bit_cast(unsigned, f); return (u + 0x7fffu + ((u >> 16) & 1u)) >> 16; }
__device__ __forceinline__ unsigned pk2(float lo, float hi) { return f2bf(lo) | (f2bf(hi) << 16); }
__device__ __forceinline__ float bf2f(bf16 b) { return __uint_as_float(((unsigned)b) << 16); }
__device__ __forceinline__ float sigmoidf_(float x) { return 1.0f / (1.0f + __expf(-x)); }
__device__ __forceinline__ float siluf_(float x) { return x / (1.0f + __expf(-x)); }
__device__ __forceinline__ float log1pexp_neg(float x) {
    const float e = __expf(x); return e < 0.03125f ? e * (1.0f - e * (0.5f - e * (0.33333334f - 0.25f * e))) : __logf(1.0f + e); }
__device__ __forceinline__ float softplusf_(float x) { return fmaxf(x, 0.f) + log1pexp_neg(-fabsf(x)); }
__device__ __forceinline__ float neg_expm1_neg(float x) {
    return x > -0.03125f ? -x * (1.0f + x * (0.5f + x * (0.16666667f + 0.041666668f * x))) : 1.0f - __expf(x); }
__constant__ float ROPE_INV[32] = {1.f, 0.749894261f, 0.562341332f, 0.421696514f, 0.316227764f, 0.237137377f, 0.177827939f, 0.133352131f, 0.100000001f, 0.0749894157f, 0.0562341325f, 0.0421696529f, 0.0316227749f, 0.0237137377f, 0.0177827943f, 0.0133352149f,
    0.00999999978f, 0.00749894185f, 0.00562341325f, 0.00421696482f, 0.00316227763f, 0.00237137359f, 0.00177827943f, 0.00133352145f, 0.00100000005f, 0.000749894243f, 0.000562341302f, 0.000421696517f, 0.000316227757f, 0.00023713737f, 0.00017782794f, 0.00013335215f};
__device__ __forceinline__ float wave_sum(float v) {
#pragma unroll
    for (int o = 1; o < 64; o <<= 1) v += __shfl_xor(v, o);
    return v;
}


#define XB_TMO      128
#define XB_XCNT(j)  (256  + 64 * (j))
#define XB_XSUB(j)  (1280 + 64 * (j))
#define XB_XGEN(j)  (2304 + 64 * (j))
#define XB_TOP      3328
#define XB_TOPGEN   3392
#define XCD_BAR_WORDS 3456
#define XB_SPIN_CAP (1u << 18)
__device__ __forceinline__ unsigned xb_ld(unsigned* p)              { return __hip_atomic_load(p, __ATOMIC_RELAXED, __HIP_MEMORY_SCOPE_AGENT); }
__device__ __forceinline__ unsigned xb_add(unsigned* p, unsigned v) { return __hip_atomic_fetch_add(p, v, __ATOMIC_RELAXED, __HIP_MEMORY_SCOPE_AGENT); }
__device__ __forceinline__ unsigned xb_xcc_id() { return (unsigned)__builtin_amdgcn_s_getreg((3 << 11) | 20) & 0xFu; }
#define XB_SPIN(cond, bar) do { unsigned _sp = 0; while (cond) { __builtin_amdgcn_s_sleep(1); \
    if ((++_sp & 255u) == 0u) { if (xb_ld(&(bar)[XB_TMO])) break; if (_sp > XB_SPIN_CAP) { atomicAdd(&(bar)[XB_TMO], 1u); break; } } } } while (0)
struct XcdBarrier { unsigned* bar; unsigned x; volatile LAS unsigned* st; };
__device__ __forceinline__ XcdBarrier xcd_barrier_post(unsigned* bar, volatile LAS unsigned* st) {
    XcdBarrier b; b.bar = bar; b.x = xb_xcc_id(); b.st = st;
    if (threadIdx.x == 0) (void)xb_add(&bar[XB_XCNT(b.x)], 1u);
    return b;
}
__device__ __forceinline__ void xcd_barrier_complete(unsigned* bar, unsigned x, unsigned& nloc, unsigned& nx) {
    const unsigned G = gridDim.x * gridDim.y * gridDim.z;
    unsigned sum, cnt, mine, sp = 0u;
    for (;;) {
        sum = 0u; cnt = 0u; mine = 0u;
#pragma unroll
        for (unsigned j = 0; j < 16; ++j) { const unsigned c = xb_ld(&bar[XB_XCNT(j)]); sum += c; cnt += (c > 0u) ? 1u : 0u; mine = (j == x) ? c : mine; }
        if (sum == G) break;
        __builtin_amdgcn_s_sleep(1);
        if ((++sp & 255u) == 0u) { if (xb_ld(&bar[XB_TMO])) break; if (sp > XB_SPIN_CAP) { atomicAdd(&bar[XB_TMO], 1u); break; } }
    }
    nloc = mine > 0u ? mine : 1u; nx = cnt > 0u ? cnt : 1u;
}
__device__ __forceinline__ void xcd_barrier(const XcdBarrier& b) {
    asm volatile("s_waitcnt vmcnt(0)" ::: "memory");
    __syncthreads();
    if (threadIdx.x == 0) {
        unsigned* bar = b.bar;
        __builtin_amdgcn_s_waitcnt(0);
        unsigned nloc = b.st[0], nx = b.st[1];
        if (nloc == 0u) { xcd_barrier_complete(bar, b.x, nloc, nx); b.st[0] = nloc; b.st[1] = nx; }
        const unsigned old = xb_add(&bar[XB_XSUB(b.x)], 1u);
        const unsigned gen = old / nloc;
        if (old + 1u == (gen + 1u) * nloc) {
            __builtin_amdgcn_fence(__ATOMIC_RELEASE, "agent");
            asm volatile("s_waitcnt vmcnt(0)" ::: "memory");
            const unsigned og = xb_add(&bar[XB_TOP], 1u);
            const unsigned tg = og / nx;
            if (og + 1u == (tg + 1u) * nx) xb_add(&bar[XB_TOPGEN], 1u);
            else XB_SPIN(xb_ld(&bar[XB_TOPGEN]) == tg, bar);
            __builtin_amdgcn_fence(__ATOMIC_ACQUIRE, "agent");
            xb_add(&bar[XB_XGEN(b.x)], 1u);
            asm volatile("s_waitcnt vmcnt(0)" ::: "memory");
        } else {
            XB_SPIN(xb_ld(&bar[XB_XGEN(b.x)]) == gen, bar);
            __builtin_amdgcn_fence(__ATOMIC_ACQUIRE, "agent");
            asm volatile("s_waitcnt vmcnt(0)" ::: "memory");
        }
    }
    __syncthreads();
}

struct Args {
    const float* in[23]; float* out; unsigned char* ws; int ph_lo, ph_hi;
};
typedef const float* cfp_t;
typedef __attribute__((address_space(4))) const cfp_t* InTab;
struct Frame {
    LAS unsigned char* lds;
    int tid, lane, wave, G, bid;
    InTab in; float* out; unsigned char* ws;
};
enum { I_X = 0, I_NORMG, I_WIN, I_ACW, I_ACB, I_AGAW, I_AGAB, I_AGXW, I_AGXB, I_ALAM, I_BCW, I_BCB, I_BDTB, I_BALOG, I_BDSKIP, I_BNORMG, I_CIB, I_CFB, I_CNORMG, I_DNORMG, I_WBR, I_WOUT, I_FNG };

__device__ __forceinline__ void transpose_item(const float* W, int ldw, int c0, int c1, const float* kscale, bf16* WT, int ldo, LAS float* scr, int k0, int lane) {
    const int sc_ = (lane & 31) < 16 ? c0 + (lane & 15) : c1 + (lane & 15);
#pragma unroll 8
    for (int i = 0; i < 32; ++i) { const int kk = 2 * i + (lane >> 5); float v = W[(size_t)(k0 + kk) * ldw + sc_]; if (kscale) v *= kscale[k0 + kk]; scr[kk * 33 + (lane & 31)] = v; }
    LDS_WAIT(); asm volatile("" ::: "memory");
    const int c = lane & 7;
#pragma unroll
    for (int j = 0; j < 4; ++j) { const int n = (lane >> 3) + 8 * j; const LAS float* sp = scr + (8 * c) * 33 + n;
        v4u o; o.x = pk2(sp[0 * 33], sp[1 * 33]); o.y = pk2(sp[2 * 33], sp[3 * 33]); o.z = pk2(sp[4 * 33], sp[5 * 33]); o.w = pk2(sp[6 * 33], sp[7 * 33]);
        *(v4u*)(WT + (size_t)n * ldo + k0 + 8 * c) = o; }
    LDS_WAIT(); asm volatile("" ::: "memory");
}
__device__ __forceinline__ void phase_weights(Frame& F, int layer) {
    LAS float* scr = (LAS float*)(F.lds + 65536 + F.wave * 8704);
    const int gw = F.bid * NWAVES + F.wave, NGW = F.G * NWAVES;
    const float* win = F.in[I_WIN] + (size_t)layer * D * W_IN;
    const float* wbr = F.in[I_WBR] + (size_t)layer * 4 * BRW * D;
    const float* wout = F.in[I_WOUT] + (size_t)layer * D * D;
    const float* bng = F.in[I_BNORMG] + (size_t)layer * BRW;
    bf16* W1 = (bf16*)(F.ws + WS_W1); bf16* WB = (bf16*)(F.ws + WS_WB); bf16* WO = (bf16*)(F.ws + WS_WO);
    constexpr int I1 = (D / 64) * (NW1 / 32), IB = 4 * (BRW / 64) * (D / 32), IO = (D / 64) * (D / 32);
    for (int it = gw; it < I1 + IB + IO; it += NGW) {
        int r = it;
        if (r < I1) { const int nb = r % (NW1 / 32), kb = r / (NW1 / 32); const int n0 = nb * 32;
            int c0, c1;
            if (n0 < GG0) { c0 = orig_col(n0); c1 = c0 + 16; }
            else {
                const int rel = n0 - GG0, u = rel >> 8, cl = rel & 255, bj = cl >> 7, wcg = (cl >> 5) & 3;
                c0 = 6672 + (2 * bj) * 1024 + 64 * u + 16 * wcg; c1 = c0 + 1024; }
            transpose_item(win, W_IN, c0, c1, nullptr, W1 + (size_t)n0 * D, D, scr, kb * 64, F.lane); continue; }
        r -= I1;
        if (r < IB) { const int n = r / ((BRW / 64) * (D / 32)); const int r2 = r % ((BRW / 64) * (D / 32)); const int nb = r2 % (D / 32), kb = r2 / (D / 32);
            transpose_item(wbr + (size_t)n * BRW * D, D, nb * 32, nb * 32 + 16, n == 1 ? bng : nullptr, WB + (size_t)(nb * 32) * 2048 + n * BRW, 2048, scr, kb * 64, F.lane); continue; }
        r -= IB;
        { const int nb = r % (D / 32), kb = r / (D / 32);
          transpose_item(wout, D, nb * 32, nb * 32 + 16, nullptr, WO + (size_t)(nb * 32) * D, D, scr, kb * 64, F.lane); }
    }
}
__device__ __forceinline__ void phase_prep(Frame& F, int layer, const float* xin) {
    LAS float* tab = (LAS float*)F.lds;
    const float* win = F.in[I_WIN] + (size_t)layer * D * W_IN;
    const float* ng = F.in[I_NORMG] + (size_t)layer * D;
    for (int e = F.tid; e < 16 * D; e += NWAVES * 64) { const int k = e >> 4, c = e & 15; const int col = c < 8 ? 2560 + c : 5120 + c;
        tab[c * D + k] = win[(size_t)k * W_IN + col] * ng[k]; }
    __syncthreads();
    bf16* hn = (bf16*)(F.ws + WS_HN); float* small = (float*)(F.ws + WS_SMALL);
    const int gw = F.bid * NWAVES + F.wave, NGW = F.G * NWAVES;
    f32x4 gv[4];
#pragma unroll
    for (int j = 0; j < 4; ++j) gv[j] = *((const f32x4*)ng + F.lane + 64 * j);
    for (int row = gw; row < T; row += NGW) {
        const f32x4* xr = (const f32x4*)(xin + (size_t)row * D) + F.lane;
        f32x4 v[4]; float s = 0.f;
#pragma unroll
        for (int j = 0; j < 4; ++j) { v[j] = xr[64 * j]; s += (v[j].x * v[j].x + v[j].y * v[j].y) + (v[j].z * v[j].z + v[j].w * v[j].w); }
        const float rs = 1.0f / sqrtf(wave_sum(s) * (1.f / D) + EPS);
        unsigned long long* o8 = (unsigned long long*)(hn + (size_t)row * D) + F.lane;
#pragma unroll
        for (int j = 0; j < 4; ++j) { const f32x4 h = v[j] * rs * gv[j];
            o8[64 * j] = (unsigned long long)pk2(h.x, h.y) | ((unsigned long long)pk2(h.z, h.w) << 32); }
        float myv = 0.f;
#pragma unroll 2
        for (int c = 0; c < 16; ++c) { float a = 0.f;
#pragma unroll
            for (int j = 0; j < 4; ++j) { const f32x4 w = *((const LAS f32x4*)(tab + c * D) + F.lane + 64 * j); a += (v[j].x * w.x + v[j].y * w.y) + (v[j].z * w.z + v[j].w * w.w); }
            a = wave_sum(a) * rs; if (F.lane == c) myv = a; }
        if (F.lane < 16) small[(size_t)row * 16 + F.lane] = myv;
    }
    __syncthreads();
}

namespace gla {
typedef short bf16x8 __attribute__((ext_vector_type(8)));
constexpr int P64 = 144;
constexpr int NCHUNK = SEQ / 64;
template <int KIND> struct GC;
template <> struct GC<0> { static constexpr int DK = 128, DV = 64,  PLD = 2560, PCOL = 1024, NH = 8, NCH = 8; };
template <> struct GC<1> { static constexpr int DK = 128, DV = 128, PLD = 4096, PCOL = 0, NH = 4, NCH = 8; };
template <> struct GC<2> { static constexpr int DK = 64,  DV = 128, PLD = 4096, PCOL = 2560, NH = 4, NCH = 8; };
template <int KIND> struct Lay {
    using C = GC<KIND>;
    static constexpr int PK = C::DK * 2 + 16;
    static constexpr int RP = KIND == 0 ? 656 : (KIND == 1 ? 272 : 528), RAWB = (KIND == 0 ? 67 : 64) * RP;
    static constexpr int Q = 0, KN = Q + 64 * PK, KUT = KN + 64 * PK, VT = KUT + C::DK * P64, XT = VT + C::DV * P64,
        PM = XT + (KIND == 0 ? C::DV * P64 : 0), ST = PM + 64 * P64, RAW = PM,
        SC = PM + ((64 * P64 + C::DV * PK) > RAWB ? (64 * P64 + C::DV * PK) : RAWB), END = SC + 8192;
    template <int PASS> static constexpr int npf() { return KIND == 0 ? (PASS == 3 ? 6 : 4) : (KIND == 1 ? (PASS == 3 ? 6 : 4) : (PASS == 3 ? 4 : 3)); }
    static constexpr int NTK = C::DK / 16, NTV = C::DV / 16, NKB = C::DK / 32, TKW = 2, TVW = NTK * NTV / 16, NWV = NTV / TVW;
    static constexpr int NREG = TKW * TVW * 4, NREGX = NREG, NEL = NREGX * 512;
    static constexpr int NSC = NCHUNK / C::NCH, NITEMS = BATCH * C::NH * NSC;
    static_assert(END <= LDS_BYTES, "LDS");
};
enum { S_ROWF = 0, S_COLF = 64, S_INTER = 128, S_U = 192, S_DT = 256, S_EINV = 320, S_QN = 448, S_RED = 512, S_NVEC = 768, S_MISC = 896, S_ROWSUM = 1024   };

__device__ __forceinline__ bf16x8 ldf(LAS const unsigned char* base, int pitch, int row, int kel) { return *(LAS const bf16x8*)(base + row * pitch + kel * 2); }
__device__ __forceinline__ v4u pack8(const float (&v)[8]) { v4u o; o.x = pk2(v[0], v[1]); o.y = pk2(v[2], v[3]); o.z = pk2(v[4], v[5]); o.w = pk2(v[6], v[7]); return o; }
__device__ __forceinline__ float bfround(float f) { return __uint_as_float(f2bf(f) << 16); }


template <int KIND, int PASS>
__device__ __forceinline__ void raw_piece(int tid, int i, int head, int& goff, int& loff) {
    using C = GC<KIND>; using LY = Lay<KIND>;
    constexpr int PK = LY::PK, PLD = C::PLD, RP = LY::RP;
    const int idx = tid + 512 * i; goff = 0; loff = -1;
    if (KIND == 0) { constexpr int CPR = PASS == 3 ? 40 : 24;
        if (idx < 67 * CPR) { const int r = idx / CPR, c8 = idx % CPR, g = head >> 2;
            const int gc = c8 < 8 ? head * 64 + c8 * 8 : (c8 < 24 ? 512 + g * 128 + (c8 - 8) * 8 : 768 + g * 128 + (c8 - 24) * 8);
            goff = (r - 3) * PLD + gc; loff = LY::RAW + r * RP + c8 * 16; } }
    if (KIND == 1) { constexpr int CPR = PASS == 3 ? 48 : 32;
        if (idx < 64 * CPR) { const int r = idx / CPR, cc = idx % CPR, seg = (PASS == 3 ? 0 : 1) + cc / 16, c8 = cc % 16;
            goff = r * PLD + seg * 512 + head * 128 + c8 * 8;
            loff = seg == 0 ? LY::Q + r * PK + c8 * 16 : (seg == 1 ? LY::KN + r * PK + c8 * 16 : LY::RAW + r * RP + c8 * 16); } }
    if (KIND == 2) { constexpr int CPR = PASS == 3 ? 32 : 24;
        if (idx < 64 * CPR) { const int r = idx / CPR, c8 = (PASS == 3 ? 0 : 8) + idx % CPR;
            const int gc = c8 < 8 ? head * 64 + c8 * 8 : (c8 < 16 ? 256 + head * 64 + (c8 - 8) * 8 : 512 + head * 128 + (c8 - 16) * 8);
            goff = r * PLD + gc; loff = LY::RAW + r * RP + c8 * 16; } }
}

template <int KIND, int PASS>
__device__ __forceinline__ void gla_item(Frame& F, int layer, int b, int head, int j, float* stbase, float* scbase, float* nbase, float* ssqB) {
    using C = GC<KIND>; using LY = Lay<KIND>;
    constexpr int DK = C::DK, DV = C::DV, PK = LY::PK, PLD = C::PLD, NKB = LY::NKB, TKW = LY::TKW, TVW = LY::TVW, NWV = LY::NWV, NM = LY::NTV / 2, NREG = LY::NREG;
    constexpr int RP = LY::RP, NPF = LY::template npf<PASS>();
    LAS unsigned char* const lds = F.lds;
    LAS float* const sc = (LAS float*)(lds + LY::SC);
    const int tid = F.tid, lane = F.lane, w = F.wave, c = lane & 15, q = lane >> 4;
    const int wk = w / NWV, wv = w % NWV;
    const bf16* P = (const bf16*)(F.ws + WS_P) + C::PCOL;
    const float* small = (const float*)(F.ws + WS_SMALL);
    const int chain = b * C::NH + head, sl = chain * LY::NSC + j;
    __syncthreads();
    float* const stp = stbase + (size_t)sl * LY::NEL + tid;
    f32x4 st[TKW][TVW];
    float nreg = 0.f, mp = 0.f, asum = 0.f;
    if (PASS == 3) {
#pragma unroll
        for (int a = 0; a < TKW; ++a)
#pragma unroll
            for (int bb = 0; bb < TVW; ++bb)
#pragma unroll
                for (int r = 0; r < 4; ++r) st[a][bb][r] = stp[(size_t)((a * TVW + bb) * 4 + r) * 512];
        if (KIND == 1) { if (tid < 128) nreg = nbase[sl * 128 + tid]; mp = scbase[sl * 4 + 2]; }
    } else {
#pragma unroll
        for (int a = 0; a < TKW; ++a)
#pragma unroll
            for (int bb = 0; bb < TVW; ++bb) st[a][bb] = (f32x4){0.f, 0.f, 0.f, 0.f};
        if (KIND == 1) mp = -1e30f;
    }
    float dtb = 0.f, Aneg = 0.f, Dsk = 0.f, ib = 0.f, fb = 0.f, logg = 0.f, inv = 0.f, cd = 1.f, sd = 0.f;
    float cw0 = 0.f, cw1 = 0.f, cw2 = 0.f, cw3 = 0.f, cbs = 0.f; int rcol = 0;
    if (KIND == 0) {
        dtb = F.in[I_BDTB][layer * 8 + head]; Aneg = -__expf(F.in[I_BALOG][layer * 8 + head]); Dsk = F.in[I_BDSKIP][layer * 8 + head];
        if (tid < 320) { const int g = head >> 2; const int scol = w < 2 ? 768 + g * 128 + tid : (w < 4 ? 512 + g * 128 + (tid - 128) : head * 64 + (tid - 256));
            rcol = w < 2 ? 192 + tid : (w < 4 ? 64 + (tid - 128) : tid - 256);
            const float* cwp = F.in[I_BCW] + (size_t)layer * 4 * 1024 + scol;
            cw0 = cwp[0]; cw1 = cwp[1024]; cw2 = cwp[2048]; cw3 = cwp[3072]; cbs = F.in[I_BCB][layer * 1024 + scol]; }
    }
    if (KIND == 1) { ib = F.in[I_CIB][layer * 4 + head]; fb = F.in[I_CFB][layer * 4 + head]; }
    if (KIND == 2) { logg = head == 0 ? -0.0317486983f : (head == 1 ? -0.0157483570f : (head == 2 ? -0.00784317746f : -0.00391389932f));
        inv = ROPE_INV[tid & 31]; cd = __cosf(inv); sd = __sinf(inv); }
    v4u pf[NPF];
    float spf0 = 0.f, spf1 = 0.f;
    {
        const int cg = j * C::NCH; const size_t row0 = (size_t)b * SEQ + (size_t)cg * 64;
#pragma unroll
        for (int i = 0; i < NPF; ++i) { int go, lo; raw_piece<KIND, PASS>(tid, i, head, go, lo); pf[i] = (v4u){0u, 0u, 0u, 0u};
            if (lo >= 0 && !(KIND == 0 && cg == 0 && go < 0)) pf[i] = *(const v4u*)(P + (ptrdiff_t)row0 * PLD + go); }
        if (w == 0) { if (KIND == 0) spf0 = small[(row0 + lane) * 16 + head]; if (KIND == 1) { spf0 = small[(row0 + lane) * 16 + 8 + head]; spf1 = small[(row0 + lane) * 16 + 12 + head]; } }
    }

    for (int ci = 0; ci < C::NCH; ++ci) {
        const int cg = j * C::NCH + ci; const size_t row0 = (size_t)b * SEQ + (size_t)cg * 64;
        int tl = tid; asm volatile("" : "+v"(tl));
#pragma unroll
        for (int i = 0; i < NPF; ++i) { int go, lo; raw_piece<KIND, PASS>(tl, i, head, go, lo);
            if (lo >= 0) { *(LAS v4u*)(lds + lo) = pf[i]; if (ci + 1 < C::NCH) pf[i] = *(const v4u*)(P + (ptrdiff_t)(row0 + 64) * PLD + go); } }
        v2u zpf[NM], opf[NM];
        if (w == 0) {
            float a = 0.f, li = 0.f, dtv = 0.f;
            if (KIND == 0) { dtv = softplusf_(spf0 + dtb); a = Aneg * dtv; }
            if (KIND == 1) { li = spf0 + ib; a = -softplusf_(-(spf1 + fb)); }
            if (KIND == 2) a = logg;
            if (ci + 1 < C::NCH) { if (KIND == 0) spf0 = small[(row0 + 64 + lane) * 16 + head]; if (KIND == 1) { spf0 = small[(row0 + 64 + lane) * 16 + 8 + head]; spf1 = small[(row0 + 64 + lane) * 16 + 12 + head]; } }
            float acs = a;
#pragma unroll
            for (int o = 1; o < 64; o <<= 1) { const float t = __shfl_up(acs, o); if (lane >= o) acs += t; }
            const float a63 = __shfl(acs, 63);
            float mrow = 0.f, mn = 0.f;
            if (KIND == 1) { float cm = li - acs;
#pragma unroll
                for (int o = 1; o < 64; o <<= 1) { const float t = __shfl_up(cm, o); if (lane >= o) cm = fmaxf(cm, t); }
                mrow = acs + fmaxf(mp, cm); mn = __shfl(mrow, 63); }
            sc[S_ROWF + lane] = acs - mrow; sc[S_COLF + lane] = li - acs;
            sc[S_INTER + lane] = __expf(acs + mp - mrow);
            sc[S_U + lane] = __expf(a63 - acs + li - mn);
            if (KIND == 0) sc[S_DT + lane] = dtv;
            if (KIND == 1) sc[S_EINV + lane] = __expf(-mrow);
            if (lane == 0) sc[S_MISC] = __expf(a63 + mp - mn);
            if (KIND == 1) mp = mn;
            asum += a63;
        }
        __syncthreads();
        const float sdec = sc[S_MISC];
        if (KIND == 0) {
            if (tid < 320 && (PASS == 3 || w >= 2)) {
                const int role = w < 2 ? 0 : (w < 4 ? 1 : 2), ch = role == 0 ? tid : (role == 1 ? tid - 128 : tid - 256);
                const LAS unsigned char* rp = lds + LY::RAW + rcol * 2;
                float w3 = bf2f(*(const LAS bf16*)(rp)), w2 = bf2f(*(const LAS bf16*)(rp + RP)), w1 = bf2f(*(const LAS bf16*)(rp + 2 * RP));
#pragma unroll 2
                for (int g = 0; g < 8; ++g) {
                    const f32x4 u0 = *(const LAS f32x4*)(sc + (role == 2 ? S_DT : S_U) + 8 * g), u1 = *(const LAS f32x4*)(sc + (role == 2 ? S_DT : S_U) + 8 * g + 4);
                    float va[8], vb[8];
#pragma unroll
                    for (int e = 0; e < 8; ++e) { const float x0 = bf2f(*(const LAS bf16*)(rp + (3 + 8 * g + e) * RP));
                        const float xc = cbs + cw3 * x0 + cw2 * w1 + cw1 * w2 + cw0 * w3; w3 = w2; w2 = w1; w1 = x0;
                        const float val = siluf_(xc); va[e] = val; vb[e] = val * (e < 4 ? u0[e & 3] : u1[e & 3]);
                        if (role == 0) *(LAS bf16*)(lds + LY::Q + (8 * g + e) * PK + ch * 2) = (bf16)f2bf(val);
                        if (role == 1 && PASS == 3) *(LAS bf16*)(lds + LY::KN + (8 * g + e) * PK + ch * 2) = (bf16)f2bf(val); }
                    if (role == 1) *(LAS v4u*)(lds + LY::KUT + ch * P64 + g * 16) = pack8(vb);
                    if (role == 2) { *(LAS v4u*)(lds + LY::VT + ch * P64 + g * 16) = pack8(vb); if (PASS == 3) *(LAS v4u*)(lds + LY::XT + ch * P64 + g * 16) = pack8(va); }
                }
            }
        }
        if (KIND == 1) {
            if (tid < 128) {
                const int dk = tid; float nsum = 0.f;
#pragma unroll 2
                for (int g = 0; g < 8; ++g) {
                    const f32x4 u0 = *(const LAS f32x4*)(sc + S_U + 8 * g), u1 = *(const LAS f32x4*)(sc + S_U + 8 * g + 4);
                    float ku[8];
#pragma unroll
                    for (int e = 0; e < 8; ++e) { const float kf = bf2f(*(const LAS bf16*)(lds + LY::KN + (8 * g + e) * PK + dk * 2)) * 0.08838834764831845f;
                        ku[e] = kf * (e < 4 ? u0[e & 3] : u1[e & 3]); nsum += ku[e]; }
                    *(LAS v4u*)(lds + LY::KUT + dk * P64 + g * 16) = pack8(ku);
                }
                if (PASS == 3) sc[S_NVEC + dk] = nreg;
                nreg = sdec * nreg + nsum;
            } else if (tid < 256) {
                const int dv = tid - 128;
#pragma unroll 2
                for (int g = 0; g < 8; ++g) { unsigned r[8];
#pragma unroll
                    for (int e = 0; e < 8; ++e) r[e] = *(const LAS bf16*)(lds + LY::RAW + (8 * g + e) * RP + dv * 2);
                    v4u o; o.x = r[0] | (r[1] << 16); o.y = r[2] | (r[3] << 16); o.z = r[4] | (r[5] << 16); o.w = r[6] | (r[7] << 16);
                    *(LAS v4u*)(lds + LY::VT + dv * P64 + g * 16) = o; }
            }
        }
        if (KIND == 2) {
            if (tid < 256) {
                const int jj = tid & 31, lq = tid >> 6; const bool isK = (tid >> 5) & 1;
                if (PASS == 3 || isK) {
                    const LAS unsigned char* rp = lds + LY::RAW + ((isK ? 64 : 0) + jj) * 2;
                    LAS unsigned char* nat = lds + (isK ? LY::KN : LY::Q);
                    const float ang = (float)(cg * 64 + lq * 16) * inv;
                    double ad = (double)ang; ad -= 6.283185307179586476925286766559 * rint(ad * 0.15915494309189533576888376337251);
                    const float ar = (float)ad; float cs = __cosf(ar), sn = __sinf(ar);
#pragma unroll
                    for (int g = 0; g < 2; ++g) {
                        const f32x4 u0 = *(const LAS f32x4*)(sc + S_U + lq * 16 + 8 * g), u1 = *(const LAS f32x4*)(sc + S_U + lq * 16 + 8 * g + 4);
                        float k1[8], k2[8];
#pragma unroll
                        for (int e = 0; e < 8; ++e) { const int l = lq * 16 + 8 * g + e;
                            const float x1 = bf2f(*(const LAS bf16*)(rp + l * RP)), x2 = bf2f(*(const LAS bf16*)(rp + l * RP + 64));
                            float o1 = x1 * cs - x2 * sn, o2 = x1 * sn + x2 * cs;
                            const float cn = cs * cd - sn * sd; sn = sn * cd + cs * sd; cs = cn;
                            if (isK) { o1 *= 0.125f; o2 *= 0.125f; }
                            if (PASS == 3) { *(LAS bf16*)(nat + l * PK + jj * 2) = (bf16)f2bf(o1); *(LAS bf16*)(nat + l * PK + (jj + 32) * 2) = (bf16)f2bf(o2); }
                            const float uu = e < 4 ? u0[e & 3] : u1[e & 3]; k1[e] = o1 * uu; k2[e] = o2 * uu; }
                        if (isK) { *(LAS v4u*)(lds + LY::KUT + jj * P64 + lq * 32 + g * 16) = pack8(k1); *(LAS v4u*)(lds + LY::KUT + (jj + 32) * P64 + lq * 32 + g * 16) = pack8(k2); }
                    }
                }
            } else if (tid < 384) {
                const int dv = tid - 256;
#pragma unroll 2
                for (int g = 0; g < 8; ++g) { unsigned r[8];
#pragma unroll
                    for (int e = 0; e < 8; ++e) r[e] = *(const LAS bf16*)(lds + LY::RAW + (8 * g + e) * RP + (128 + dv) * 2);
                    v4u o; o.x = r[0] | (r[1] << 16); o.y = r[2] | (r[3] << 16); o.z = r[4] | (r[5] << 16); o.w = r[6] | (r[7] << 16);
                    *(LAS v4u*)(lds + LY::VT + dv * P64 + g * 16) = o; }
            }
        }
        __syncthreads();
        f32x4 aD[NM], aI[NM];
        if (PASS == 3) {
            { const int ts = w >> 1, tl0 = 2 * (w & 1);
              f32x4 sacc[2] = {(f32x4){0.f, 0.f, 0.f, 0.f}, (f32x4){0.f, 0.f, 0.f, 0.f}};
#pragma unroll
              for (int kb = 0; kb < NKB; ++kb) { const bf16x8 xf = ldf(lds + LY::KN, PK, ts * 16 + c, kb * 32 + q * 8);
#pragma unroll
                  for (int i = 0; i < 2; ++i) { const bf16x8 yf = ldf(lds + LY::Q, PK, (tl0 + i) * 16 + c, kb * 32 + q * 8); sacc[i] = __builtin_amdgcn_mfma_f32_16x16x32_bf16(xf, yf, sacc[i], 0, 0, 0); } }
              const f32x4 cf = *(const LAS f32x4*)(sc + S_COLF + ts * 16 + 4 * q);
              const float ksc = KIND == 1 ? 0.08838834764831845f : 1.0f;
#pragma unroll
              for (int i = 0; i < 2; ++i) { const int l = (tl0 + i) * 16 + c; const float rf = sc[S_ROWF + l];
                  float p[4];
#pragma unroll
                  for (int r = 0; r < 4; ++r) { const int s = ts * 16 + 4 * q + r; const float wgt = (s <= l) ? __expf(rf + cf[r]) * ksc : 0.f; p[r] = sacc[i][r] * wgt; }
                  v2u o; o.x = pk2(p[0], p[1]); o.y = pk2(p[2], p[3]);
                  *(LAS v2u*)(lds + LY::PM + l * P64 + (ts * 16 + 4 * q) * 2) = o;
                  if (KIND == 1) { float ps = (bfround(p[0]) + bfround(p[1])) + (bfround(p[2]) + bfround(p[3])); ps += __shfl_xor(ps, 16); ps += __shfl_xor(ps, 32);
                      if (q == 0) sc[S_ROWSUM + ts * 64 + l] = ps; } } }
#pragma unroll
            for (int a = 0; a < TKW; ++a)
#pragma unroll
                for (int bb = 0; bb < TVW; ++bb) { const int dv = (wv * TVW + bb) * 16 + c, dk0 = (wk * TKW + a) * 16 + 4 * q;
                    v2u o; o.x = pk2(st[a][bb][0], st[a][bb][1]); o.y = pk2(st[a][bb][2], st[a][bb][3]);
                    *(LAS v2u*)(lds + LY::ST + dv * PK + dk0 * 2) = o; }
            if (KIND == 1) { const int l = tid >> 3, part = tid & 7; float a = 0.f;
                const v4u qa = *(const LAS v4u*)(lds + LY::Q + l * PK + part * 32), qb = *(const LAS v4u*)(lds + LY::Q + l * PK + part * 32 + 16);
                const unsigned qw[8] = {qa.x, qa.y, qa.z, qa.w, qb.x, qb.y, qb.z, qb.w};
#pragma unroll
                for (int i = 0; i < 8; ++i) a += pg8::bf_lo(qw[i]) * sc[S_NVEC + part * 16 + 2 * i] + pg8::bf_hi(qw[i]) * sc[S_NVEC + part * 16 + 2 * i + 1];
                a += __shfl_xor(a, 1); a += __shfl_xor(a, 2); a += __shfl_xor(a, 4);
                if (part == 0) sc[S_QN + l] = a; }
            { const int n = w & 3, mh = w >> 2, l = n * 16 + c;
#pragma unroll
              for (int mm = 0; mm < NM; ++mm) { const int dv0 = (mh * NM + mm) * 16 + 4 * q;
                  const int zc = KIND == 0 ? 1024 + head * 64 : (KIND == 1 ? 2048 + head * 128 : 1024 + head * 128);
                  zpf[mm] = *(const v2u*)(P + (row0 + l) * PLD + zc + dv0);
                  if (KIND == 1) opf[mm] = *(const v2u*)(P + (row0 + l) * PLD + 1536 + head * 128 + dv0); } }
            __syncthreads();
            { const int n = w & 3, mh = w >> 2;
#pragma unroll
              for (int mm = 0; mm < NM; ++mm) { aD[mm] = (f32x4){0.f, 0.f, 0.f, 0.f}; aI[mm] = (f32x4){0.f, 0.f, 0.f, 0.f}; }
#pragma unroll
              for (int kb = 0; kb < 2; ++kb) { const bf16x8 yf = ldf(lds + LY::PM, P64, n * 16 + c, kb * 32 + q * 8);
#pragma unroll
                  for (int mm = 0; mm < NM; ++mm) { const bf16x8 xf = ldf(lds + LY::VT, P64, (mh * NM + mm) * 16 + c, kb * 32 + q * 8); aD[mm] = __builtin_amdgcn_mfma_f32_16x16x32_bf16(xf, yf, aD[mm], 0, 0, 0); } }
#pragma unroll
              for (int kb = 0; kb < NKB; ++kb) { const bf16x8 yf = ldf(lds + LY::Q, PK, n * 16 + c, kb * 32 + q * 8);
#pragma unroll
                  for (int mm = 0; mm < NM; ++mm) { const bf16x8 xf = ldf(lds + LY::ST, PK, (mh * NM + mm) * 16 + c, kb * 32 + q * 8); aI[mm] = __builtin_amdgcn_mfma_f32_16x16x32_bf16(xf, yf, aI[mm], 0, 0, 0); } } }
        }
#pragma unroll
        for (int a = 0; a < TKW; ++a)
#pragma unroll
            for (int bb = 0; bb < TVW; ++bb) st[a][bb] *= sdec;
#pragma unroll
        for (int kb = 0; kb < 2; ++kb) { bf16x8 xf[TKW];
#pragma unroll
            for (int a = 0; a < TKW; ++a) xf[a] = ldf(lds + LY::KUT, P64, (wk * TKW + a) * 16 + c, kb * 32 + q * 8);
#pragma unroll
            for (int bb = 0; bb < TVW; ++bb) { const bf16x8 yf = ldf(lds + LY::VT, P64, (wv * TVW + bb) * 16 + c, kb * 32 + q * 8);
#pragma unroll
                for (int a = 0; a < TKW; ++a) st[a][bb] = __builtin_amdgcn_mfma_f32_16x16x32_bf16(xf[a], yf, st[a][bb], 0, 0, 0); } }
        if (PASS == 3) {
            const int n = w & 3, mh = w >> 2, l = n * 16 + c; const float inter = sc[S_INTER + l];
            const size_t grow = row0 + l;
            if (KIND == 0) {
                bf16* Y = (bf16*)(F.ws + WS_Y); float ssq = 0.f;
#pragma unroll
                for (int mm = 0; mm < NM; ++mm) { const int dv0 = (mh * NM + mm) * 16 + 4 * q;
                    const v2u zw = zpf[mm];
                    const float zf[4] = {pg8::bf_lo(zw.x), pg8::bf_hi(zw.x), pg8::bf_lo(zw.y), pg8::bf_hi(zw.y)};
                    float o[4];
#pragma unroll
                    for (int r = 0; r < 4; ++r) { const float xv = bf2f(*(const LAS bf16*)(lds + LY::XT + (dv0 + r) * P64 + l * 2));
                        o[r] = bfround((aD[mm][r] + inter * aI[mm][r] + Dsk * xv) * siluf_(zf[r])); ssq += o[r] * o[r]; }
                    v2u ow; ow.x = pk2(o[0], o[1]); ow.y = pk2(o[2], o[3]);
                    *(v2u*)(Y + grow * 2048 + 512 + head * 64 + dv0) = ow; }
                ssq += __shfl_xor(ssq, 16); ssq += __shfl_xor(ssq, 32);
                const int par = ci & 1;
                if (q == 0) sc[S_RED + par * 128 + mh * 64 + l] = ssq;
                __syncthreads();
                if (mh == 0 && q == 0) ssqB[grow * 8 + head] = sc[S_RED + par * 128 + l] + sc[S_RED + par * 128 + 64 + l];
            } else {
                float dinv = 1.0f;
                if (KIND == 1) { const float den = ((sc[S_ROWSUM + l] + sc[S_ROWSUM + 64 + l]) + (sc[S_ROWSUM + 128 + l] + sc[S_ROWSUM + 192 + l])) + inter * sc[S_QN + l]; dinv = 1.0f / fmaxf(fabsf(den), sc[S_EINV + l]); }
                float hv[NM][4]; float ssq = 0.f;
#pragma unroll
                for (int mm = 0; mm < NM; ++mm) {
                    float og[4] = {1.f, 1.f, 1.f, 1.f};
                    if (KIND == 1) { const v2u ow = opf[mm];
                        og[0] = sigmoidf_(pg8::bf_lo(ow.x)); og[1] = sigmoidf_(pg8::bf_hi(ow.x)); og[2] = sigmoidf_(pg8::bf_lo(ow.y)); og[3] = sigmoidf_(pg8::bf_hi(ow.y)); }
#pragma unroll
                    for (int r = 0; r < 4; ++r) { hv[mm][r] = (aD[mm][r] + inter * aI[mm][r]) * dinv * og[r]; ssq += hv[mm][r] * hv[mm][r]; } }
                ssq += __shfl_xor(ssq, 16); ssq += __shfl_xor(ssq, 32);
                const int par = ci & 1;
                if (q == 0) sc[S_RED + par * 128 + mh * 64 + l] = ssq;
                __syncthreads();
                const float tot = sc[S_RED + par * 128 + l] + sc[S_RED + par * 128 + 64 + l];
                const float rs = 1.0f / sqrtf(tot * (1.f / 128.f) + EPS);
                const float* ng = F.in[KIND == 1 ? I_CNORMG : I_DNORMG] + layer * BRW + head * 128;
                const int ycol = KIND == 1 ? 1024 : 1536;
                bf16* Y = (bf16*)(F.ws + WS_Y);
#pragma unroll
                for (int mm = 0; mm < NM; ++mm) { const int dv0 = (mh * NM + mm) * 16 + 4 * q;
                    const v2u zw = zpf[mm];
                    const f32x4 gv = *(const f32x4*)(ng + dv0);
                    const float o0 = hv[mm][0] * rs * gv[0] * siluf_(pg8::bf_lo(zw.x)), o1 = hv[mm][1] * rs * gv[1] * siluf_(pg8::bf_hi(zw.x));
                    const float o2 = hv[mm][2] * rs * gv[2] * siluf_(pg8::bf_lo(zw.y)), o3 = hv[mm][3] * rs * gv[3] * siluf_(pg8::bf_hi(zw.y));
                    v2u o; o.x = pk2(o0, o1); o.y = pk2(o2, o3);
                    *(v2u*)(Y + grow * 2048 + ycol + head * 128 + dv0) = o; }
            }
        } else {
            __syncthreads();
        }
    }
    if (PASS == 1) {
#pragma unroll
        for (int a = 0; a < TKW; ++a)
#pragma unroll
            for (int bb = 0; bb < TVW; ++bb)
#pragma unroll
                for (int r = 0; r < 4; ++r) stp[(size_t)((a * TVW + bb) * 4 + r) * 512] = st[a][bb][r];
        if (KIND == 1 && tid < 128) nbase[sl * 128 + tid] = nreg;
        if (tid == 0) { scbase[sl * 4 + 0] = asum; scbase[sl * 4 + 1] = mp; }
    }
}
template <int KIND>
__device__ __forceinline__ void scan_part(Frame& F, float* stbase, float* scbase, float* nbase) {
    using C = GC<KIND>; using LY = Lay<KIND>;
    const int total = BATCH * C::NH * LY::NEL + (KIND == 1 ? BATCH * C::NH * 128 : 0);
    for (int idx = F.bid * (NWAVES * 64) + F.tid; idx < total; idx += F.G * NWAVES * 64) {
        const bool isn = idx >= BATCH * C::NH * LY::NEL;
        const int i2 = isn ? idx - BATCH * C::NH * LY::NEL : idx, per = isn ? 128 : LY::NEL;
        const int chain = i2 / per, e = i2 % per;
        float* base = isn ? nbase : stbase;
        float start = 0.f, m = 0.f;
        for (int j = 0; j < LY::NSC; ++j) { const int sl = chain * LY::NSC + j; const float A = scbase[sl * 4];
            float fo, fl;
            if (KIND == 1) { const float ml = scbase[sl * 4 + 1], mnew = fmaxf(A + m, ml); fo = __expf(A + m - mnew); fl = __expf(ml - mnew); if (e == 0 && !isn) scbase[sl * 4 + 2] = m; m = mnew; }
            else { fo = __expf(A); fl = 1.f; }
            const float loc = base[(size_t)sl * per + e]; base[(size_t)sl * per + e] = start; start = fo * start + fl * loc; }
    }
}
}

namespace rg {
using gla::ldf; using gla::pack8; using gla::P64; using gla::bf16x8;
constexpr int NCH = 8, NSC = gla::NCHUNK / NCH, NITEMS = BATCH * 8 * NSC;
constexpr int PLD = 2560, PCOL = 0;
constexpr int L_WA = 0, L_WX = 9216, L_XB = 18432, L_XF = 27648, L_A = L_XF + 16384, L_D = L_A + 17408, L_RU = L_D + 17408, L_RZ = L_RU + 67 * 144, L_YT = L_RZ + 64 * 144, L_END = L_YT + 8192;
static_assert(L_END <= LDS_BYTES - 64 && L_RU % 16 == 0 && L_RZ % 16 == 0 && L_YT % 16 == 0, "LDS");
template <int PASS> __device__ __forceinline__ void raw_piece(int tid, int i, int hb, int& goff, int& loff) {
    const int idx = tid + 512 * i; goff = 0; loff = -1;
    if (idx < 536) { const int r = idx >> 3, c8 = idx & 7; goff = (r - 3) * PLD + hb * 64 + c8 * 8; loff = L_RU + r * 144 + c8 * 16; }
    else if (PASS == 3 && idx < 1048) { const int i2 = idx - 536, r = i2 >> 3, c8 = i2 & 7; goff = r * PLD + 512 + hb * 64 + c8 * 8; loff = L_RZ + r * 144 + c8 * 16; }
}
template <int PASS>
__device__ __forceinline__ void item(Frame& F, int layer, int b, int hb, int j, float* stA) {
    constexpr int NPF = PASS == 3 ? 3 : 2;
    LAS unsigned char* const lds = F.lds;
    const int tid = F.tid, lane = F.lane, w = F.wave, c = lane & 15, q = lane >> 4;
    const bf16* P = (const bf16*)(F.ws + WS_P) + PCOL; bf16* Y = (bf16*)(F.ws + WS_Y);
    float* slot = stA + (size_t)(((b * 8 + hb) * NSC + j) * 128);
    __syncthreads();
    { const float* wa = F.in[I_AGAW] + ((size_t)layer * 8 + hb) * 4096; const float* wx = F.in[I_AGXW] + ((size_t)layer * 8 + hb) * 4096;
      const int jo = tid & 63, i0 = (tid >> 6) * 8; float va[8], vx[8];
#pragma unroll
      for (int e = 0; e < 8; ++e) { va[e] = wa[(i0 + e) * 64 + jo]; vx[e] = wx[(i0 + e) * 64 + jo]; }
      *(LAS v4u*)(lds + L_WA + jo * P64 + i0 * 2) = pack8(va); *(LAS v4u*)(lds + L_WX + jo * P64 + i0 * 2) = pack8(vx); }
    float cw0 = 0.f, cw1 = 0.f, cw2 = 0.f, cw3 = 0.f, cbs = 0.f;
    if (tid < 256) { const int chg = hb * 64 + (tid & 63); const float* cwp = F.in[I_ACW] + (size_t)layer * 4 * BRW + chg;
        cw0 = cwp[0]; cw1 = cwp[BRW]; cw2 = cwp[2 * BRW]; cw3 = cwp[3 * BRW]; cbs = F.in[I_ACB][layer * BRW + chg]; }
    float ba[2], bx[2], sp[2];
#pragma unroll
    for (int i2 = 0; i2 < 2; ++i2) { const int chg = hb * 64 + (2 * (w & 1) + i2) * 16 + c;
        ba[i2] = F.in[I_AGAB][layer * BRW + chg]; bx[i2] = F.in[I_AGXB][layer * BRW + chg]; sp[i2] = softplusf_(-F.in[I_ALAM][layer * BRW + chg]); }
    float hs = 0.f, ap = 1.f;
    if (PASS == 3 && tid < 64) hs = slot[64 + tid];
    v4u pf[NPF];
    { const int cg = j * NCH; const size_t row0 = (size_t)b * SEQ + (size_t)cg * 64;
#pragma unroll
      for (int i = 0; i < NPF; ++i) { int go, lo; raw_piece<PASS>(tid, i, hb, go, lo); pf[i] = (v4u){0u, 0u, 0u, 0u};
          if (lo >= 0 && !(cg == 0 && go < 0)) pf[i] = *(const v4u*)(P + (ptrdiff_t)row0 * PLD + go); } }
    for (int ci = 0; ci < NCH; ++ci) {
        const int cg = j * NCH + ci; const size_t row0 = (size_t)b * SEQ + (size_t)cg * 64;
        int tl = tid; asm volatile("" : "+v"(tl));
#pragma unroll
        for (int i = 0; i < NPF; ++i) { int go, lo; raw_piece<PASS>(tl, i, hb, go, lo);
            if (lo >= 0) { *(LAS v4u*)(lds + lo) = pf[i]; if (ci + 1 < NCH) pf[i] = *(const v4u*)(P + (ptrdiff_t)(row0 + 64) * PLD + go); } }
        __syncthreads();
        if (tid < 256) {
            const int ch = tid & 63, lq = tid >> 6; const LAS unsigned char* rp = lds + L_RU + (lq * 16) * 144 + ch * 2;
            float x3 = bf2f(*(const LAS bf16*)(rp)), x2 = bf2f(*(const LAS bf16*)(rp + 144)), x1 = bf2f(*(const LAS bf16*)(rp + 288));
#pragma unroll
            for (int e = 0; e < 16; ++e) { const float x0 = bf2f(*(const LAS bf16*)(rp + (3 + e) * 144));
                const float xc = cbs + cw3 * x0 + cw2 * x1 + cw1 * x2 + cw0 * x3; x3 = x2; x2 = x1; x1 = x0;
                const int l = lq * 16 + e;
                *(LAS bf16*)(lds + L_XB + l * P64 + ch * 2) = (bf16)f2bf(xc); *(LAS float*)(lds + L_XF + (l * 64 + ch) * 4) = xc; }
        }
        __syncthreads();
        { const int lt = w >> 1, jt0 = 2 * (w & 1);
          f32x4 ra[2] = {(f32x4){0.f, 0.f, 0.f, 0.f}, (f32x4){0.f, 0.f, 0.f, 0.f}}, ia[2] = {(f32x4){0.f, 0.f, 0.f, 0.f}, (f32x4){0.f, 0.f, 0.f, 0.f}};
#pragma unroll
          for (int kb = 0; kb < 2; ++kb) { const bf16x8 xf = ldf(lds + L_XB, P64, lt * 16 + c, kb * 32 + q * 8);
#pragma unroll
              for (int i2 = 0; i2 < 2; ++i2) { const bf16x8 ya = ldf(lds + L_WA, P64, (jt0 + i2) * 16 + c, kb * 32 + q * 8), yx = ldf(lds + L_WX, P64, (jt0 + i2) * 16 + c, kb * 32 + q * 8);
                  ra[i2] = __builtin_amdgcn_mfma_f32_16x16x32_bf16(xf, ya, ra[i2], 0, 0, 0); ia[i2] = __builtin_amdgcn_mfma_f32_16x16x32_bf16(xf, yx, ia[i2], 0, 0, 0); } }
#pragma unroll
          for (int i2 = 0; i2 < 2; ++i2)
#pragma unroll
              for (int r = 0; r < 4; ++r) { const int l = lt * 16 + 4 * q + r, jj = (jt0 + i2) * 16 + c;
                  const float rr = sigmoidf_(ra[i2][r] + ba[i2]), ig = sigmoidf_(ia[i2][r] + bx[i2]);
                  const float la = -8.0f * rr * sp[i2]; const float a = __expf(la);
                  const float dr = sqrtf(neg_expm1_neg(2.0f * la)) * (ig * *(const LAS float*)(lds + L_XF + (l * 64 + jj) * 4));
                  *(LAS float*)(lds + L_A + (l * 68 + jj) * 4) = a; *(LAS float*)(lds + L_D + (l * 68 + jj) * 4) = dr; } }
        __syncthreads();
        if (w == 0) {
            const int ch = lane;
#pragma unroll 8
            for (int l = 0; l < 64; ++l) { const float a = *(const LAS float*)(lds + L_A + (l * 68 + ch) * 4), d = *(const LAS float*)(lds + L_D + (l * 68 + ch) * 4);
                hs = a * hs + d;
                if (PASS == 1) ap *= a;
                else { const float z = bf2f(*(const LAS bf16*)(lds + L_RZ + l * 144 + ch * 2)); *(LAS bf16*)(lds + L_YT + l * 128 + ch * 2) = (bf16)f2bf(hs * siluf_(z)); } }
        }
        if (PASS == 3) {
            __syncthreads();
            const int r = tid >> 3, c8 = tid & 7;
            *(v4u*)(Y + (row0 + r) * 2048 + hb * 64 + c8 * 8) = *(const LAS v4u*)(lds + L_YT + r * 128 + c8 * 16);
        }
    }
    if (PASS == 1 && tid < 64) { slot[tid] = ap; slot[64 + tid] = hs; }
}
__device__ __forceinline__ void scan_part(Frame& F, float* stA) {
    for (int idx = F.bid * (NWAVES * 64) + F.tid; idx < BATCH * BRW; idx += F.G * NWAVES * 64) {
        const int b = idx >> 9, chx = idx & 511, hb = chx >> 6, ch = chx & 63; float start = 0.f;
        for (int j = 0; j < NSC; ++j) { float* s = stA + (size_t)(((b * 8 + hb) * NSC + j) * 128); const float ap = s[ch], hl = s[64 + ch]; s[64 + ch] = start; start = ap * start + hl; }
    }
}
}

__device__ __forceinline__ void phase_final(Frame& F) {
    const int gw = F.bid * NWAVES + F.wave, NGW = F.G * NWAVES;
    const float* ng = F.in[I_FNG];
    f32x4 gv[4];
#pragma unroll
    for (int j = 0; j < 4; ++j) gv[j] = *((const f32x4*)ng + F.lane + 64 * j);
    for (int row = gw; row < T; row += NGW) {
        f32x4* xr = (f32x4*)(F.out + (size_t)row * D) + F.lane;
        f32x4 v[4]; float s = 0.f;
#pragma unroll
        for (int j = 0; j < 4; ++j) { v[j] = xr[64 * j]; s += (v[j].x * v[j].x + v[j].y * v[j].y) + (v[j].z * v[j].z + v[j].w * v[j].w); }
        const float rs = 1.0f / sqrtf(wave_sum(s) * (1.f / D) + EPS);
#pragma unroll
        for (int j = 0; j < 4; ++j) xr[64 * j] = v[j] * rs * gv[j];
    }
}

#ifndef REPMASK
#define REPMASK 0u
#endif
constexpr int NPL = 12;
constexpr int NPH = DEPTH * NPL + 1;

__device__ __forceinline__ void gemm_in_group(Frame& F, int col0, int ncols) {
    pg8::Gemm g{(const pg8::bf16_t*)(F.ws + WS_HN), (const pg8::bf16_t*)(F.ws + WS_W1) + (size_t)col0 * D, T, ncols, D, D, D, 0};
    pg8::StaticOrder S; S.init(T, ncols, F.G, F.bid);
    pg8::EpiBf16S E{(pg8::bf16_t*)(F.ws + WS_P), ncols, 0};
    pg8::gemm_phase<pg8::EpiBf16S, pg8::StaticOrder, true, true>(F.lds, g, S, E, F.tid);
}

template <int KSEL> __global__ void __launch_bounds__(NWAVES * 64, 2) fwd(Args args) {
    extern __shared__ __attribute__((aligned(16))) unsigned char lds[];
    Frame F;
    F.lds = (LAS unsigned char*)lds;
    F.tid = threadIdx.x; F.lane = F.tid & 63; F.wave = __builtin_amdgcn_readfirstlane(F.tid >> 6);
    F.G = gridDim.x; F.bid = blockIdx.x;
    F.in = (InTab)__builtin_amdgcn_kernarg_segment_ptr(); F.out = args.out; F.ws = args.ws;
    volatile LAS unsigned* bst = (volatile LAS unsigned*)(F.lds + LDS_BYTES - 64);
    if (F.tid < 16) bst[F.tid] = 0u;
    __syncthreads();
    XcdBarrier xbar; xbar.bar = (unsigned*)(F.ws + WS_CTL) + 4096; xbar.x = 0; xbar.st = bst;
    if (KSEL < 0) xbar = xcd_barrier_post((unsigned*)(F.ws + WS_CTL) + 4096, bst);

    int rep = 0, first = 1;
    for (int ph = args.ph_lo; ph < args.ph_hi; (REPMASK != 0u && ph < NPL && ((REPMASK >> ph) & 1u) && rep == 0) ? (rep = 1) : (rep = 0, ++ph)) {
        const int was_first = first; first = 0;
        if (KSEL < 0 && !was_first) { if (ph == args.ph_lo + 1 && rep == 0) cooperative_groups::this_grid().sync(); else xcd_barrier(xbar); }
        int layer = ph / NPL; const int k = KSEL >= 0 ? KSEL : ph % NPL;
        if (KSEL < 0) {
            int t_ = threadIdx.x; unsigned char* w_ = args.ws; float* o_ = args.out; InTab i_ = (InTab)__builtin_amdgcn_kernarg_segment_ptr();
            asm volatile("" : "+v"(t_), "+s"(w_), "+s"(o_), "+s"(layer), "+s"(i_));
            F.in = i_; F.tid = t_; F.lane = t_ & 63; F.wave = __builtin_amdgcn_readfirstlane(t_ >> 6); F.ws = w_; F.out = o_;
        }
        if (KSEL == NPL || (KSEL < 0 && ph == NPH - 1)) { phase_final(F); continue; }
        const float* xin = layer == 0 ? F.in[I_X] : F.out;
        float* const stBC = (float*)(F.ws + WS_STBC); float* const stD = (float*)(F.ws + WS_STD); float* const stA = (float*)(F.ws + WS_RGST);
        float* const scB = (float*)(F.ws + WS_SCB); float* const scC = (float*)(F.ws + WS_SCC); float* const scD = (float*)(F.ws + WS_SCD);
        float* const nC = (float*)(F.ws + WS_NC); float* const ssqB = (float*)(F.ws + WS_SSQB);
        switch (k) {
        case 0: phase_prep(F, layer, xin); phase_weights(F, layer); break;
        case 1: gemm_in_group(F, GA0, 2560); break;
        case 2: for (int it = F.bid; it < 1024; it += F.G) {
                if (it < 512) { const int j = it % rg::NSC, hb = (it / rg::NSC) & 7, b = it / (rg::NSC * 8); rg::item<1>(F, layer, b, hb, j, stA); }
                else { const int i2 = it - 512, j = i2 % 16, head = (i2 / 16) & 7, b = i2 / 128; gla::gla_item<0, 1>(F, layer, b, head, j, stBC, scB, nullptr, ssqB); } } break;
        case 3: rg::scan_part(F, stA); gla::scan_part<0>(F, stBC, scB, nullptr); break;
        case 4: for (int it = F.bid; it < 1024; it += F.G) {
                if (it < 512) { const int j = it % rg::NSC, hb = (it / rg::NSC) & 7, b = it / (rg::NSC * 8); rg::item<3>(F, layer, b, hb, j, stA); }
                else { const int i2 = it - 512, j = i2 % 16, head = (i2 / 16) & 7, b = i2 / 128; gla::gla_item<0, 3>(F, layer, b, head, j, stBC, scB, nullptr, ssqB); } } break;
        case 5: gemm_in_group(F, GC0, 4096); break;
        case 6: for (int it = F.bid; it < 512; it += F.G) {
                const int i2 = it & 255, j = i2 % 16, head = (i2 / 16) & 3, b = i2 / 64;
                if (it < 256) gla::gla_item<1, 1>(F, layer, b, head, j, stBC, scC, nC, nullptr); else gla::gla_item<2, 1>(F, layer, b, head, j, stD, scD, nullptr, nullptr); } break;
        case 7: gla::scan_part<1>(F, stBC, scC, nC); gla::scan_part<2>(F, stD, scD, nullptr); break;
        case 8: for (int it = F.bid; it < 512; it += F.G) {
                const int i2 = it & 255, j = i2 % 16, head = (i2 / 16) & 3, b = i2 / 64;
                if (it < 256) gla::gla_item<1, 3>(F, layer, b, head, j, stBC, scC, nC, nullptr); else gla::gla_item<2, 3>(F, layer, b, head, j, stD, scD, nullptr, nullptr); } break;
        case 9: {
            pg8::Gemm g{(const pg8::bf16_t*)(F.ws + WS_HN), (const pg8::bf16_t*)(F.ws + WS_W1) + (size_t)GG0 * D, T, 4096, D, D, D, 0};
            pg8::StaticOrder S; S.init(T, 4096, F.G, F.bid);
            pg8::EpiGates E{(pg8::bf16_t*)(F.ws + WS_P), ssqB};
            pg8::gemm_phase<pg8::EpiGates, pg8::StaticOrder, true, true>(F.lds, g, S, E, F.tid);
        } break;
        case 10: {
            pg8::Gemm g{(const pg8::bf16_t*)(F.ws + WS_Y), (const pg8::bf16_t*)(F.ws + WS_WB), T, D, BRW, 2048, 2048, BRW};
            pg8::SegOrder<4> S; S.init(T, D, F.G, F.bid);
            pg8::EpiHorner E{(const pg8::bf16_t*)(F.ws + WS_P), (pg8::bf16_t*)(F.ws + WS_HN), 1024};
            pg8::gemm_phase<pg8::EpiHorner, pg8::SegOrder<4>, true, true>(F.lds, g, S, E, F.tid);
        } break;
        case 11: {
            pg8::Gemm g{(const pg8::bf16_t*)(F.ws + WS_HN), (const pg8::bf16_t*)(F.ws + WS_WO), T, D, D, D, D, 0};
            pg8::StaticOrder S; S.init(T, D, F.G, F.bid);
            pg8::EpiResid E{xin, F.out, D};
            pg8::gemm_phase<pg8::EpiResid, pg8::StaticOrder, true, true>(F.lds, g, S, E, F.tid);
        } break;
        }
    }
}

extern "C" void kernel_launch(void* const* d_in, const int* in_sizes, int n_in, void* d_out, int out_size, void* d_ws, size_t ws_size, hipStream_t stream) {
    static int grid = 0;
    if (grid == 0) {
        if (n_in != 23 || in_sizes[0] != T * D || out_size != T * D || ws_size < WS_END) { fprintf(stderr, "kernel_launch: unexpected shapes (n_in %d, in0 %d, out %d, ws %zu)\n", n_in, n_in > 0 ? in_sizes[0] : -1, out_size, ws_size); grid = -1; return; }
        int dev = 0, cus = 0, per_cu = 0;
        if (hipGetDevice(&dev) != hipSuccess || hipDeviceGetAttribute(&cus, hipDeviceAttributeMultiprocessorCount, dev) != hipSuccess) { grid = -1; return; }
        if (hipFuncSetAttribute((const void*)fwd<-1>, hipFuncAttributeMaxDynamicSharedMemorySize, LDS_BYTES) != hipSuccess) { fprintf(stderr, "kernel_launch: hipFuncSetAttribute failed\n"); grid = -1; return; }
        if (hipOccupancyMaxActiveBlocksPerMultiprocessor(&per_cu, (const void*)fwd<-1>, NWAVES * 64, LDS_BYTES) != hipSuccess || per_cu < 1) { fprintf(stderr, "kernel_launch: occupancy query says %d blocks per CU\n", per_cu); grid = -1; return; }
        grid = cus;
    }
    if (grid < 0) return;
    Args a{};
    for (int i = 0; i < 23; ++i) a.in[i] = (const float*)d_in[i];
    a.out = (float*)d_out; a.ws = (unsigned char*)d_ws; a.ph_lo = 0; a.ph_hi = NPH;
    if (hipMemsetAsync((char*)d_ws + WS_CTL, 0, CTL_ZERO_BYTES, stream) != hipSuccess) { fprintf(stderr, "kernel_launch: memset failed\n"); return; }
    void* kargs[] = {&a};
    hipError_t e = hipLaunchCooperativeKernel((const void*)fwd<-1>, dim3(grid), dim3(NWAVES * 64), kargs, LDS_BYTES, stream);
    if (e != hipSuccess) fprintf(stderr, "kernel_launch: cooperative launch failed: %s (grid %d)\n", hipGetErrorString(e), grid);
}
```

```cpp
#include <hip/hip_runtime.h>
#include <hip/hip_cooperative_groups.h>
#include <cstdio>
#include <cstdint>

#ifndef WT_STORES
#define WT_STORES 1
#endif
__device__ __forceinline__ void st16_wt(void* p, const unsigned __attribute__((ext_vector_type(4))) v) { asm volatile("global_store_dwordx4 %0, %1, off sc1\n\ts_nop 1" :: "v"(p), "v"(v) : "memory"); }
__device__ __forceinline__ void st8_wt(void* p, const unsigned __attribute__((ext_vector_type(2))) v) { asm volatile("global_store_dwordx2 %0, %1, off sc1\n\ts_nop 1" :: "v"(p), "v"(v) : "memory"); }
__device__ __forceinline__ void st4_wt(void* p, const unsigned v) { asm volatile("global_store_dword %0, %1, off sc1\n\ts_nop 1" :: "v"(p), "v"(v) : "memory"); }
namespace pg8 {
#define PG8_LAS __attribute__((address_space(3)))
typedef unsigned short bf16_t;
typedef short bf16x8 __attribute__((ext_vector_type(8)));
typedef float f32x4 __attribute__((ext_vector_type(4)));
typedef unsigned u32x4 __attribute__((ext_vector_type(4)));
typedef unsigned u32x2 __attribute__((ext_vector_type(2)));
constexpr int BM = 256, BK = 64, HALF = 128, HTB = HALF * BK * 2  , STAGE_BYTES = 8 * HTB, NXCD = 8, WGM = 8;

__host__ __device__ __forceinline__ int lds_byte(int r, int c) { const int st = (r >> 4) * 2 + (c >> 5), rr = r & 15, cc = c & 31, ob = rr * 64 + cc * 2; return st * 1024 + (ob ^ (((ob >> 9) & 1) << 5)); }
__host__ __device__ __forceinline__ void stage_rc(int b, int& R, int& C) { const int st = b / 1024, sb = b % 1024, swz = sb ^ (((sb >> 9) & 1) << 5); R = (st >> 1) * 16 + swz / 64; C = (st & 1) * 32 + (swz % 64) / 2; }
__host__ __device__ __forceinline__ int perm32(int rho) { const int n = rho >> 4, i = rho & 15; return 8 * (i >> 2) + 4 * n + (i & 3); }

struct Unit { int pm, pn, ks; };
struct Gemm { const bf16_t* A; const bf16_t* Bt; int M, N, K, lda, ldb, kseg; };

struct StaticOrder {
    int nM, nN, nwg, G, c;
    __host__ __device__ void init(int M, int N, int G_, int c_) { nM = M / BM; nN = N / BM; nwg = nM * nN; G = G_; c = c_; }
    __host__ __device__ bool next(int i, Unit& u) const {
        const long L = (long)i * G + c; if (L >= nwg) return false;
        int wgid = (int)L; { const int q = nwg / NXCD, r = nwg % NXCD, xcd = wgid % NXCD, off = wgid / NXCD; wgid = (xcd < r ? xcd * (q + 1) : r * (q + 1) + (xcd - r) * q) + off; }
        const int nig = WGM * nN, gid = wgid / nig, fm = gid * WGM, gsz = (nM - fm) < WGM ? (nM - fm) : WGM;
        u.pm = fm + ((wgid % nig) % gsz); u.pn = (wgid % nig) / gsz; u.ks = 0; return true;
    }
    __device__ __forceinline__ void a_ready(const Unit&) const {}
    __device__ __forceinline__ void done(const Unit&) const {}
};


template <int NSEG> struct SegOrder : StaticOrder {
    __host__ __device__ bool next(int i, Unit& u) const { if (!StaticOrder::next(i / NSEG, u)) return false; u.ks = i % NSEG; return true; }
};

__device__ __forceinline__ unsigned cvt_pk_bf16(float lo, float hi) { unsigned r; asm volatile("v_cvt_pk_bf16_f32 %0, %1, %2" : "=v"(r) : "v"(lo), "v"(hi)); return r; }
__device__ __forceinline__ float bf_lo(unsigned w) { return __uint_as_float(w << 16); }
__device__ __forceinline__ float bf_hi(unsigned w) { return __uint_as_float(w & 0xffff0000u); }
__device__ __forceinline__ float sigmoid_f(float x) { return __builtin_amdgcn_rcpf(1.0f + __expf(-x)); }

struct EpiBf16S {
    static constexpr bool PERM = true, AFTER_DRAIN = false, KEEP = false;
    bf16_t* O; int ldc; int sig;
    __device__ __forceinline__ void operator()(const f32x4 (&acc)[2][2][4][2], const Unit& u, int wr, int wc, int fr, int fq) const {
        const int row0 = u.pm * BM + wr * 64 + fr; const int col0 = u.pn * BM + wc * 32 + 8 * fq;
#pragma unroll
        for (int ai = 0; ai < 2; ++ai)
#pragma unroll
            for (int m = 0; m < 4; ++m) { bf16_t* rowp = O + (size_t)(row0 + ai * HALF + m * 16) * ldc + col0;
#pragma unroll
                for (int bj = 0; bj < 2; ++bj) { f32x4 v0 = acc[ai][bj][m][0], v1 = acc[ai][bj][m][1];
                    if (sig) {
#pragma unroll
                        for (int j = 0; j < 4; ++j) { v0[j] = sigmoid_f(v0[j]); v1[j] = sigmoid_f(v1[j]); } }
                    u32x4 w; w.x = cvt_pk_bf16(v0[0], v0[1]); w.y = cvt_pk_bf16(v0[2], v0[3]); w.z = cvt_pk_bf16(v1[0], v1[1]); w.w = cvt_pk_bf16(v1[2], v1[3]);
                    if (WT_STORES) asm volatile("global_store_dwordx4 %0, %1, off sc1\n\ts_nop 1" :: "v"(rowp + bj * HALF), "v"(w) : "memory");
                    else *(u32x4*)(rowp + bj * HALF) = w; } }
    }
};
struct EpiGates {
    static constexpr bool PERM = false, AFTER_DRAIN = false, KEEP = false;
    bf16_t* GR;
    __device__ __forceinline__ void operator()(const f32x4 (&acc)[2][2][4][2], const Unit& u, int wr, int wc, int fr, int fq) const {
        const int row0 = u.pm * BM + wr * 64 + fr, d0 = u.pn * 64 + wc * 16 + 4 * fq;
#pragma unroll
        for (int ai = 0; ai < 2; ++ai)
#pragma unroll
            for (int m = 0; m < 4; ++m) { const size_t row = (size_t)(row0 + ai * HALF + m * 16);
                float r0[4], r1[4], r2[4], r3[4];
#pragma unroll
                for (int e = 0; e < 4; ++e) {
                    const float e0 = 1.0f + __expf(-fmaxf(acc[ai][0][m][0][e], -30.f)), e1 = 1.0f + __expf(-fmaxf(acc[ai][0][m][1][e], -30.f));
                    const float e2 = 1.0f + __expf(-fmaxf(acc[ai][1][m][0][e], -30.f)), e3 = 1.0f + __expf(-fmaxf(acc[ai][1][m][1][e], -30.f));
                    r0[e] = e1 * __builtin_amdgcn_rcpf(e0); r1[e] = e2 * __builtin_amdgcn_rcpf(e1); r2[e] = e3 * __builtin_amdgcn_rcpf(e2); r3[e] = __builtin_amdgcn_rcpf(e3); }
                bf16_t* o = GR + row * 4096 + d0;
                u32x2 w; w.x = cvt_pk_bf16(r0[0], r0[1]); w.y = cvt_pk_bf16(r0[2], r0[3]); *(u32x2*)(o) = w;
                w.x = cvt_pk_bf16(r1[0], r1[1]); w.y = cvt_pk_bf16(r1[2], r1[3]); *(u32x2*)(o + 1024) = w;
                w.x = cvt_pk_bf16(r2[0], r2[1]); w.y = cvt_pk_bf16(r2[2], r2[3]); *(u32x2*)(o + 2048) = w;
                w.x = cvt_pk_bf16(r3[0], r3[1]); w.y = cvt_pk_bf16(r3[2], r3[3]); *(u32x2*)(o + 3072) = w; }
    }
};
struct EpiHorner {
    static constexpr bool PERM = true, AFTER_DRAIN = false, KEEP = true;
    const bf16_t* GR; const float* rsB; bf16_t* Mb; int ldc;
    __device__ __forceinline__ void operator()(f32x4 (&acc)[2][2][4][2], const Unit& u, int wr, int wc, int fr, int fq) const {
        const int row0 = u.pm * BM + wr * 64 + fr, col0 = u.pn * BM + wc * 32 + 8 * fq;
        u32x4 gwa[2][4][2]; float rsa[2][4];
#pragma unroll
        for (int ai = 0; ai < 2; ++ai)
#pragma unroll
            for (int m = 0; m < 4; ++m) { const size_t row = (size_t)(row0 + ai * HALF + m * 16);
                rsa[ai][m] = u.ks < 2 ? rsB[row] : 1.0f;
#pragma unroll
                for (int bj = 0; bj < 2; ++bj) gwa[ai][m][bj] = *(const u32x4*)(GR + row * 4096 + u.ks * 1024 + col0 + bj * HALF); }
#pragma unroll
        for (int ai = 0; ai < 2; ++ai) {
#pragma unroll
            for (int m = 0; m < 4; ++m) { const float sc_ = u.ks == 0 ? __builtin_amdgcn_rcpf(rsa[ai][m]) : rsa[ai][m];
#pragma unroll
                for (int bj = 0; bj < 2; ++bj) { const u32x4 g4 = gwa[ai][m][bj];
                    f32x4 g0, g1; g0[0] = bf_lo(g4.x); g0[1] = bf_hi(g4.x); g0[2] = bf_lo(g4.y); g0[3] = bf_hi(g4.y); g1[0] = bf_lo(g4.z); g1[1] = bf_hi(g4.z); g1[2] = bf_lo(g4.w); g1[3] = bf_hi(g4.w);
                    acc[ai][bj][m][0] *= g0 * sc_; acc[ai][bj][m][1] *= g1 * sc_; } }
            asm volatile("" ::: "memory");
        }
        if (u.ks == 3) {
#pragma unroll
            for (int ai = 0; ai < 2; ++ai)
#pragma unroll
                for (int m = 0; m < 4; ++m) { const size_t row = (size_t)(row0 + ai * HALF + m * 16);
#pragma unroll
                    for (int bj = 0; bj < 2; ++bj) { u32x4 w; w.x = cvt_pk_bf16(acc[ai][bj][m][0][0], acc[ai][bj][m][0][1]); w.y = cvt_pk_bf16(acc[ai][bj][m][0][2], acc[ai][bj][m][0][3]);
                        w.z = cvt_pk_bf16(acc[ai][bj][m][1][0], acc[ai][bj][m][1][1]); w.w = cvt_pk_bf16(acc[ai][bj][m][1][2], acc[ai][bj][m][1][3]);
                        *(u32x4*)(Mb + row * ldc + col0 + bj * HALF) = w; } }
        }
    }
};
struct EpiResid {
    static constexpr bool PERM = false, AFTER_DRAIN = false, KEEP = false;
    const float* xin; float* out; int ldc;
    __device__ __forceinline__ void operator()(const f32x4 (&acc)[2][2][4][2], const Unit& u, int wr, int wc, int fr, int fq) const {
        const int row0 = u.pm * BM + wr * 64 + fr, col0 = u.pn * BM + wc * 32 + 4 * fq;
#pragma unroll
        for (int ai = 0; ai < 2; ++ai) { f32x4 xs[4][2][2];
#pragma unroll
            for (int m = 0; m < 4; ++m) { const size_t off = (size_t)(row0 + ai * HALF + m * 16) * ldc + col0;
#pragma unroll
                for (int bj = 0; bj < 2; ++bj)
#pragma unroll
                    for (int n = 0; n < 2; ++n) xs[m][bj][n] = *(const f32x4*)(xin + off + bj * HALF + n * 16); }
            asm volatile("" ::: "memory");
#pragma unroll
            for (int m = 0; m < 4; ++m) { const size_t off = (size_t)(row0 + ai * HALF + m * 16) * ldc + col0;
#pragma unroll
                for (int bj = 0; bj < 2; ++bj)
#pragma unroll
                    for (int n = 0; n < 2; ++n) *(f32x4*)(out + off + bj * HALF + n * 16) = xs[m][bj][n] + acc[ai][bj][m][n]; }
            asm volatile("" ::: "memory"); }
    }
};

template <class Epi, class Sched, bool ALIGN_EPI = false, bool SP2 = false>
__device__ __forceinline__ void gemm_phase(PG8_LAS unsigned char* lds, const Gemm g, const Sched& S, const Epi& E, const int tid) {
    const int wid = __builtin_amdgcn_readfirstlane(tid >> 6), lane = tid & 63, wr = wid >> 2, wc = wid & 3, fr = lane & 15, fq = lane >> 4;
    const int K = g.K, nt = K / BK;
    unsigned voffA[2], voffB[2];
#pragma unroll
    for (int i = 0; i < 2; ++i) { int R, C; stage_rc(tid * 16 + i * 8192, R, C); const int Rb = Epi::PERM ? ((R & ~31) + perm32(R & 31)) : R;
        voffA[i] = (unsigned)(R * g.lda + C) * 2u; voffB[i] = (unsigned)(Rb * g.ldb + C) * 2u; }
    const size_t kstep = (size_t)(BK * 2);
    const size_t hstepA = (size_t)HALF * g.lda * 2, hstepB = (size_t)HALF * g.ldb * 2;
    const size_t tstepA = 2 * hstepA, tstepB = 2 * hstepB;
    const unsigned ldsw = (unsigned)wid * 1024u;
    const int aoff = lds_byte(wr * 64 + fr, fq * 8), boff = lds_byte(wc * 32 + fr, fq * 8);
#define PG8_SA(b, h) (((b) * 2 + (h)) * HTB)
#define PG8_SB(b, h) ((4 + (b) * 2 + (h)) * HTB)
#define PG8_STAGE(bufoff, gbase, voff) do { _Pragma("unroll") for (int _i = 0; _i < 2; ++_i) \
        __builtin_amdgcn_global_load_lds((const unsigned*)((const char*)(gbase) + (voff)[_i]), (PG8_LAS unsigned*)(lds + (bufoff) + ldsw + _i * 8192), 16, 0, 0); } while (0)
#define PG8_LDA(dst, b, h) do { _Pragma("unroll") for (int m = 0; m < 4; ++m) _Pragma("unroll") for (int k = 0; k < 2; ++k) dst[m][k] = *(const PG8_LAS bf16x8*)(lds + PG8_SA(b, h) + aoff + m * 2048 + k * 1024); } while (0)
#define PG8_LDB(dst, b, h) do { _Pragma("unroll") for (int n = 0; n < 2; ++n) _Pragma("unroll") for (int k = 0; k < 2; ++k) dst[n][k] = *(const PG8_LAS bf16x8*)(lds + PG8_SB(b, h) + boff + n * 2048 + k * 1024); } while (0)
#define PG8_MMA(ai, bj, At, Bt) do { __builtin_amdgcn_s_setprio(1); _Pragma("unroll") for (int m = 0; m < 4; ++m) _Pragma("unroll") for (int n = 0; n < 2; ++n) _Pragma("unroll") for (int k = 0; k < 2; ++k) \
        acc[ai][bj][m][n] = __builtin_amdgcn_mfma_f32_16x16x32_bf16(Bt[n][k], At[m][k], acc[ai][bj][m][n], 0, 0, 0); __builtin_amdgcn_s_setprio(0); } while (0)
#define PG8_WAIT_V(n) asm volatile("s_waitcnt vmcnt(" #n ")" ::: "memory")
#define PG8_WAIT_L(n) asm volatile("s_waitcnt lgkmcnt(" #n ")" ::: "memory")
#define PG8_BAR __builtin_amdgcn_s_barrier()
#define PG8_SCHED __builtin_amdgcn_sched_barrier(0)
    Unit cur, nxt; int ui = 0;
    if (!S.next(0, cur)) return;
    f32x4 acc[2][2][4][2];
#pragma unroll
    for (int a = 0; a < 2; ++a)
#pragma unroll
        for (int b = 0; b < 2; ++b)
#pragma unroll
            for (int m = 0; m < 4; ++m)
#pragma unroll
                for (int n = 0; n < 2; ++n) acc[a][b][m][n] = (f32x4){0.f, 0.f, 0.f, 0.f};
    bf16x8 At[4][2], B0[2][2], B1[2][2];
    const size_t sstep = (size_t)g.kseg * 2;
    const char* cA = (const char*)g.A + (size_t)cur.pm * tstepA + (size_t)cur.ks * sstep; const char* cB = (const char*)g.Bt + (size_t)cur.pn * tstepB + (size_t)cur.ks * sstep;
    S.a_ready(cur);
    if constexpr (SP2) {
        PG8_STAGE(PG8_SB(0, 0), cB, voffB); PG8_STAGE(PG8_SB(0, 1), cB + hstepB, voffB); PG8_STAGE(PG8_SA(0, 0), cA, voffA); PG8_STAGE(PG8_SA(0, 1), cA + hstepA, voffA);
        if (wr == 1) PG8_BAR;
        PG8_WAIT_V(2); PG8_BAR;
        PG8_STAGE(PG8_SB(1, 0), cB + kstep, voffB); PG8_STAGE(PG8_SA(1, 0), cA + kstep, voffA); PG8_STAGE(PG8_SB(1, 1), cB + hstepB + kstep, voffB);
        PG8_WAIT_V(6); PG8_BAR;
    } else {
        PG8_STAGE(PG8_SB(0, 0), cB, voffB); PG8_STAGE(PG8_SA(0, 0), cA, voffA); PG8_STAGE(PG8_SB(0, 1), cB + hstepB, voffB); PG8_STAGE(PG8_SA(0, 1), cA + hstepA, voffA);
        if (wr == 1) PG8_BAR;
        PG8_WAIT_V(4); PG8_BAR;
        PG8_STAGE(PG8_SB(1, 0), cB + kstep, voffB); PG8_STAGE(PG8_SA(1, 0), cA + kstep, voffA); PG8_STAGE(PG8_SB(1, 1), cB + hstepB + kstep, voffB);
        PG8_WAIT_V(6); PG8_BAR;
    }
    for (;;) {
        const bool has_next = S.next(ui + 1, nxt);
        const char* nA = has_next ? (const char*)g.A + (size_t)nxt.pm * tstepA + (size_t)nxt.ks * sstep : cA; const char* nB = has_next ? (const char*)g.Bt + (size_t)nxt.pn * tstepB + (size_t)nxt.ks * sstep : cB;
        for (int t = 0; t < nt; t += 2) {
            const bool last = (t == nt - 2);
            const char* a1 = cA + (size_t)(t + 1) * kstep;
            const char* a2 = last ? nA : cA + (size_t)(t + 2) * kstep; const char* b2 = last ? nB : cB + (size_t)(t + 2) * kstep;
            const char* a3 = a2 + kstep; const char* b3 = b2 + kstep;
            if (last && has_next) S.a_ready(nxt);
            if constexpr (SP2) {
            PG8_LDB(B0, 0, 0); PG8_LDB(B1, 0, 1); PG8_SCHED; PG8_LDA(At, 0, 0); PG8_STAGE(PG8_SA(1, 1), a1 + hstepA, voffA);
            PG8_WAIT_V(8); PG8_WAIT_L(0); PG8_BAR; PG8_MMA(0, 0, At, B0); PG8_MMA(0, 1, At, B1); PG8_BAR; PG8_SCHED;
            PG8_LDA(At, 0, 1); PG8_STAGE(PG8_SB(0, 0), b2, voffB); PG8_STAGE(PG8_SB(0, 1), b2 + hstepB, voffB); PG8_STAGE(PG8_SA(0, 0), a2, voffA);
            PG8_WAIT_V(8); PG8_WAIT_L(0); PG8_BAR; PG8_MMA(1, 0, At, B0); PG8_MMA(1, 1, At, B1); PG8_BAR; PG8_SCHED;
            PG8_LDB(B0, 1, 0); PG8_LDB(B1, 1, 1); PG8_SCHED; PG8_LDA(At, 1, 0); PG8_STAGE(PG8_SA(0, 1), a2 + hstepA, voffA);
            PG8_WAIT_V(8); PG8_WAIT_L(0); PG8_BAR; PG8_MMA(0, 0, At, B0); PG8_MMA(0, 1, At, B1); PG8_BAR; PG8_SCHED;
            PG8_LDA(At, 1, 1); PG8_STAGE(PG8_SB(1, 0), b3, voffB); PG8_STAGE(PG8_SB(1, 1), b3 + hstepB, voffB); PG8_STAGE(PG8_SA(1, 0), a3, voffA);
            PG8_WAIT_V(8); PG8_WAIT_L(0); PG8_BAR; PG8_MMA(1, 0, At, B0); PG8_MMA(1, 1, At, B1); PG8_BAR; PG8_SCHED;
            } else {
            PG8_LDB(B0, 0, 0); PG8_SCHED; PG8_LDA(At, 0, 0); PG8_STAGE(PG8_SA(1, 1), a1 + hstepA, voffA);
            PG8_WAIT_L(8); PG8_BAR; PG8_WAIT_L(0); PG8_MMA(0, 0, At, B0); PG8_BAR; PG8_SCHED;
            PG8_LDB(B1, 0, 1); PG8_STAGE(PG8_SB(0, 0), b2, voffB);
            PG8_BAR; PG8_WAIT_L(0); PG8_MMA(0, 1, At, B1); PG8_BAR;
            PG8_LDA(At, 0, 1); PG8_STAGE(PG8_SA(0, 0), a2, voffA);
            PG8_BAR; PG8_WAIT_L(0); PG8_MMA(1, 0, At, B0); PG8_BAR; PG8_SCHED;
            PG8_STAGE(PG8_SB(0, 1), b2 + hstepB, voffB);
            PG8_WAIT_V(6); PG8_BAR; PG8_MMA(1, 1, At, B1); PG8_BAR;
            PG8_LDB(B0, 1, 0); PG8_SCHED; PG8_LDA(At, 1, 0); PG8_STAGE(PG8_SA(0, 1), a2 + hstepA, voffA);
            PG8_WAIT_L(8); PG8_BAR; PG8_WAIT_L(0); PG8_MMA(0, 0, At, B0); PG8_BAR; PG8_SCHED;
            PG8_LDB(B1, 1, 1); PG8_STAGE(PG8_SB(1, 0), b3, voffB);
            PG8_BAR; PG8_WAIT_L(0); PG8_MMA(0, 1, At, B1); PG8_BAR;
            PG8_LDA(At, 1, 1); PG8_STAGE(PG8_SA(1, 0), a3, voffA);
            PG8_BAR; PG8_WAIT_L(0); PG8_MMA(1, 0, At, B0); PG8_BAR; PG8_SCHED;
            PG8_STAGE(PG8_SB(1, 1), b3 + hstepB, voffB);
            PG8_WAIT_V(6); PG8_BAR; PG8_MMA(1, 1, At, B1); PG8_BAR;
            }
        }
        if constexpr (ALIGN_EPI) { if (wr == 0) PG8_BAR; }
        if constexpr (!Epi::AFTER_DRAIN) { int fr_ = fr, fq_ = fq; asm volatile("" : "+v"(fr_), "+v"(fq_));
            E(acc, cur, wr, wc, fr_, fq_); S.done(cur); }
        if (!has_next) break;
        if (!Epi::KEEP || nxt.ks == 0) {
#pragma unroll
        for (int a = 0; a < 2; ++a)
#pragma unroll
            for (int b = 0; b < 2; ++b)
#pragma unroll
                for (int m = 0; m < 4; ++m)
#pragma unroll
                    for (int n = 0; n < 2; ++n) acc[a][b][m][n] = (f32x4){0.f, 0.f, 0.f, 0.f};
        }
        cur = nxt; cA = nA; cB = nB; ++ui;
        if constexpr (ALIGN_EPI) { if (wr == 1) PG8_BAR; }
    }
    PG8_WAIT_V(0);
    if constexpr (!ALIGN_EPI) { if (wr == 0) PG8_BAR; }
    PG8_BAR;
#undef PG8_SA
#undef PG8_SB
#undef PG8_STAGE
#undef PG8_LDA
#undef PG8_LDB
#undef PG8_MMA
#undef PG8_WAIT_V
#undef PG8_WAIT_L
#undef PG8_BAR
#undef PG8_SCHED
}
}

#ifndef DUPSEL
#define DUPSEL 3
#endif
#ifndef TPHASE
#define TPHASE -1
#endif
#ifndef TSEL
#define TSEL 0
#endif
#ifndef TPASS
#define TPASS 3
#endif
#define TREG_W ((volatile LAS unsigned*)(lds + LDS_BYTES - 64))
#define TREG_BEGIN(id) do { if (TSEL == (id) && PASS == TPASS && tid == 0) TREG_W[6] = (unsigned)__builtin_amdgcn_s_memrealtime(); } while (0)
#define TREG_END(id) do { if (TSEL == (id) && PASS == TPASS && tid == 0) TREG_W[4] += (unsigned)__builtin_amdgcn_s_memrealtime() - TREG_W[6]; } while (0)
constexpr int NWAVES = 8;
constexpr int BATCH = 4, SEQ = 8192, D = 1024, DEPTH = 2, T = BATCH * SEQ;
constexpr int W_IN = 10768, BRW = 512;
constexpr float EPS = 1e-6f;
constexpr int GA0 = 0, GB0 = 1024, GC0 = 2560, GD0 = 5120, GG0 = 6656, NW1 = 10752;
__host__ __device__ __forceinline__ int orig_col(int j) { return j < 2560 ? j : (j < 5120 ? j + 8 : (j < 6656 ? j + 16 : j + 16)); }

constexpr size_t MiB = 1u << 20;
constexpr size_t WS_CTL = 0, CTL_ZERO_BYTES = 1 * MiB;
constexpr size_t WS_SMALL = 1 * MiB;
constexpr size_t WS_SCB = 3 * MiB, WS_SCC = WS_SCB + 16384, WS_SCD = WS_SCB + 32768;
constexpr size_t WS_RGST = WS_SCB + 65536;
constexpr size_t WS_NC = WS_SCB + 512 * 1024;
constexpr size_t WS_SSQB = 4 * MiB;
constexpr size_t WS_RSB = WS_SCB + 768 * 1024;
constexpr size_t WS_STD = 5 * MiB;
constexpr size_t WS_W1 = 16 * MiB;
constexpr size_t WS_WB = 37 * MiB;
constexpr size_t WS_WO = 41 * MiB;
constexpr size_t WS_HN = 48 * MiB;
constexpr size_t WS_Y = 112 * MiB;
constexpr size_t WS_ACT = (240 + 160) * MiB;
constexpr size_t WS_P = 240 * MiB;
constexpr size_t WS_STBC = 496 * MiB;
constexpr size_t WS_END = 512 * MiB;

constexpr int LDS_BYTES = 147456;

#define LAS __attribute__((address_space(3)))
typedef unsigned short bf16;
typedef unsigned v4u __attribute__((ext_vector_type(4)));
typedef unsigned v2u __attribute__((ext_vector_type(2)));
typedef float f32x4 __attribute__((ext_vector_type(4)));
#define LDS_WAIT() asm volatile("s_waitcnt lgkmcnt(0)" ::: "memory")

__device__ __forceinline__ unsigned pk2(float lo, float hi) { unsigned r; asm("v_cvt_pk_bf16_f32 %0, %1, %2" : "=v"(r) : "v"(lo), "v"(hi)); return r; }
__device__ __forceinline__ unsigned f2bf(float f) { return pk2(f, 0.f) & 0xffffu; }
__device__ __forceinline__ float bf2f(bf16 b) { return __uint_as_float(((unsigned)b) << 16); }
__device__ __forceinline__ float sigmoidf_(float x) { return __builtin_amdgcn_rcpf(1.0f + __expf(-x)); }
__device__ __forceinline__ float siluf_(float x) { return x * __builtin_amdgcn_rcpf(1.0f + __expf(-x)); }
__device__ __forceinline__ float log1pexp_neg(float x) {
    const float e = __expf(x); return e < 0.03125f ? e * (1.0f - e * (0.5f - e * (0.33333334f - 0.25f * e))) : __logf(1.0f + e); }
__device__ __forceinline__ float softplusf_(float x) { return fmaxf(x, 0.f) + log1pexp_neg(-fabsf(x)); }
__device__ __forceinline__ float neg_expm1_neg(float x) {
    return x > -0.03125f ? -x * (1.0f + x * (0.5f + x * (0.16666667f + 0.041666668f * x))) : 1.0f - __expf(x); }
__constant__ float ROPE_INV[32] = {1.f, 0.749894261f, 0.562341332f, 0.421696514f, 0.316227764f, 0.237137377f, 0.177827939f, 0.133352131f, 0.100000001f, 0.0749894157f, 0.0562341325f, 0.0421696529f, 0.0316227749f, 0.0237137377f, 0.0177827943f, 0.0133352149f,
    0.00999999978f, 0.00749894185f, 0.00562341325f, 0.00421696482f, 0.00316227763f, 0.00237137359f, 0.00177827943f, 0.00133352145f, 0.00100000005f, 0.000749894243f, 0.000562341302f, 0.000421696517f, 0.000316227757f, 0.00023713737f, 0.00017782794f, 0.00013335215f};
__device__ __forceinline__ float wave_sum(float v) {
#pragma unroll
    for (int o = 1; o < 64; o <<= 1) v += __shfl_xor(v, o);
    return v;
}


#define XB_TMO      128
#define XB_XCNT(j)  (256  + 64 * (j))
#define XB_XSUB(j)  (1280 + 64 * (j))
#define XB_XGEN(j)  (2304 + 64 * (j))
#define XB_TOP      3328
#define XB_TOPGEN   3392
#define XCD_BAR_WORDS 3456
#define XB_SPIN_CAP (1u << 18)
__device__ __forceinline__ unsigned xb_ld(unsigned* p)              { return __hip_atomic_load(p, __ATOMIC_RELAXED, __HIP_MEMORY_SCOPE_AGENT); }
__device__ __forceinline__ unsigned xb_add(unsigned* p, unsigned v) { return __hip_atomic_fetch_add(p, v, __ATOMIC_RELAXED, __HIP_MEMORY_SCOPE_AGENT); }
__device__ __forceinline__ unsigned xb_xcc_id() { return (unsigned)__builtin_amdgcn_s_getreg((3 << 11) | 20) & 0xFu; }
#define XB_SPIN(cond, bar) do { unsigned _sp = 0; while (cond) { __builtin_amdgcn_s_sleep(1); \
    if ((++_sp & 255u) == 0u) { if (xb_ld(&(bar)[XB_TMO])) break; if (_sp > XB_SPIN_CAP) { atomicAdd(&(bar)[XB_TMO], 1u); break; } } } } while (0)
struct XcdBarrier { unsigned* bar; unsigned x; volatile LAS unsigned* st; };
__device__ __forceinline__ XcdBarrier xcd_barrier_post(unsigned* bar, volatile LAS unsigned* st) {
    XcdBarrier b; b.bar = bar; b.x = xb_xcc_id(); b.st = st;
    if (threadIdx.x == 0) (void)xb_add(&bar[XB_XCNT(b.x)], 1u);
    return b;
}
__device__ __forceinline__ void xcd_barrier_complete(unsigned* bar, unsigned x, unsigned& nloc, unsigned& nx) {
    const unsigned G = gridDim.x * gridDim.y * gridDim.z;
    unsigned sum, cnt, mine, sp = 0u;
    for (;;) {
        sum = 0u; cnt = 0u; mine = 0u;
#pragma unroll
        for (unsigned j = 0; j < 16; ++j) { const unsigned c = xb_ld(&bar[XB_XCNT(j)]); sum += c; cnt += (c > 0u) ? 1u : 0u; mine = (j == x) ? c : mine; }
        if (sum == G) break;
        __builtin_amdgcn_s_sleep(1);
        if ((++sp & 255u) == 0u) { if (xb_ld(&bar[XB_TMO])) break; if (sp > XB_SPIN_CAP) { atomicAdd(&bar[XB_TMO], 1u); break; } }
    }
    nloc = mine > 0u ? mine : 1u; nx = cnt > 0u ? cnt : 1u;
}
__device__ __forceinline__ void xcd_barrier(unsigned* bar_, volatile LAS unsigned* st_) {
    XcdBarrier b; b.bar = bar_; b.x = xb_xcc_id(); b.st = st_;
    asm volatile("s_waitcnt vmcnt(0)" ::: "memory");
    __syncthreads();
    if (threadIdx.x == 0) {
        unsigned* bar = b.bar;
        __builtin_amdgcn_s_waitcnt(0);
        unsigned nloc = b.st[0], nx = b.st[1];
        if (nloc == 0u) { xcd_barrier_complete(bar, b.x, nloc, nx); b.st[0] = nloc; b.st[1] = nx; }
        const unsigned old = xb_add(&bar[XB_XSUB(b.x)], 1u);
        const unsigned gen = old / nloc;
        if (old + 1u == (gen + 1u) * nloc) {
            __builtin_amdgcn_fence(__ATOMIC_RELEASE, "agent");
            asm volatile("s_waitcnt vmcnt(0)" ::: "memory");
            const unsigned og = xb_add(&bar[XB_TOP], 1u);
            const unsigned tg = og / nx;
            if (og + 1u == (tg + 1u) * nx) xb_add(&bar[XB_TOPGEN], 1u);
            else XB_SPIN(xb_ld(&bar[XB_TOPGEN]) == tg, bar);
            __builtin_amdgcn_fence(__ATOMIC_ACQUIRE, "agent");
            xb_add(&bar[XB_XGEN(b.x)], 1u);
            asm volatile("s_waitcnt vmcnt(0)" ::: "memory");
        } else {
            XB_SPIN(xb_ld(&bar[XB_XGEN(b.x)]) == gen, bar);
            __builtin_amdgcn_fence(__ATOMIC_ACQUIRE, "agent");
            asm volatile("s_waitcnt vmcnt(0)" ::: "memory");
        }
    }
    __syncthreads();
}

struct Args {
    const float* in[23]; float* out; unsigned char* ws; int ph_lo, ph_hi;
};
typedef const float* cfp_t;
typedef __attribute__((address_space(4))) const cfp_t* InTab;
struct Frame {
    LAS unsigned char* lds;
    int tid, lane, wave, G, bid;
    InTab in; float* out; unsigned char* ws;
};
enum { I_X = 0, I_NORMG, I_WIN, I_ACW, I_ACB, I_AGAW, I_AGAB, I_AGXW, I_AGXB, I_ALAM, I_BCW, I_BCB, I_BDTB, I_BALOG, I_BDSKIP, I_BNORMG, I_CIB, I_CFB, I_CNORMG, I_DNORMG, I_WBR, I_WOUT, I_FNG };

__device__ __forceinline__ void transpose_item(const float* W, int ldw, int c0, int c1, const float* kscale, bf16* WT, int ldo, LAS float* scr, int k0, int lane) {
    const int sc_ = (lane & 31) < 16 ? c0 + (lane & 15) : c1 + (lane & 15);
#pragma unroll
    for (int i = 0; i < 32; ++i) { const int kk = 2 * i + (lane >> 5); float v = W[(size_t)(k0 + kk) * ldw + sc_]; if (kscale) v *= kscale[k0 + kk]; scr[kk * 33 + (lane & 31)] = v; }
    LDS_WAIT(); asm volatile("" ::: "memory");
    const int c = lane & 7;
#pragma unroll
    for (int j = 0; j < 4; ++j) { const int n = (lane >> 3) + 8 * j; const LAS float* sp = scr + (8 * c) * 33 + n;
        v4u o; o.x = pk2(sp[0 * 33], sp[1 * 33]); o.y = pk2(sp[2 * 33], sp[3 * 33]); o.z = pk2(sp[4 * 33], sp[5 * 33]); o.w = pk2(sp[6 * 33], sp[7 * 33]);
        *(v4u*)(WT + (size_t)n * ldo + k0 + 8 * c) = o; }
    LDS_WAIT(); asm volatile("" ::: "memory");
}
__device__ __forceinline__ void phase_weights(Frame& F, int layer) {
    LAS float* scr = (LAS float*)(F.lds + 65536 + F.wave * 8704);
    const int gw = F.bid * NWAVES + F.wave, NGW = F.G * NWAVES;
    const float* win = F.in[I_WIN] + (size_t)layer * D * W_IN;
    const float* wbr = F.in[I_WBR] + (size_t)layer * 4 * BRW * D;
    const float* wout = F.in[I_WOUT] + (size_t)layer * D * D;
    const float* bng = F.in[I_BNORMG] + (size_t)layer * BRW;
    bf16* W1 = (bf16*)(F.ws + WS_W1); bf16* WB = (bf16*)(F.ws + WS_WB); bf16* WO = (bf16*)(F.ws + WS_WO);
    constexpr int I1 = (D / 64) * (NW1 / 32), IB = 4 * (BRW / 64) * (D / 32), IO = (D / 64) * (D / 32);
    for (int it = gw; it < I1 + IB + IO; it += NGW) {
        int r = it;
        if (r < I1) { const int nb = r % (NW1 / 32), kb = r / (NW1 / 32); const int n0 = nb * 32;
            int c0, c1;
            if (n0 < GG0) { c0 = orig_col(n0); c1 = c0 + 16; }
            else {
                const int rel = n0 - GG0, u = rel >> 8, cl = rel & 255, bj = cl >> 7, wcg = (cl >> 5) & 3;
                c0 = 6672 + (2 * bj) * 1024 + 64 * u + 16 * wcg; c1 = c0 + 1024; }
            transpose_item(win, W_IN, c0, c1, nullptr, W1 + (size_t)n0 * D, D, scr, kb * 64, F.lane); continue; }
        r -= I1;
        if (r < IB) { const int n = r / ((BRW / 64) * (D / 32)); const int r2 = r % ((BRW / 64) * (D / 32)); const int nb = r2 % (D / 32), kb = r2 / (D / 32);
            transpose_item(wbr + (size_t)n * BRW * D, D, nb * 32, nb * 32 + 16, n == 1 ? bng : nullptr, WB + (size_t)(nb * 32) * 2048 + n * BRW, 2048, scr, kb * 64, F.lane); continue; }
        r -= IB;
        { const int nb = r % (D / 32), kb = r / (D / 32);
          transpose_item(wout, D, nb * 32, nb * 32 + 16, nullptr, WO + (size_t)(nb * 32) * D, D, scr, kb * 64, F.lane); }
    }
}
__device__ __forceinline__ void phase_prep(Frame& F, int layer, const float* xin, const bf16* delta, float* xout) {
    LAS float* tab = (LAS float*)F.lds;
    const float* win = F.in[I_WIN] + (size_t)layer * D * W_IN;
    const float* ng = F.in[I_NORMG] + (size_t)layer * D;
#pragma unroll
    for (int kk = 0; kk < 2; ++kk) { const int k = F.tid + 512 * kk; const float g = ng[k];
        const f32x4 w0 = *(const f32x4*)(win + (size_t)k * W_IN + 2560), w1 = *(const f32x4*)(win + (size_t)k * W_IN + 2564), w2 = *(const f32x4*)(win + (size_t)k * W_IN + 5128), w3 = *(const f32x4*)(win + (size_t)k * W_IN + 5132);
#pragma unroll
        for (int c = 0; c < 4; ++c) { tab[c * D + k] = w0[c] * g; tab[(4 + c) * D + k] = w1[c] * g; tab[(8 + c) * D + k] = w2[c] * g; tab[(12 + c) * D + k] = w3[c] * g; } }
    __syncthreads();
    bf16* hn = (bf16*)(F.ws + WS_HN); float* small = (float*)(F.ws + WS_SMALL);
    const int gw = F.bid * NWAVES + F.wave, NGW = F.G * NWAVES, lane = F.lane;
    constexpr int RPS = 2;
    f32x4 gv[4];
#pragma unroll
    for (int j = 0; j < 4; ++j) gv[j] = *((const f32x4*)ng + lane + 64 * j);
    for (int r0 = gw * RPS; r0 < T; r0 += NGW * RPS) {
        f32x4 v[RPS][4]; float rs[RPS];
#pragma unroll
        for (int r = 0; r < RPS; ++r)
#pragma unroll
            for (int j = 0; j < 4; ++j) v[r][j] = *((const f32x4*)(xin + (size_t)(r0 + r) * D) + lane + 64 * j);
        if (delta) {
#pragma unroll
            for (int r = 0; r < RPS; ++r)
#pragma unroll
                for (int j = 0; j < 4; ++j) { const v2u dw = *((const v2u*)(delta + (size_t)(r0 + r) * D) + lane + 64 * j);
                    v[r][j].x += pg8::bf_lo(dw.x); v[r][j].y += pg8::bf_hi(dw.x); v[r][j].z += pg8::bf_lo(dw.y); v[r][j].w += pg8::bf_hi(dw.y);
                    *((f32x4*)(xout + (size_t)(r0 + r) * D) + lane + 64 * j) = v[r][j]; }
        }
#pragma unroll
        for (int r = 0; r < RPS; ++r) { float s_ = 0.f;
#pragma unroll
            for (int j = 0; j < 4; ++j) s_ += (v[r][j].x * v[r][j].x + v[r][j].y * v[r][j].y) + (v[r][j].z * v[r][j].z + v[r][j].w * v[r][j].w);
            rs[r] = 1.0f / sqrtf(wave_sum(s_) * (1.f / D) + EPS);
            unsigned long long* o8 = (unsigned long long*)(hn + (size_t)(r0 + r) * D) + lane;
#pragma unroll
            for (int j = 0; j < 4; ++j) { const f32x4 h = v[r][j] * rs[r] * gv[j];
                o8[64 * j] = (unsigned long long)pk2(h.x, h.y) | ((unsigned long long)pk2(h.z, h.w) << 32); } }
#pragma unroll
        for (int h = 0; h < 2; ++h) {
            float a[RPS][8];
#pragma unroll
            for (int c = 0; c < 8; ++c) {
#pragma unroll
                for (int r = 0; r < RPS; ++r) a[r][c] = 0.f;
#pragma unroll
                for (int j = 0; j < 4; ++j) { const f32x4 w = *((const LAS f32x4*)(tab + (8 * h + c) * D) + lane + 64 * j);
#pragma unroll
                    for (int r = 0; r < RPS; ++r) a[r][c] += (v[r][j].x * w.x + v[r][j].y * w.y) + (v[r][j].z * w.z + v[r][j].w * w.w); }
                if ((c & 1) == 1) asm volatile("" ::: "memory"); }
#pragma unroll
            for (int r = 0; r < RPS; ++r) {
#pragma unroll
                for (int i = 0; i < 4; ++i) { const bool hi = (lane & 32) != 0; const float keep = hi ? a[r][i + 4] : a[r][i], send = hi ? a[r][i] : a[r][i + 4]; a[r][i] = keep + __shfl_xor(send, 32); }
#pragma unroll
                for (int i = 0; i < 2; ++i) { const bool hi = (lane & 16) != 0; const float keep = hi ? a[r][i + 2] : a[r][i], send = hi ? a[r][i] : a[r][i + 2]; a[r][i] = keep + __shfl_xor(send, 16); }
                { const bool hi = (lane & 8) != 0; const float keep = hi ? a[r][1] : a[r][0], send = hi ? a[r][0] : a[r][1]; a[r][0] = keep + __shfl_xor(send, 8); }
                a[r][0] += __shfl_xor(a[r][0], 4); a[r][0] += __shfl_xor(a[r][0], 2); a[r][0] += __shfl_xor(a[r][0], 1);
                if ((lane & 7) == 0) small[(size_t)(r0 + r) * 16 + 8 * h + (((lane >> 5) & 1) * 4 + ((lane >> 4) & 1) * 2 + ((lane >> 3) & 1))] = a[r][0] * rs[r];
            }
        }
    }
    __syncthreads();
}

namespace gla {
typedef short bf16x8 __attribute__((ext_vector_type(8)));
constexpr int P64 = 144;
constexpr int NCHUNK = SEQ / 64;
template <int KIND> struct GC;
template <> struct GC<0> { static constexpr int DK = 128, DV = 64,  PLD = 2560, PCOL = 1024, SLD = 1024, NH = 8, NCH = 8; };
template <> struct GC<1> { static constexpr int DK = 128, DV = 128, PLD = 4096, PCOL = 0, SLD = 4096, NH = 4, NCH = 8; };
template <> struct GC<2> { static constexpr int DK = 64,  DV = 128, PLD = 4096, PCOL = 2560, SLD = 4096, NH = 4, NCH = 8; };
template <int KIND> struct Lay {
    using C = GC<KIND>;
    static constexpr int PK = C::DK * 2 + 16;
    static constexpr int RP = KIND == 0 ? 144 : (KIND == 1 ? 272 : 528), RAWB = 64 * RP;
    static constexpr int Q = 0, KN = Q + 64 * PK, KUT = KN + 64 * PK, VT = KUT + C::DK * P64, XT = VT + C::DV * P64,
        PM = XT + (KIND == 0 ? C::DV * P64 : 0), ST = PM + 64 * P64, RAW = PM,
        SC = PM + ((64 * P64 + C::DV * PK) > RAWB ? (64 * P64 + C::DV * PK) : RAWB), END = SC + 8192;
    template <int PASS> static constexpr int npf() { return KIND == 0 ? (PASS == 3 ? 5 : 3) : (KIND == 1 ? (PASS == 3 ? 6 : 4) : (PASS == 3 ? 4 : 3)); }
    static constexpr int NTK = C::DK / 16, NTV = C::DV / 16, NKB = C::DK / 32, TKW = 2, TVW = NTK * NTV / 16, NWV = NTV / TVW;
    static constexpr int NREG = TKW * TVW * 4, NREGX = NREG, NEL = NREGX * 512;
    static constexpr int NSC = NCHUNK / C::NCH, NITEMS = BATCH * C::NH * NSC;
    static_assert(END <= LDS_BYTES - 64, "LDS");
    static_assert(64 * (KIND == 0 ? 40 : (KIND == 1 ? 48 : 32)) == 512 * npf<3>() && 64 * (KIND == 0 ? 24 : (KIND == 1 ? 32 : 24)) == 512 * npf<1>(), "every thread owns exactly npf pieces");
};
enum { S_ROWF = 0, S_COLF = 64, S_INTER = 128, S_U = 192, S_DT = 256, S_EINV = 320, S_QN = 448, S_RED = 512, S_NVEC = 768, S_MISC = 896, S_ROWSUM = 1024  , S_G = 1280  , S_NACC = 1408   };

__device__ __forceinline__ bf16x8 ldf(LAS const unsigned char* base, int pitch, int row, int kel) { return *(LAS const bf16x8*)(base + row * pitch + kel * 2); }
__device__ __forceinline__ v4u pack8(const float (&v)[8]) { v4u o; o.x = pk2(v[0], v[1]); o.y = pk2(v[2], v[3]); o.z = pk2(v[4], v[5]); o.w = pk2(v[6], v[7]); return o; }
__device__ __forceinline__ float bfround(float f) { return __uint_as_float(f2bf(f) << 16); }


template <int CTRL, int RMASK> __device__ __forceinline__ float dpp_f(float ident, float v) { return __uint_as_float(__builtin_amdgcn_update_dpp(__float_as_uint(ident), __float_as_uint(v), CTRL, RMASK, 0xf, false)); }
#define DPP_SCAN(v, OP, IDENT) do { \
    v = OP(v, dpp_f<0x111, 0xf>(IDENT, v)); v = OP(v, dpp_f<0x112, 0xf>(IDENT, v)); v = OP(v, dpp_f<0x114, 0xf>(IDENT, v)); v = OP(v, dpp_f<0x118, 0xf>(IDENT, v)); \
    v = OP(v, dpp_f<0x142, 0xa>(IDENT, v)); v = OP(v, dpp_f<0x143, 0xc>(IDENT, v)); } while (0)
__device__ __forceinline__ float op_add(float a, float b) { return a + b; }
__device__ __forceinline__ float op_max(float a, float b) { return fmaxf(a, b); }

template <int KIND, int PASS>
__device__ __forceinline__ void raw_piece(int tid, int i, int head, int& goff, int& loff) {
    using C = GC<KIND>; using LY = Lay<KIND>;
    constexpr int PK = LY::PK, RP = LY::RP, SLD = C::SLD;
    if (KIND == 0) {
        const int seg = PASS == 3 ? (i >> 1) : 1 + ((i + 0) >> 1), g = head >> 2;
        if (seg < 2) { const int idx = tid + 512 * (i & 1), r = idx >> 4, c8 = idx & 15;
            goff = r * SLD + (seg == 0 ? 768 : 512) + g * 128 + c8 * 8; loff = (seg == 0 ? LY::Q : LY::KN) + r * PK + c8 * 16; }
        else { const int r = tid >> 3, c8 = tid & 7; goff = r * SLD + head * 64 + c8 * 8; loff = LY::RAW + r * RP + c8 * 16; } }
    if (KIND == 1) {
        const int seg = (PASS == 3 ? 0 : 1) + (i >> 1); const int idx = tid + 512 * (i & 1), r = idx >> 4, c8 = idx & 15;
        goff = r * SLD + seg * 512 + head * 128 + c8 * 8;
        loff = seg == 0 ? LY::Q + r * PK + c8 * 16 : (seg == 1 ? LY::KN + r * PK + c8 * 16 : LY::RAW + r * RP + c8 * 16); }
    if (KIND == 2) {
        const int ii = PASS == 3 ? i : i + 1;
        if (ii < 2) { const int r = tid >> 3, c8 = tid & 7; goff = r * SLD + (ii == 0 ? 0 : 256) + head * 64 + c8 * 8; loff = LY::RAW + r * RP + (ii * 8 + c8) * 16; }
        else { const int idx = tid + 512 * (ii & 1), r = idx >> 4, c8 = idx & 15; goff = r * SLD + 512 + head * 128 + c8 * 8; loff = LY::RAW + r * RP + (16 + c8) * 16; } }
}
#define GLA_LOAD_ZO(ROW0) do { const int n_ = w & 3, mh_ = w >> 2, l_ = n_ * 16 + c; \
        _Pragma("unroll") for (int mm = 0; mm < NM; ++mm) { const int dv0_ = (mh_ * NM + mm) * 16 + 4 * q; \
            const int zc_ = KIND == 0 ? 1024 + head * 64 : (KIND == 1 ? 2048 + head * 128 : 1024 + head * 128); \
            zpf[mm] = *(const v2u*)(P + ((ROW0) + l_) * PLD + zc_ + dv0_); \
            if (KIND == 1) opf[mm] = *(const v2u*)(P + ((ROW0) + l_) * PLD + 1536 + head * 128 + dv0_); } } while (0)
template <int KIND, int PASS>
__device__ __forceinline__ void gla_item(Frame& F, int layer, int b, int head, int j, float* stbase, float* scbase, float* nbase, float* ssqB) {
    using C = GC<KIND>; using LY = Lay<KIND>;
    constexpr int DK = C::DK, DV = C::DV, PK = LY::PK, PLD = C::PLD, NKB = LY::NKB, TKW = LY::TKW, TVW = LY::TVW, NWV = LY::NWV, NM = LY::NTV / 2, NREG = LY::NREG;
    constexpr int RP = LY::RP, NPF = LY::template npf<PASS>();
    LAS unsigned char* const lds = F.lds;
    LAS float* const sc = (LAS float*)(lds + LY::SC);
    const int tid = F.tid, lane = F.lane, w = F.wave, c = lane & 15, q = lane >> 4;
    const int wk = w / NWV, wv = w % NWV;
    const bf16* P = (const bf16*)(F.ws + WS_P) + C::PCOL;
    const bf16* PS = KIND == 0 ? (const bf16*)(F.ws + WS_ACT) : P;
    constexpr int SLD = C::SLD;
    const float* small = (const float*)(F.ws + WS_SMALL);
    const int chain = b * C::NH + head, sl = chain * LY::NSC + j;
    TREG_BEGIN(1);
    __syncthreads();
    float* const stp = stbase + (size_t)sl * LY::NEL + tid;
    f32x4 st[TKW][TVW];
    float nreg = 0.f, mp = 0.f, asum = 0.f;
    if (PASS == 3) {
#pragma unroll
        for (int a = 0; a < TKW; ++a)
#pragma unroll
            for (int bb = 0; bb < TVW; ++bb)
#pragma unroll
                for (int r = 0; r < 4; ++r) st[a][bb][r] = stp[(size_t)((a * TVW + bb) * 4 + r) * 512];
        if (KIND == 1) { if (tid < 128) nreg = nbase[sl * 128 + tid]; mp = scbase[sl * 4 + 2]; }
    } else {
#pragma unroll
        for (int a = 0; a < TKW; ++a)
#pragma unroll
            for (int bb = 0; bb < TVW; ++bb) st[a][bb] = (f32x4){0.f, 0.f, 0.f, 0.f};
        if (KIND == 1) mp = -1e30f;
    }
    float dtb = 0.f, Aneg = 0.f, Dsk = 0.f, ib = 0.f, fb = 0.f, logg = 0.f, inv = 0.f, cd = 1.f, sd = 0.f;
    if (KIND == 0) {
        dtb = F.in[I_BDTB][layer * 8 + head]; Aneg = -__expf(F.in[I_BALOG][layer * 8 + head]); Dsk = F.in[I_BDSKIP][layer * 8 + head];
    }
    if (KIND == 1) { ib = F.in[I_CIB][layer * 4 + head]; fb = F.in[I_CFB][layer * 4 + head]; }
    if (PASS == 3 && KIND != 0 && tid < 128) sc[S_G + tid] = F.in[KIND == 1 ? I_CNORMG : I_DNORMG][layer * BRW + head * 128 + tid];
    if (KIND == 2) { logg = head == 0 ? -0.0317486983f : (head == 1 ? -0.0157483570f : (head == 2 ? -0.00784317746f : -0.00391389932f));
        inv = ROPE_INV[tid & 31]; cd = __cosf(inv); sd = __sinf(inv); }
    v4u pf[NPF];
    float spf0 = 0.f, spf1 = 0.f;
    {
        const int cg = j * C::NCH; const size_t row0 = (size_t)b * SEQ + (size_t)cg * 64;
        if (w == 0) { if (KIND == 0) spf0 = small[(row0 + lane) * 16 + head]; if (KIND == 1) { spf0 = small[(row0 + lane) * 16 + 8 + head]; spf1 = small[(row0 + lane) * 16 + 12 + head]; } }
#pragma unroll
        for (int i = 0; i < NPF; ++i) { int go, lo; raw_piece<KIND, PASS>(tid, i, head, go, lo); pf[i] = *(const v4u*)(PS + (ptrdiff_t)row0 * SLD + go); }
    }

    v2u zpf[NM], opf[NM];
    if (PASS == 3) { const size_t r0_ = (size_t)b * SEQ + (size_t)(j * C::NCH) * 64; GLA_LOAD_ZO(r0_); }

    TREG_END(1);
    for (int ci = 0; ci < C::NCH; ++ci) {
        const int cg = j * C::NCH + ci; const size_t row0 = (size_t)b * SEQ + (size_t)cg * 64;
        TREG_BEGIN(2);
        int tl = tid; asm volatile("" : "+v"(tl));
#pragma unroll
        for (int i = 0; i < NPF; ++i) { int go, lo; raw_piece<KIND, PASS>(tl, i, head, go, lo); *(LAS v4u*)(lds + lo) = pf[i]; }
        const float cur0 = spf0, cur1 = spf1;
        if (ci + 1 < C::NCH) {
            if (w == 0) { if (KIND == 0) spf0 = small[(row0 + 64 + lane) * 16 + head]; if (KIND == 1) { spf0 = small[(row0 + 64 + lane) * 16 + 8 + head]; spf1 = small[(row0 + 64 + lane) * 16 + 12 + head]; } }
#pragma unroll
            for (int i = 0; i < NPF; ++i) { int go, lo; raw_piece<KIND, PASS>(tl, i, head, go, lo); pf[i] = *(const v4u*)(PS + (ptrdiff_t)(row0 + 64) * SLD + go); } }
        if (w == 0) {
            float a = 0.f, li = 0.f, dtv = 0.f;
            if (KIND == 0) { dtv = softplusf_(cur0 + dtb); a = Aneg * dtv; }
            if (KIND == 1) { li = cur0 + ib; a = -softplusf_(-(cur1 + fb)); }
            if (KIND == 2) a = logg;
            float acs = a; DPP_SCAN(acs, op_add, 0.f);
            const float a63 = __uint_as_float(__builtin_amdgcn_readlane(__float_as_uint(acs), 63));
            float mrow = 0.f, mn = 0.f;
            if (KIND == 1) { float cm = li - acs; DPP_SCAN(cm, op_max, -3.0e38f);
                mrow = acs + fmaxf(mp, cm); mn = __uint_as_float(__builtin_amdgcn_readlane(__float_as_uint(mrow), 63)); }
            sc[S_ROWF + lane] = acs - mrow; sc[S_COLF + lane] = li - acs;
            sc[S_INTER + lane] = __expf(acs + mp - mrow);
            sc[S_U + lane] = __expf(a63 - acs + li - mn);
            if (KIND == 0) sc[S_DT + lane] = dtv;
            if (KIND == 1) sc[S_EINV + lane] = __expf(-mrow);
            if (lane == 0) sc[S_MISC] = __expf(a63 + mp - mn);
            if (KIND == 1) mp = mn;
            asum += a63;
        }
        __syncthreads();
        TREG_END(2); TREG_BEGIN(3);
        const float sdec = sc[S_MISC];
        if (KIND == 0 || KIND == 1) {
            {
                const int dk = tid & 127, rq = tid >> 7; float nsum = 0.f;
                if (KIND == 1 && PASS == 3 && tid < 128) sc[S_NVEC + tid] = nreg;
#pragma unroll 1
                for (int g = 0; g < 2; ++g) {
                    const f32x4 u0 = *(const LAS f32x4*)(sc + S_U + rq * 16 + 8 * g), u1 = *(const LAS f32x4*)(sc + S_U + rq * 16 + 8 * g + 4);
                    float ku[8];
#pragma unroll
                    for (int e = 0; e < 8; ++e) { const float kf = bf2f(*(const LAS bf16*)(lds + LY::KN + (rq * 16 + 8 * g + e) * PK + dk * 2)) * (KIND == 1 ? 0.08838834764831845f : 1.0f);
                        ku[e] = kf * (e < 4 ? u0[e & 3] : u1[e & 3]); nsum += ku[e]; }
                    *(LAS v4u*)(lds + LY::KUT + dk * P64 + rq * 32 + g * 16) = pack8(ku);
                }
                if (KIND == 1) sc[S_NACC + rq * 128 + dk] = nsum;
            }
            if (KIND == 0) { if (tid < 256) {
                const int dv = tid & 63, rq = tid >> 6;
#pragma unroll 1
                for (int g = 0; g < 2; ++g) {
                    const f32x4 u0 = *(const LAS f32x4*)(sc + S_DT + rq * 16 + 8 * g), u1 = *(const LAS f32x4*)(sc + S_DT + rq * 16 + 8 * g + 4);
                    float va[8], vb[8];
#pragma unroll
                    for (int e = 0; e < 8; ++e) { va[e] = bf2f(*(const LAS bf16*)(lds + LY::RAW + (rq * 16 + 8 * g + e) * RP + dv * 2)); vb[e] = va[e] * (e < 4 ? u0[e & 3] : u1[e & 3]); }
                    *(LAS v4u*)(lds + LY::VT + dv * P64 + rq * 32 + g * 16) = pack8(vb);
                    if (PASS == 3) *(LAS v4u*)(lds + LY::XT + dv * P64 + rq * 32 + g * 16) = pack8(va);
                } } }
            else {
                const int dv = tid & 127, rq = tid >> 7;
#pragma unroll 1
                for (int g = 0; g < 2; ++g) { unsigned r[8];
#pragma unroll
                    for (int e = 0; e < 8; ++e) r[e] = *(const LAS bf16*)(lds + LY::RAW + (rq * 16 + 8 * g + e) * RP + dv * 2);
                    v4u o; o.x = r[0] | (r[1] << 16); o.y = r[2] | (r[3] << 16); o.z = r[4] | (r[5] << 16); o.w = r[6] | (r[7] << 16);
                    *(LAS v4u*)(lds + LY::VT + dv * P64 + rq * 32 + g * 16) = o; }
            }
        }
        if (KIND == 2) {
            if (tid < 256) {
                const int jj = tid & 31, lq = tid >> 6; const bool isK = (tid >> 5) & 1;
                if (PASS == 3 || isK) {
                    const LAS unsigned char* rp = lds + LY::RAW + ((isK ? 64 : 0) + jj) * 2;
                    LAS unsigned char* nat = lds + (isK ? LY::KN : LY::Q);
                    const float ang = (float)(cg * 64 + lq * 16) * inv;
                    double ad = (double)ang; ad -= 6.283185307179586476925286766559 * rint(ad * 0.15915494309189533576888376337251);
                    const float ar = (float)ad; float cs = __cosf(ar), sn = __sinf(ar);
#pragma unroll
                    for (int g = 0; g < 2; ++g) {
                        const f32x4 u0 = *(const LAS f32x4*)(sc + S_U + lq * 16 + 8 * g), u1 = *(const LAS f32x4*)(sc + S_U + lq * 16 + 8 * g + 4);
                        float k1[8], k2[8];
#pragma unroll
                        for (int e = 0; e < 8; ++e) { const int l = lq * 16 + 8 * g + e;
                            const float x1 = bf2f(*(const LAS bf16*)(rp + l * RP)), x2 = bf2f(*(const LAS bf16*)(rp + l * RP + 64));
                            float o1 = x1 * cs - x2 * sn, o2 = x1 * sn + x2 * cs;
                            const float cn = cs * cd - sn * sd; sn = sn * cd + cs * sd; cs = cn;
                            if (isK) { o1 *= 0.125f; o2 *= 0.125f; }
                            if (PASS == 3) { *(LAS bf16*)(nat + l * PK + jj * 2) = (bf16)f2bf(o1); *(LAS bf16*)(nat + l * PK + (jj + 32) * 2) = (bf16)f2bf(o2); }
                            const float uu = e < 4 ? u0[e & 3] : u1[e & 3]; k1[e] = o1 * uu; k2[e] = o2 * uu; }
                        if (isK) { *(LAS v4u*)(lds + LY::KUT + jj * P64 + lq * 32 + g * 16) = pack8(k1); *(LAS v4u*)(lds + LY::KUT + (jj + 32) * P64 + lq * 32 + g * 16) = pack8(k2); }
                    }
                }
            }
            {
                const int dv = tid & 127, rq = tid >> 7;
#pragma unroll
                for (int g = 0; g < 2; ++g) { unsigned r[8];
#pragma unroll
                    for (int e = 0; e < 8; ++e) r[e] = *(const LAS bf16*)(lds + LY::RAW + (rq * 16 + 8 * g + e) * RP + (128 + dv) * 2);
                    v4u o; o.x = r[0] | (r[1] << 16); o.y = r[2] | (r[3] << 16); o.z = r[4] | (r[5] << 16); o.w = r[6] | (r[7] << 16);
                    *(LAS v4u*)(lds + LY::VT + dv * P64 + rq * 32 + g * 16) = o; }
            }
        }
        __syncthreads();
        TREG_END(3); TREG_BEGIN(4);
        if (KIND == 1 && tid < 128) nreg = sdec * nreg + ((sc[S_NACC + tid] + sc[S_NACC + 128 + tid]) + (sc[S_NACC + 256 + tid] + sc[S_NACC + 384 + tid]));
        f32x4 aD[NM], aI[NM];
        if (PASS == 3) {
            { const int ts = w >> 1, tl0 = 2 * (w & 1);
              f32x4 sacc[2] = {(f32x4){0.f, 0.f, 0.f, 0.f}, (f32x4){0.f, 0.f, 0.f, 0.f}};
#pragma unroll
              for (int kb = 0; kb < NKB; ++kb) { const bf16x8 xf = ldf(lds + LY::KN, PK, ts * 16 + c, kb * 32 + q * 8);
#pragma unroll
                  for (int i = 0; i < 2; ++i) { const bf16x8 yf = ldf(lds + LY::Q, PK, (tl0 + i) * 16 + c, kb * 32 + q * 8); sacc[i] = __builtin_amdgcn_mfma_f32_16x16x32_bf16(xf, yf, sacc[i], 0, 0, 0); } }
              const f32x4 cf = *(const LAS f32x4*)(sc + S_COLF + ts * 16 + 4 * q);
              const float ksc = KIND == 1 ? 0.08838834764831845f : 1.0f;
#pragma unroll
              for (int i = 0; i < 2; ++i) { const int l = (tl0 + i) * 16 + c; const float rf = sc[S_ROWF + l];
                  float p[4];
#pragma unroll
                  for (int r = 0; r < 4; ++r) { const int s = ts * 16 + 4 * q + r; const float wgt = (s <= l) ? __expf(rf + cf[r]) * ksc : 0.f; p[r] = sacc[i][r] * wgt; }
                  v2u o; o.x = pk2(p[0], p[1]); o.y = pk2(p[2], p[3]);
                  *(LAS v2u*)(lds + LY::PM + l * P64 + (ts * 16 + 4 * q) * 2) = o;
                  if (KIND == 1) { float ps = (bfround(p[0]) + bfround(p[1])) + (bfround(p[2]) + bfround(p[3])); ps += __shfl_xor(ps, 16); ps += __shfl_xor(ps, 32);
                      if (q == 0) sc[S_ROWSUM + ts * 64 + l] = ps; } } }
#pragma unroll
            for (int a = 0; a < TKW; ++a)
#pragma unroll
                for (int bb = 0; bb < TVW; ++bb) { const int dv = (wv * TVW + bb) * 16 + c, dk0 = (wk * TKW + a) * 16 + 4 * q;
                    v2u o; o.x = pk2(st[a][bb][0], st[a][bb][1]); o.y = pk2(st[a][bb][2], st[a][bb][3]);
                    *(LAS v2u*)(lds + LY::ST + dv * PK + dk0 * 2) = o; }
            if (KIND == 1) { const int l = tid >> 3, part = tid & 7; float a = 0.f;
                const v4u qa = *(const LAS v4u*)(lds + LY::Q + l * PK + part * 32), qb = *(const LAS v4u*)(lds + LY::Q + l * PK + part * 32 + 16);
                const unsigned qw[8] = {qa.x, qa.y, qa.z, qa.w, qb.x, qb.y, qb.z, qb.w};
#pragma unroll
                for (int i = 0; i < 8; ++i) a += pg8::bf_lo(qw[i]) * sc[S_NVEC + part * 16 + 2 * i] + pg8::bf_hi(qw[i]) * sc[S_NVEC + part * 16 + 2 * i + 1];
                a += __shfl_xor(a, 1); a += __shfl_xor(a, 2); a += __shfl_xor(a, 4);
                if (part == 0) sc[S_QN + l] = a; }
            __syncthreads();
            TREG_END(4); TREG_BEGIN(5);
            { const int n = w & 3, mh = w >> 2;
#pragma unroll
              for (int mm = 0; mm < NM; ++mm) { aD[mm] = (f32x4){0.f, 0.f, 0.f, 0.f}; aI[mm] = (f32x4){0.f, 0.f, 0.f, 0.f}; }
#pragma unroll
              for (int kb = 0; kb < 2; ++kb) { const bf16x8 yf = ldf(lds + LY::PM, P64, n * 16 + c, kb * 32 + q * 8);
#pragma unroll
                  for (int mm = 0; mm < NM; ++mm) { const bf16x8 xf = ldf(lds + LY::VT, P64, (mh * NM + mm) * 16 + c, kb * 32 + q * 8); aD[mm] = __builtin_amdgcn_mfma_f32_16x16x32_bf16(xf, yf, aD[mm], 0, 0, 0); } }
#pragma unroll
              for (int kb = 0; kb < NKB; ++kb) { const bf16x8 yf = ldf(lds + LY::Q, PK, n * 16 + c, kb * 32 + q * 8);
#pragma unroll
                  for (int mm = 0; mm < NM; ++mm) { const bf16x8 xf = ldf(lds + LY::ST, PK, (mh * NM + mm) * 16 + c, kb * 32 + q * 8); aI[mm] = __builtin_amdgcn_mfma_f32_16x16x32_bf16(xf, yf, aI[mm], 0, 0, 0); } } }
        }
#pragma unroll
        for (int a = 0; a < TKW; ++a)
#pragma unroll
            for (int bb = 0; bb < TVW; ++bb) st[a][bb] *= sdec;
#pragma unroll
        for (int kb = 0; kb < 2; ++kb) { bf16x8 xf[TKW];
#pragma unroll
            for (int a = 0; a < TKW; ++a) xf[a] = ldf(lds + LY::KUT, P64, (wk * TKW + a) * 16 + c, kb * 32 + q * 8);
#pragma unroll
            for (int bb = 0; bb < TVW; ++bb) { const bf16x8 yf = ldf(lds + LY::VT, P64, (wv * TVW + bb) * 16 + c, kb * 32 + q * 8);
#pragma unroll
                for (int a = 0; a < TKW; ++a) st[a][bb] = __builtin_amdgcn_mfma_f32_16x16x32_bf16(xf[a], yf, st[a][bb], 0, 0, 0); } }
        TREG_END(5); TREG_BEGIN(6);
        if (PASS == 3) {
            const int n = w & 3, mh = w >> 2, l = n * 16 + c; const float inter = sc[S_INTER + l];
            const size_t grow = row0 + l;
            if (KIND == 0) {
                bf16* Y = (bf16*)(F.ws + WS_Y); float ssq = 0.f;
#pragma unroll
                for (int mm = 0; mm < NM; ++mm) { const int dv0 = (mh * NM + mm) * 16 + 4 * q;
                    const v2u zw = zpf[mm];
                    const float zf[4] = {pg8::bf_lo(zw.x), pg8::bf_hi(zw.x), pg8::bf_lo(zw.y), pg8::bf_hi(zw.y)};
                    float o[4];
#pragma unroll
                    for (int r = 0; r < 4; ++r) { const float xv = bf2f(*(const LAS bf16*)(lds + LY::XT + (dv0 + r) * P64 + l * 2));
                        o[r] = bfround((aD[mm][r] + inter * aI[mm][r] + Dsk * xv) * siluf_(zf[r])); ssq += o[r] * o[r]; }
                    v2u ow; ow.x = pk2(o[0], o[1]); ow.y = pk2(o[2], o[3]);
                    *(v2u*)(Y + grow * 2048 + 512 + head * 64 + dv0) = ow; }
                ssq += __shfl_xor(ssq, 16); ssq += __shfl_xor(ssq, 32);
                const int par = ci & 1;
                if (q == 0) sc[S_RED + par * 128 + mh * 64 + l] = ssq;
                __syncthreads();
                if (mh == 0 && q == 0) ssqB[grow * 8 + head] = sc[S_RED + par * 128 + l] + sc[S_RED + par * 128 + 64 + l];
                if (ci + 1 < C::NCH) GLA_LOAD_ZO(row0 + 64);
            } else {
                float dinv = 1.0f;
                if (KIND == 1) { const float den = ((sc[S_ROWSUM + l] + sc[S_ROWSUM + 64 + l]) + (sc[S_ROWSUM + 128 + l] + sc[S_ROWSUM + 192 + l])) + inter * sc[S_QN + l]; dinv = 1.0f / fmaxf(fabsf(den), sc[S_EINV + l]); }
                float hv[NM][4]; float ssq = 0.f;
#pragma unroll
                for (int mm = 0; mm < NM; ++mm) {
                    float og[4] = {1.f, 1.f, 1.f, 1.f};
                    if (KIND == 1) { const v2u ow = opf[mm];
                        og[0] = sigmoidf_(pg8::bf_lo(ow.x)); og[1] = sigmoidf_(pg8::bf_hi(ow.x)); og[2] = sigmoidf_(pg8::bf_lo(ow.y)); og[3] = sigmoidf_(pg8::bf_hi(ow.y)); }
#pragma unroll
                    for (int r = 0; r < 4; ++r) { hv[mm][r] = (aD[mm][r] + inter * aI[mm][r]) * dinv * og[r]; ssq += hv[mm][r] * hv[mm][r]; } }
                ssq += __shfl_xor(ssq, 16); ssq += __shfl_xor(ssq, 32);
                const int par = ci & 1;
                if (q == 0) sc[S_RED + par * 128 + mh * 64 + l] = ssq;
                __syncthreads();
                const float tot = sc[S_RED + par * 128 + l] + sc[S_RED + par * 128 + 64 + l];
                const float rs = 1.0f / sqrtf(tot * (1.f / 128.f) + EPS);
                const int ycol = KIND == 1 ? 1024 : 1536;
                bf16* Y = (bf16*)(F.ws + WS_Y);
#pragma unroll
                for (int mm = 0; mm < NM; ++mm) { const int dv0 = (mh * NM + mm) * 16 + 4 * q;
                    const v2u zw = zpf[mm];
                    const f32x4 gv = *(const LAS f32x4*)(sc + S_G + dv0);
                    const float o0 = hv[mm][0] * rs * gv[0] * siluf_(pg8::bf_lo(zw.x)), o1 = hv[mm][1] * rs * gv[1] * siluf_(pg8::bf_hi(zw.x));
                    const float o2 = hv[mm][2] * rs * gv[2] * siluf_(pg8::bf_lo(zw.y)), o3 = hv[mm][3] * rs * gv[3] * siluf_(pg8::bf_hi(zw.y));
                    v2u o; o.x = pk2(o0, o1); o.y = pk2(o2, o3);
                    *(v2u*)(Y + grow * 2048 + ycol + head * 128 + dv0) = o; }
                if (ci + 1 < C::NCH) GLA_LOAD_ZO(row0 + 64);
            }
        } else {
            __syncthreads();
        }
        TREG_END(6);
    }
    if (PASS == 1) {
#pragma unroll
        for (int a = 0; a < TKW; ++a)
#pragma unroll
            for (int bb = 0; bb < TVW; ++bb)
#pragma unroll
                for (int r = 0; r < 4; ++r) stp[(size_t)((a * TVW + bb) * 4 + r) * 512] = st[a][bb][r];
        if (KIND == 1 && tid < 128) nbase[sl * 128 + tid] = nreg;
        if (tid == 0) { scbase[sl * 4 + 0] = asum; scbase[sl * 4 + 1] = mp; }
    }
}
template <int KIND>
__device__ __forceinline__ void scan_part(Frame& F, float* stbase, float* scbase, float* nbase) {
    using C = GC<KIND>; using LY = Lay<KIND>;
    const int total = BATCH * C::NH * LY::NEL + (KIND == 1 ? BATCH * C::NH * 128 : 0);
    for (int idx = F.bid * (NWAVES * 64) + F.tid; idx < total; idx += F.G * NWAVES * 64) {
        const bool isn = idx >= BATCH * C::NH * LY::NEL;
        const int i2 = isn ? idx - BATCH * C::NH * LY::NEL : idx, per = isn ? 128 : LY::NEL;
        const int chain = i2 / per, e = i2 % per;
        float* base = isn ? nbase : stbase;
        float start = 0.f, m = 0.f;
        for (int j = 0; j < LY::NSC; ++j) { const int sl = chain * LY::NSC + j; const float A = scbase[sl * 4];
            float fo, fl;
            if (KIND == 1) { const float ml = scbase[sl * 4 + 1], mnew = fmaxf(A + m, ml); fo = __expf(A + m - mnew); fl = __expf(ml - mnew); if (e == 0 && !isn) scbase[sl * 4 + 2] = m; m = mnew; }
            else { fo = __expf(A); fl = 1.f; }
            const float loc = base[(size_t)sl * per + e]; base[(size_t)sl * per + e] = start; start = fo * start + fl * loc; }
    }
}
}

namespace rg {
using gla::ldf; using gla::pack8; using gla::P64; using gla::bf16x8;
constexpr int NCH = 8, NSC = gla::NCHUNK / NCH, NITEMS = BATCH * 8 * NSC;
constexpr int PLD = 2560, PCOL = 0;
constexpr int L_WA = 0, L_WX = 9216, L_XB = 18432, L_XF = 27648, L_A = L_XF + 16384, L_D = L_A + 17408, L_RU = L_D + 17408, L_RZ = L_RU + 67 * 144, L_YT = L_RZ + 64 * 144, L_SG = L_YT + 8192, L_END = L_SG + 4352;
static_assert(L_END <= LDS_BYTES - 64 && L_RU % 16 == 0 && L_RZ % 16 == 0 && L_YT % 16 == 0, "LDS");
template <int PASS> __device__ __forceinline__ void raw_piece(int tid, int i, int hb, int& goff, int& loff) {
    int idx = tid + 512 * i; const int npieces = PASS == 3 ? 1048 : 536; if (idx >= npieces) idx -= 512;
    if (idx < 536) { const int r = idx >> 3, c8 = idx & 7; goff = (r - 3) * PLD + hb * 64 + c8 * 8; loff = L_RU + r * 144 + c8 * 16; }
    else { const int i2 = idx - 536, r = i2 >> 3, c8 = i2 & 7; goff = r * PLD + 512 + hb * 64 + c8 * 8; loff = L_RZ + r * 144 + c8 * 16; }
}
template <int PASS>
__device__ __forceinline__ void item(Frame& F, int layer, int b, int hb, int j, float* stA) {
    constexpr int NPF = PASS == 3 ? 3 : 2;
    LAS unsigned char* const lds = F.lds;
    const int tid = F.tid, lane = F.lane, w = F.wave, c = lane & 15, q = lane >> 4;
    const bf16* P = (const bf16*)(F.ws + WS_P) + PCOL; bf16* Y = (bf16*)(F.ws + WS_Y);
    float* slot = stA + (size_t)(((b * 8 + hb) * NSC + j) * 128);
    LAS float* const sg = (LAS float*)(lds + L_SG);
    TREG_BEGIN(11); TREG_BEGIN(12);
    __syncthreads();
    { const float* wa = F.in[I_AGAW] + ((size_t)layer * 8 + hb) * 4096; const float* wx = F.in[I_AGXW] + ((size_t)layer * 8 + hb) * 4096;
      const int jo = tid & 63, i0 = (tid >> 6) * 8; float va[8], vx[8];
#pragma unroll
      for (int e = 0; e < 8; ++e) { va[e] = wa[(i0 + e) * 64 + jo]; vx[e] = wx[(i0 + e) * 64 + jo]; }
      *(LAS v4u*)(lds + L_WA + jo * P64 + i0 * 2) = pack8(va); *(LAS v4u*)(lds + L_WX + jo * P64 + i0 * 2) = pack8(vx); }
    if (tid < 64) { sg[1024 + tid] = PASS == 3 ? slot[64 + tid] : 0.f; sg[1088 + tid] = 1.f; }
    float cw0 = 0.f, cw1 = 0.f, cw2 = 0.f, cw3 = 0.f, cbs = 0.f;
    if (tid < 256) { const int chg = hb * 64 + (tid & 63); const float* cwp = F.in[I_ACW] + (size_t)layer * 4 * BRW + chg;
        cw0 = cwp[0]; cw1 = cwp[BRW]; cw2 = cwp[2 * BRW]; cw3 = cwp[3 * BRW]; cbs = F.in[I_ACB][layer * BRW + chg]; }
    float ba[2], bx[2], sp[2];
#pragma unroll
    for (int i2 = 0; i2 < 2; ++i2) { const int chg = hb * 64 + (2 * (w & 1) + i2) * 16 + c;
        ba[i2] = F.in[I_AGAB][layer * BRW + chg]; bx[i2] = F.in[I_AGXB][layer * BRW + chg]; sp[i2] = softplusf_(-F.in[I_ALAM][layer * BRW + chg]); }
    v4u pf[NPF];
    { const int cg = j * NCH; const size_t row0 = (size_t)b * SEQ + (size_t)cg * 64;
#pragma unroll
      for (int i = 0; i < NPF; ++i) { int go, lo; raw_piece<PASS>(tid, i, hb, go, lo); pf[i] = (v4u){0u, 0u, 0u, 0u};
          if (!(cg == 0 && go < 0)) pf[i] = *(const v4u*)(P + (ptrdiff_t)row0 * PLD + go); } }
    TREG_END(12);
    for (int ci = 0; ci < NCH; ++ci) {
        const int cg = j * NCH + ci; const size_t row0 = (size_t)b * SEQ + (size_t)cg * 64;
        int tl = tid; asm volatile("" : "+v"(tl));
#pragma unroll
        for (int i = 0; i < NPF; ++i) { int go, lo; raw_piece<PASS>(tl, i, hb, go, lo); *(LAS v4u*)(lds + lo) = pf[i]; }
        if (ci + 1 < NCH) {
#pragma unroll
            for (int i = 0; i < NPF; ++i) { int go, lo; raw_piece<PASS>(tl, i, hb, go, lo); pf[i] = *(const v4u*)(P + (ptrdiff_t)(row0 + 64) * PLD + go); } }
        __syncthreads();
        if (tid < 256) {
            const int ch = tid & 63, lq = tid >> 6; const LAS unsigned char* rp = lds + L_RU + (lq * 16) * 144 + ch * 2;
            float x3 = bf2f(*(const LAS bf16*)(rp)), x2 = bf2f(*(const LAS bf16*)(rp + 144)), x1 = bf2f(*(const LAS bf16*)(rp + 288));
#pragma unroll
            for (int e = 0; e < 16; ++e) { const float x0 = bf2f(*(const LAS bf16*)(rp + (3 + e) * 144));
                const float xc = cbs + cw3 * x0 + cw2 * x1 + cw1 * x2 + cw0 * x3; x3 = x2; x2 = x1; x1 = x0;
                const int l = lq * 16 + e;
                *(LAS bf16*)(lds + L_XB + l * P64 + ch * 2) = (bf16)f2bf(xc); *(LAS float*)(lds + L_XF + (l * 64 + ch) * 4) = xc; }
        }
        __syncthreads();
        { const int lt = w >> 1, jt0 = 2 * (w & 1);
          f32x4 ra[2] = {(f32x4){0.f, 0.f, 0.f, 0.f}, (f32x4){0.f, 0.f, 0.f, 0.f}}, ia[2] = {(f32x4){0.f, 0.f, 0.f, 0.f}, (f32x4){0.f, 0.f, 0.f, 0.f}};
#pragma unroll
          for (int kb = 0; kb < 2; ++kb) { const bf16x8 xf = ldf(lds + L_XB, P64, lt * 16 + c, kb * 32 + q * 8);
#pragma unroll
              for (int i2 = 0; i2 < 2; ++i2) { const bf16x8 ya = ldf(lds + L_WA, P64, (jt0 + i2) * 16 + c, kb * 32 + q * 8), yx = ldf(lds + L_WX, P64, (jt0 + i2) * 16 + c, kb * 32 + q * 8);
                  ra[i2] = __builtin_amdgcn_mfma_f32_16x16x32_bf16(xf, ya, ra[i2], 0, 0, 0); ia[i2] = __builtin_amdgcn_mfma_f32_16x16x32_bf16(xf, yx, ia[i2], 0, 0, 0); } }
#pragma unroll
          for (int i2 = 0; i2 < 2; ++i2)
#pragma unroll
              for (int r = 0; r < 4; ++r) { const int l = lt * 16 + 4 * q + r, jj = (jt0 + i2) * 16 + c;
                  const float rr = sigmoidf_(ra[i2][r] + ba[i2]), ig = sigmoidf_(ia[i2][r] + bx[i2]);
                  const float la = -8.0f * rr * sp[i2]; const float a = __expf(la);
                  const float dr = sqrtf(neg_expm1_neg(2.0f * la)) * (ig * *(const LAS float*)(lds + L_XF + (l * 64 + jj) * 4));
                  *(LAS float*)(lds + L_A + (l * 68 + jj) * 4) = a; *(LAS float*)(lds + L_D + (l * 68 + jj) * 4) = dr; } }
        __syncthreads();
        { const int ch = lane, l0 = w * 8;
          float av[8], dv[8];
#pragma unroll
          for (int e = 0; e < 8; ++e) { av[e] = *(const LAS float*)(lds + L_A + ((l0 + e) * 68 + ch) * 4); dv[e] = *(const LAS float*)(lds + L_D + ((l0 + e) * 68 + ch) * 4); }
          float pa = 1.f, hl = 0.f;
#pragma unroll
          for (int e = 0; e < 8; ++e) { hl = av[e] * hl + dv[e]; pa *= av[e]; }
          sg[w * 64 + ch] = pa; sg[512 + w * 64 + ch] = hl;
          __syncthreads();
          float hs = sg[1024 + ch], ap = sg[1088 + ch];
          for (int s2 = 0; s2 < w; ++s2) { const float pa2 = sg[s2 * 64 + ch]; hs = pa2 * hs + sg[512 + s2 * 64 + ch]; ap *= pa2; }
#pragma unroll
          for (int e = 0; e < 8; ++e) { hs = av[e] * hs + dv[e];
              if (PASS == 3) { const float z = bf2f(*(const LAS bf16*)(lds + L_RZ + (l0 + e) * 144 + ch * 2)); *(LAS bf16*)(lds + L_YT + (l0 + e) * 128 + ch * 2) = (bf16)f2bf(hs * siluf_(z)); } }
          __syncthreads();
          if (w == 7) { sg[1024 + ch] = hs; sg[1088 + ch] = ap * pa; }
        }
        if (PASS == 3) {
            const int r = tid >> 3, c8 = tid & 7;
            *(v4u*)(Y + (row0 + r) * 2048 + hb * 64 + c8 * 8) = *(const LAS v4u*)(lds + L_YT + r * 128 + c8 * 16);
        }
    }
    __syncthreads();
    TREG_END(11);
    if (PASS == 1 && tid < 64) { slot[tid] = sg[1088 + tid]; slot[64 + tid] = sg[1024 + tid]; }
}
__device__ __forceinline__ void scan_part(Frame& F, float* stA) {
    for (int idx = F.bid * (NWAVES * 64) + F.tid; idx < BATCH * BRW; idx += F.G * NWAVES * 64) {
        const int b = idx >> 9, chx = idx & 511, hb = chx >> 6, ch = chx & 63; float start = 0.f;
        for (int j = 0; j < NSC; ++j) { float* s = stA + (size_t)(((b * 8 + hb) * NSC + j) * 128); const float ap = s[ch], hl = s[64 + ch]; s[64 + ch] = start; start = ap * start + hl; }
    }
}
}

__device__ __forceinline__ void conv_unit(Frame& F, int layer, int u) {
    const bf16* P = (const bf16*)(F.ws + WS_P) + 1024; bf16* ACT = (bf16*)(F.ws + WS_ACT);
    const int c0 = 2 * F.tid; const size_t row0 = (size_t)u * 64;
    const float* cwp = F.in[I_BCW] + (size_t)layer * 4 * 1024 + c0; const float* cbp = F.in[I_BCB] + (size_t)layer * 1024 + c0;
    const float a0 = cwp[0], a1 = cwp[1024], a2 = cwp[2048], a3 = cwp[3072], ab = cbp[0];
    const float b0 = cwp[1], b1 = cwp[1025], b2 = cwp[2049], b3 = cwp[3073], bb = cbp[1];
    const bf16* src = P + row0 * 2560 + c0;
    float xa1 = 0.f, xa2 = 0.f, xa3 = 0.f, xb1 = 0.f, xb2 = 0.f, xb3 = 0.f;
    if ((row0 & (SEQ - 1)) != 0) { const unsigned h1 = *(const unsigned*)(src - 2560), h2 = *(const unsigned*)(src - 2 * 2560), h3 = *(const unsigned*)(src - 3 * 2560);
        xa1 = pg8::bf_lo(h1); xb1 = pg8::bf_hi(h1); xa2 = pg8::bf_lo(h2); xb2 = pg8::bf_hi(h2); xa3 = pg8::bf_lo(h3); xb3 = pg8::bf_hi(h3); }
#pragma unroll 1
    for (int g = 0; g < 4; ++g) { unsigned r[16];
#pragma unroll
        for (int e = 0; e < 16; ++e) r[e] = *(const unsigned*)(src + (size_t)(16 * g + e) * 2560);
#pragma unroll
        for (int e = 0; e < 16; ++e) { const float xa0 = pg8::bf_lo(r[e]), xb0 = pg8::bf_hi(r[e]);
            const float ca = ab + a3 * xa0 + a2 * xa1 + a1 * xa2 + a0 * xa3, cb = bb + b3 * xb0 + b2 * xb1 + b1 * xb2 + b0 * xb3;
            xa3 = xa2; xa2 = xa1; xa1 = xa0; xb3 = xb2; xb2 = xb1; xb1 = xb0;
            *(unsigned*)(ACT + (row0 + 16 * g + e) * 1024 + c0) = pk2(siluf_(ca), siluf_(cb)); } }
}

__device__ __forceinline__ void phase_final(Frame& F) {
    const bf16* delta = (const bf16*)(F.ws + WS_Y);
    const int gw = F.bid * NWAVES + F.wave, NGW = F.G * NWAVES;
    const float* ng = F.in[I_FNG];
    f32x4 gv[4];
#pragma unroll
    for (int j = 0; j < 4; ++j) gv[j] = *((const f32x4*)ng + F.lane + 64 * j);
    for (int row = gw; row < T; row += NGW) {
        f32x4* xr = (f32x4*)(F.out + (size_t)row * D) + F.lane;
        f32x4 v[4]; float s = 0.f;
#pragma unroll
        for (int j = 0; j < 4; ++j) { v[j] = xr[64 * j]; const v2u dw = *((const v2u*)(delta + (size_t)row * D) + F.lane + 64 * j);
            v[j].x += pg8::bf_lo(dw.x); v[j].y += pg8::bf_hi(dw.x); v[j].z += pg8::bf_lo(dw.y); v[j].w += pg8::bf_hi(dw.y);
            s += (v[j].x * v[j].x + v[j].y * v[j].y) + (v[j].z * v[j].z + v[j].w * v[j].w); }
        const float rs = 1.0f / sqrtf(wave_sum(s) * (1.f / D) + EPS);
#pragma unroll
        for (int j = 0; j < 4; ++j) xr[64 * j] = v[j] * rs * gv[j];
    }
}

constexpr int NPL = 13;
constexpr int NPH = DEPTH * NPL + 1;

__device__ __forceinline__ void gemm_in_group(Frame& F, int col0, int ncols) {
    pg8::Gemm g{(const pg8::bf16_t*)(F.ws + WS_HN), (const pg8::bf16_t*)(F.ws + WS_W1) + (size_t)col0 * D, T, ncols, D, D, D, 0};
    pg8::StaticOrder S; S.init(T, ncols, F.G, F.bid);
    pg8::EpiBf16S E{(pg8::bf16_t*)(F.ws + WS_P), ncols, 0};
    pg8::gemm_phase<pg8::EpiBf16S, pg8::StaticOrder, true, true>(F.lds, g, S, E, F.tid);
}


__device__ __forceinline__ void phase_body(Frame& F, int layer, const int k) {
        float* const stBC = (float*)(F.ws + WS_STBC); float* const stD = (float*)(F.ws + WS_STD); float* const stA = (float*)(F.ws + WS_RGST);
        float* const scB = (float*)(F.ws + WS_SCB); float* const scC = (float*)(F.ws + WS_SCC); float* const scD = (float*)(F.ws + WS_SCD);
        float* const nC = (float*)(F.ws + WS_NC); float* const ssqB = (float*)(F.ws + WS_SSQB);
        switch (k) {
        case 0: { volatile LAS unsigned* tw_ = (volatile LAS unsigned*)(F.lds + LDS_BYTES - 64);
            if (TPHASE == 21 && F.tid == 0) tw_[6] = (unsigned)__builtin_amdgcn_s_memrealtime();
            phase_prep(F, layer, layer <= 1 ? F.in[I_X] : F.out, layer == 0 ? nullptr : (const bf16*)(F.ws + WS_Y), F.out);
            if (TPHASE == 21 && F.tid == 0) tw_[4] += (unsigned)__builtin_amdgcn_s_memrealtime() - tw_[6];
            if (TPHASE == 20 && F.tid == 0) tw_[6] = (unsigned)__builtin_amdgcn_s_memrealtime();
            phase_weights(F, layer);
            if (TPHASE == 20) { __syncthreads(); if (F.tid == 0) tw_[4] += (unsigned)__builtin_amdgcn_s_memrealtime() - tw_[6]; } } break;
        case 1: gemm_in_group(F, GA0, 2560); break;
        case 2: for (int it = F.bid; it < 1024; it += F.G) {
                if (it < 512) conv_unit(F, layer, it);
                else { const int i2 = it - 512, j = i2 % rg::NSC, hb = (i2 / rg::NSC) & 7, b = i2 / (rg::NSC * 8); rg::item<1>(F, layer, b, hb, j, stA); } } break;
        case 3: for (int it = F.bid; it < 512; it += F.G) { const int j = it % 16, head = (it / 16) & 7, b = it / 128; gla::gla_item<0, 1>(F, layer, b, head, j, stBC, scB, nullptr, ssqB); } break;
        case 4: rg::scan_part(F, stA); gla::scan_part<0>(F, stBC, scB, nullptr); break;
        case 5: for (int it = F.bid; it < 1024; it += F.G) {
                if (it < 512) { const int j = it % rg::NSC, hb = (it / rg::NSC) & 7, b = it / (rg::NSC * 8); rg::item<3>(F, layer, b, hb, j, stA); }
                else { const int i2 = it - 512, j = i2 % 16, head = (i2 / 16) & 7, b = i2 / 128; gla::gla_item<0, 3>(F, layer, b, head, j, stBC, scB, nullptr, ssqB); } } break;
        case 6: gemm_in_group(F, GC0, 4096); break;
        case 7: for (int it = F.bid; it < 512; it += F.G) {
                const int i2 = it & 255, j = i2 % 16, head = (i2 / 16) & 3, b = i2 / 64;
                if (it < 256) gla::gla_item<1, 1>(F, layer, b, head, j, stBC, scC, nC, nullptr); else gla::gla_item<2, 1>(F, layer, b, head, j, stD, scD, nullptr, nullptr); } break;
        case 8: gla::scan_part<1>(F, stBC, scC, nC); gla::scan_part<2>(F, stD, scD, nullptr);
            for (int row = F.bid * (NWAVES * 64) + F.tid; row < T; row += F.G * NWAVES * 64) {
                const f32x4 s0 = *(const f32x4*)(ssqB + (size_t)row * 8), s1 = *(const f32x4*)(ssqB + (size_t)row * 8 + 4);
                ((float*)(F.ws + WS_RSB))[row] = 1.0f / sqrtf((((s0[0] + s0[1]) + (s0[2] + s0[3])) + ((s1[0] + s1[1]) + (s1[2] + s1[3]))) * (1.0f / 512.0f) + EPS); }
            break;
        case 9: for (int it = F.bid; it < 512; it += F.G) {
                const int i2 = it & 255, j = i2 % 16, head = (i2 / 16) & 3, b = i2 / 64;
                if (it < 256) gla::gla_item<1, 3>(F, layer, b, head, j, stBC, scC, nC, nullptr); else gla::gla_item<2, 3>(F, layer, b, head, j, stD, scD, nullptr, nullptr); } break;
        case 10: {
            pg8::Gemm g{(const pg8::bf16_t*)(F.ws + WS_HN), (const pg8::bf16_t*)(F.ws + WS_W1) + (size_t)GG0 * D, T, 4096, D, D, D, 0};
            pg8::StaticOrder S; S.init(T, 4096, F.G, F.bid);
            pg8::EpiGates E{(pg8::bf16_t*)(F.ws + WS_P)};
            pg8::gemm_phase<pg8::EpiGates, pg8::StaticOrder, true, true>(F.lds, g, S, E, F.tid);
        } break;
        case 11: {
            pg8::Gemm g{(const pg8::bf16_t*)(F.ws + WS_Y), (const pg8::bf16_t*)(F.ws + WS_WB), T, D, BRW, 2048, 2048, BRW};
            pg8::SegOrder<4> S; S.init(T, D, F.G, F.bid);
            pg8::EpiHorner E{(const pg8::bf16_t*)(F.ws + WS_P), (const float*)(F.ws + WS_RSB), (pg8::bf16_t*)(F.ws + WS_HN), 1024};
            pg8::gemm_phase<pg8::EpiHorner, pg8::SegOrder<4>, true, true>(F.lds, g, S, E, F.tid);
        } break;
        case 12: {
            pg8::Gemm g{(const pg8::bf16_t*)(F.ws + WS_HN), (const pg8::bf16_t*)(F.ws + WS_WO), T, D, D, D, D, 0};
            pg8::StaticOrder S; S.init(T, D, F.G, F.bid);
            pg8::EpiBf16S E{(pg8::bf16_t*)(F.ws + WS_Y), D, 0};
            pg8::gemm_phase<pg8::EpiBf16S, pg8::StaticOrder, true, true>(F.lds, g, S, E, F.tid);
        } break;
        }
}
template <int PH>
__device__ __forceinline__ void run_phases(const Args& args, unsigned char* ldsg) {
    Frame F;
    { int t_ = threadIdx.x, layer_ = PH / NPL; size_t z_ = 0; InTab i_ = (InTab)__builtin_amdgcn_kernarg_segment_ptr(); unsigned l_ = (unsigned)(size_t)(LAS unsigned char*)ldsg;
      asm volatile("" : "+v"(t_), "+s"(z_), "+s"(layer_), "+s"(i_), "+s"(l_));
      F.lds = (LAS unsigned char*)(size_t)l_; F.in = i_; F.tid = t_; F.lane = t_ & 63; F.wave = __builtin_amdgcn_readfirstlane(t_ >> 6); F.ws = args.ws + z_; F.out = (float*)((unsigned char*)args.out + z_); F.G = gridDim.x; F.bid = blockIdx.x;
      if (PH == 1) cooperative_groups::this_grid().sync();
      else if (PH > 1) xcd_barrier((unsigned*)(F.ws + WS_CTL) + 4096, (volatile LAS unsigned*)(F.lds + LDS_BYTES - 64));
      const bool timed_ = TPHASE >= 0 && (PH == NPH - 1 ? TPHASE == NPL : TPHASE == PH % NPL);
      if (timed_ && F.tid == 0) ((volatile LAS unsigned*)(F.lds + LDS_BYTES - 64))[6] = (unsigned)__builtin_amdgcn_s_memrealtime();
      if (PH == NPH - 1) phase_final(F); else phase_body(F, layer_, PH % NPL);
      if (timed_) { __syncthreads(); if (F.tid == 0) { volatile LAS unsigned* w_ = (volatile LAS unsigned*)(F.lds + LDS_BYTES - 64); w_[4] += (unsigned)__builtin_amdgcn_s_memrealtime() - w_[6]; } } }
    if constexpr (PH + 1 < NPH) run_phases<PH + 1>(args, ldsg);
}

__global__ void __launch_bounds__(NWAVES * 64, 2) fwd(Args args) {
    extern __shared__ __attribute__((aligned(16))) unsigned char lds[];
    { volatile LAS unsigned* bst = (volatile LAS unsigned*)((LAS unsigned char*)lds + LDS_BYTES - 64);
      if (threadIdx.x < 16) bst[threadIdx.x] = 0u;
      __syncthreads();
      (void)xcd_barrier_post((unsigned*)(args.ws + WS_CTL) + 4096, bst); }
    run_phases<0>(args, lds);
    if ((TSEL != 0 || TPHASE >= 0) && blockIdx.x == 0 && threadIdx.x == 0) { volatile LAS unsigned* bst = (volatile LAS unsigned*)((LAS unsigned char*)lds + LDS_BYTES - 64);
        const unsigned long long t0_ = __builtin_amdgcn_s_memrealtime(); const unsigned ticks = bst[4];
        while (__builtin_amdgcn_s_memrealtime() - t0_ < (unsigned long long)ticks) __builtin_amdgcn_s_sleep(8); }
}

extern "C" void kernel_launch(void* const* d_in, const int* in_sizes, int n_in, void* d_out, int out_size, void* d_ws, size_t ws_size, hipStream_t stream) {
    static int grid = 0;
    if (grid == 0) {
        if (n_in != 23 || in_sizes[0] != T * D || out_size != T * D || ws_size < WS_END) { fprintf(stderr, "kernel_launch: unexpected shapes (n_in %d, in0 %d, out %d, ws %zu)\n", n_in, n_in > 0 ? in_sizes[0] : -1, out_size, ws_size); grid = -1; return; }
        int dev = 0, cus = 0, per_cu = 0;
        if (hipGetDevice(&dev) != hipSuccess || hipDeviceGetAttribute(&cus, hipDeviceAttributeMultiprocessorCount, dev) != hipSuccess) { grid = -1; return; }
        if (hipFuncSetAttribute((const void*)fwd, hipFuncAttributeMaxDynamicSharedMemorySize, LDS_BYTES) != hipSuccess) { fprintf(stderr, "kernel_launch: hipFuncSetAttribute failed\n"); grid = -1; return; }
        if (hipOccupancyMaxActiveBlocksPerMultiprocessor(&per_cu, (const void*)fwd, NWAVES * 64, LDS_BYTES) != hipSuccess || per_cu < 1) { fprintf(stderr, "kernel_launch: occupancy query says %d blocks per CU\n", per_cu); grid = -1; return; }
        grid = cus;
    }
    if (grid < 0) return;
    Args a{};
    for (int i = 0; i < 23; ++i) a.in[i] = (const float*)d_in[i];
    a.out = (float*)d_out; a.ws = (unsigned char*)d_ws; a.ph_lo = 0; a.ph_hi = NPH;
    if (hipMemsetAsync((char*)d_ws + WS_CTL, 0, CTL_ZERO_BYTES, stream) != hipSuccess) { fprintf(stderr, "kernel_launch: memset failed\n"); return; }
    void* kargs[] = {&a};
    hipError_t e = hipLaunchCooperativeKernel((const void*)fwd, dim3(grid), dim3(NWAVES * 64), kargs, LDS_BYTES, stream);
    if (e != hipSuccess) fprintf(stderr, "kernel_launch: cooperative launch failed: %s (grid %d)\n", hipGetErrorString(e), grid);
}
```

```cpp
#include <hip/hip_runtime.h>
#include <hip/hip_cooperative_groups.h>
#include <cstdio>
#include <cstdint>

#ifndef WT_STORES
#define WT_STORES 1
#endif
__device__ __forceinline__ void st16_wt(void* p, const unsigned __attribute__((ext_vector_type(4))) v) { asm volatile("global_store_dwordx4 %0, %1, off sc1\n\ts_nop 1" :: "v"(p), "v"(v) : "memory"); }
__device__ __forceinline__ void st8_wt(void* p, const unsigned __attribute__((ext_vector_type(2))) v) { asm volatile("global_store_dwordx2 %0, %1, off sc1\n\ts_nop 1" :: "v"(p), "v"(v) : "memory"); }
__device__ __forceinline__ void st4_wt(void* p, const unsigned v) { asm volatile("global_store_dword %0, %1, off sc1\n\ts_nop 1" :: "v"(p), "v"(v) : "memory"); }
namespace pg8 {
#define PG8_LAS __attribute__((address_space(3)))
typedef unsigned short bf16_t;
typedef short bf16x8 __attribute__((ext_vector_type(8)));
typedef float f32x4 __attribute__((ext_vector_type(4)));
typedef unsigned u32x4 __attribute__((ext_vector_type(4)));
typedef unsigned u32x2 __attribute__((ext_vector_type(2)));
constexpr int BM = 256, BK = 64, HALF = 128, HTB = HALF * BK * 2  , STAGE_BYTES = 8 * HTB, NXCD = 8, WGM = 8;

__host__ __device__ __forceinline__ int lds_byte(int r, int c) { const int st = (r >> 4) * 2 + (c >> 5), rr = r & 15, cc = c & 31, ob = rr * 64 + cc * 2; return st * 1024 + (ob ^ (((ob >> 9) & 1) << 5)); }
__host__ __device__ __forceinline__ void stage_rc(int b, int& R, int& C) { const int st = b / 1024, sb = b % 1024, swz = sb ^ (((sb >> 9) & 1) << 5); R = (st >> 1) * 16 + swz / 64; C = (st & 1) * 32 + (swz % 64) / 2; }
__host__ __device__ __forceinline__ int perm32(int rho) { const int n = rho >> 4, i = rho & 15; return 8 * (i >> 2) + 4 * n + (i & 3); }

struct Unit { int pm, pn, ks; };
struct Gemm { const bf16_t* A; const bf16_t* Bt; int M, N, K, lda, ldb, kseg; };

struct StaticOrder {
    int nM, nN, nwg, G, c;
    __host__ __device__ void init(int M, int N, int G_, int c_) { nM = M / BM; nN = N / BM; nwg = nM * nN; G = G_; c = c_; }
    __host__ __device__ bool next(int i, Unit& u) const {
        const long L = (long)i * G + c; if (L >= nwg) return false;
        int wgid = (int)L; { const int q = nwg / NXCD, r = nwg % NXCD, xcd = wgid % NXCD, off = wgid / NXCD; wgid = (xcd < r ? xcd * (q + 1) : r * (q + 1) + (xcd - r) * q) + off; }
        const int nig = WGM * nN, gid = wgid / nig, fm = gid * WGM, gsz = (nM - fm) < WGM ? (nM - fm) : WGM;
        u.pm = fm + ((wgid % nig) % gsz); u.pn = (wgid % nig) / gsz; u.ks = 0; return true;
    }
    __device__ __forceinline__ void a_ready(const Unit&) const {}
    __device__ __forceinline__ void done(const Unit&) const {}
};


template <int NSEG> struct SegOrder : StaticOrder {
    __host__ __device__ bool next(int i, Unit& u) const { if (!StaticOrder::next(i / NSEG, u)) return false; u.ks = i % NSEG; return true; }
};

__device__ __forceinline__ unsigned cvt_pk_bf16(float lo, float hi) { unsigned r; asm volatile("v_cvt_pk_bf16_f32 %0, %1, %2" : "=v"(r) : "v"(lo), "v"(hi)); return r; }
__device__ __forceinline__ float bf_lo(unsigned w) { return __uint_as_float(w << 16); }
__device__ __forceinline__ float bf_hi(unsigned w) { return __uint_as_float(w & 0xffff0000u); }
__device__ __forceinline__ float sigmoid_f(float x) { return __builtin_amdgcn_rcpf(1.0f + __expf(-x)); }

struct EpiBf16S {
    static constexpr bool PERM = true, AFTER_DRAIN = false, KEEP = false;
    bf16_t* O; int ldc; int sig;
    __device__ __forceinline__ void operator()(const f32x4 (&acc)[2][2][4][2], const Unit& u, int wr, int wc, int fr, int fq) const {
        const int row0 = u.pm * BM + wr * 64 + fr; const int col0 = u.pn * BM + wc * 32 + 8 * fq;
#pragma unroll
        for (int ai = 0; ai < 2; ++ai)
#pragma unroll
            for (int m = 0; m < 4; ++m) { bf16_t* rowp = O + (size_t)(row0 + ai * HALF + m * 16) * ldc + col0;
#pragma unroll
                for (int bj = 0; bj < 2; ++bj) { f32x4 v0 = acc[ai][bj][m][0], v1 = acc[ai][bj][m][1];
                    if (sig) {
#pragma unroll
                        for (int j = 0; j < 4; ++j) { v0[j] = sigmoid_f(v0[j]); v1[j] = sigmoid_f(v1[j]); } }
                    u32x4 w; w.x = cvt_pk_bf16(v0[0], v0[1]); w.y = cvt_pk_bf16(v0[2], v0[3]); w.z = cvt_pk_bf16(v1[0], v1[1]); w.w = cvt_pk_bf16(v1[2], v1[3]);
                    if (WT_STORES) asm volatile("global_store_dwordx4 %0, %1, off sc1\n\ts_nop 1" :: "v"(rowp + bj * HALF), "v"(w) : "memory");
                    else *(u32x4*)(rowp + bj * HALF) = w; } }
    }
};
struct EpiGates {
    static constexpr bool PERM = false, AFTER_DRAIN = false, KEEP = false;
    bf16_t* GR;
    __device__ __forceinline__ void operator()(const f32x4 (&acc)[2][2][4][2], const Unit& u, int wr, int wc, int fr, int fq) const {
        const int row0 = u.pm * BM + wr * 64 + fr, d0 = u.pn * 64 + wc * 16 + 4 * fq;
#pragma unroll
        for (int ai = 0; ai < 2; ++ai)
#pragma unroll
            for (int m = 0; m < 4; ++m) { const size_t row = (size_t)(row0 + ai * HALF + m * 16);
                float r0[4], r1[4], r2[4], r3[4];
#pragma unroll
                for (int e = 0; e < 4; ++e) {
                    const float e0 = 1.0f + __expf(-fmaxf(acc[ai][0][m][0][e], -30.f)), e1 = 1.0f + __expf(-fmaxf(acc[ai][0][m][1][e], -30.f));
                    const float e2 = 1.0f + __expf(-fmaxf(acc[ai][1][m][0][e], -30.f)), e3 = 1.0f + __expf(-fmaxf(acc[ai][1][m][1][e], -30.f));
                    r0[e] = e1 * __builtin_amdgcn_rcpf(e0); r1[e] = e2 * __builtin_amdgcn_rcpf(e1); r2[e] = e3 * __builtin_amdgcn_rcpf(e2); r3[e] = __builtin_amdgcn_rcpf(e3); }
                u32x2 w0, w1, w2, w3; w0.x = cvt_pk_bf16(r0[0], r0[1]); w0.y = cvt_pk_bf16(r0[2], r0[3]); w1.x = cvt_pk_bf16(r1[0], r1[1]); w1.y = cvt_pk_bf16(r1[2], r1[3]);
                w2.x = cvt_pk_bf16(r2[0], r2[1]); w2.y = cvt_pk_bf16(r2[2], r2[3]); w3.x = cvt_pk_bf16(r3[0], r3[1]); w3.y = cvt_pk_bf16(r3[2], r3[3]);
                const bool odd = (fq & 1) != 0;
                const u32x2 sa = odd ? w0 : w2, sb = odd ? w1 : w3;
                u32x2 ra, rb; ra.x = __shfl_xor(sa.x, 16); ra.y = __shfl_xor(sa.y, 16); rb.x = __shfl_xor(sb.x, 16); rb.y = __shfl_xor(sb.y, 16);
                const u32x2 ka = odd ? w2 : w0, kb = odd ? w3 : w1;
                u32x4 oa, ob;
                oa.x = odd ? ra.x : ka.x; oa.y = odd ? ra.y : ka.y; oa.z = odd ? ka.x : ra.x; oa.w = odd ? ka.y : ra.y;
                ob.x = odd ? rb.x : kb.x; ob.y = odd ? rb.y : kb.y; ob.z = odd ? kb.x : rb.x; ob.w = odd ? kb.y : rb.y;
                bf16_t* o = GR + row * 4096 + (d0 & ~7) + (odd ? 2048 : 0);
                *(u32x4*)(o) = oa; *(u32x4*)(o + 1024) = ob; }
    }
};
struct EpiHorner {
    static constexpr bool PERM = true, AFTER_DRAIN = false, KEEP = true;
    const bf16_t* GR; const float* rsB; bf16_t* Mb; int ldc;
    __device__ __forceinline__ void operator()(f32x4 (&acc)[2][2][4][2], const Unit& u, int wr, int wc, int fr, int fq) const {
        const int row0 = u.pm * BM + wr * 64 + fr, col0 = u.pn * BM + wc * 32 + 8 * fq;
        u32x4 gwa[2][4][2]; float rsa[2][4];
#pragma unroll
        for (int ai = 0; ai < 2; ++ai)
#pragma unroll
            for (int m = 0; m < 4; ++m) { const size_t row = (size_t)(row0 + ai * HALF + m * 16);
                rsa[ai][m] = u.ks < 2 ? rsB[row] : 1.0f;
#pragma unroll
                for (int bj = 0; bj < 2; ++bj) gwa[ai][m][bj] = *(const u32x4*)(GR + row * 4096 + u.ks * 1024 + col0 + bj * HALF); }
#pragma unroll
        for (int ai = 0; ai < 2; ++ai) {
#pragma unroll
            for (int m = 0; m < 4; ++m) { const float sc_ = u.ks == 0 ? __builtin_amdgcn_rcpf(rsa[ai][m]) : rsa[ai][m];
#pragma unroll
                for (int bj = 0; bj < 2; ++bj) { const u32x4 g4 = gwa[ai][m][bj];
                    f32x4 g0, g1; g0[0] = bf_lo(g4.x); g0[1] = bf_hi(g4.x); g0[2] = bf_lo(g4.y); g0[3] = bf_hi(g4.y); g1[0] = bf_lo(g4.z); g1[1] = bf_hi(g4.z); g1[2] = bf_lo(g4.w); g1[3] = bf_hi(g4.w);
                    acc[ai][bj][m][0] *= g0 * sc_; acc[ai][bj][m][1] *= g1 * sc_; } }
            asm volatile("" ::: "memory");
        }
        if (u.ks == 3) {
#pragma unroll
            for (int ai = 0; ai < 2; ++ai)
#pragma unroll
                for (int m = 0; m < 4; ++m) { const size_t row = (size_t)(row0 + ai * HALF + m * 16);
#pragma unroll
                    for (int bj = 0; bj < 2; ++bj) { u32x4 w; w.x = cvt_pk_bf16(acc[ai][bj][m][0][0], acc[ai][bj][m][0][1]); w.y = cvt_pk_bf16(acc[ai][bj][m][0][2], acc[ai][bj][m][0][3]);
                        w.z = cvt_pk_bf16(acc[ai][bj][m][1][0], acc[ai][bj][m][1][1]); w.w = cvt_pk_bf16(acc[ai][bj][m][1][2], acc[ai][bj][m][1][3]);
                        *(u32x4*)(Mb + row * ldc + col0 + bj * HALF) = w; } }
        }
    }
};
struct EpiResid {
    static constexpr bool PERM = false, AFTER_DRAIN = false, KEEP = false;
    const float* xin; float* out; int ldc;
    __device__ __forceinline__ void operator()(const f32x4 (&acc)[2][2][4][2], const Unit& u, int wr, int wc, int fr, int fq) const {
        const int row0 = u.pm * BM + wr * 64 + fr, col0 = u.pn * BM + wc * 32 + 4 * fq;
#pragma unroll
        for (int ai = 0; ai < 2; ++ai) { f32x4 xs[4][2][2];
#pragma unroll
            for (int m = 0; m < 4; ++m) { const size_t off = (size_t)(row0 + ai * HALF + m * 16) * ldc + col0;
#pragma unroll
                for (int bj = 0; bj < 2; ++bj)
#pragma unroll
                    for (int n = 0; n < 2; ++n) xs[m][bj][n] = *(const f32x4*)(xin + off + bj * HALF + n * 16); }
            asm volatile("" ::: "memory");
#pragma unroll
            for (int m = 0; m < 4; ++m) { const size_t off = (size_t)(row0 + ai * HALF + m * 16) * ldc + col0;
#pragma unroll
                for (int bj = 0; bj < 2; ++bj)
#pragma unroll
                    for (int n = 0; n < 2; ++n) *(f32x4*)(out + off + bj * HALF + n * 16) = xs[m][bj][n] + acc[ai][bj][m][n]; }
            asm volatile("" ::: "memory"); }
    }
};

template <class Epi, class Sched, bool ALIGN_EPI = false, bool SP2 = false>
__device__ __forceinline__ void gemm_phase(PG8_LAS unsigned char* lds, const Gemm g, const Sched& S, const Epi& E, const int tid) {
    const int wid = __builtin_amdgcn_readfirstlane(tid >> 6), lane = tid & 63, wr = wid >> 2, wc = wid & 3, fr = lane & 15, fq = lane >> 4;
    const int K = g.K, nt = K / BK;
    unsigned voffA[2], voffB[2];
#pragma unroll
    for (int i = 0; i < 2; ++i) { int R, C; stage_rc(tid * 16 + i * 8192, R, C); const int Rb = Epi::PERM ? ((R & ~31) + perm32(R & 31)) : R;
        voffA[i] = (unsigned)(R * g.lda + C) * 2u; voffB[i] = (unsigned)(Rb * g.ldb + C) * 2u; }
    const size_t kstep = (size_t)(BK * 2);
    const size_t hstepA = (size_t)HALF * g.lda * 2, hstepB = (size_t)HALF * g.ldb * 2;
    const size_t tstepA = 2 * hstepA, tstepB = 2 * hstepB;
    const unsigned ldsw = (unsigned)wid * 1024u;
    const int aoff = lds_byte(wr * 64 + fr, fq * 8), boff = lds_byte(wc * 32 + fr, fq * 8);
#define PG8_SA(b, h) (((b) * 2 + (h)) * HTB)
#define PG8_SB(b, h) ((4 + (b) * 2 + (h)) * HTB)
#define PG8_STAGE(bufoff, gbase, voff) do { _Pragma("unroll") for (int _i = 0; _i < 2; ++_i) \
        __builtin_amdgcn_global_load_lds((const unsigned*)((const char*)(gbase) + (voff)[_i]), (PG8_LAS unsigned*)(lds + (bufoff) + ldsw + _i * 8192), 16, 0, 0); } while (0)
#define PG8_LDA(dst, b, h) do { _Pragma("unroll") for (int m = 0; m < 4; ++m) _Pragma("unroll") for (int k = 0; k < 2; ++k) dst[m][k] = *(const PG8_LAS bf16x8*)(lds + PG8_SA(b, h) + aoff + m * 2048 + k * 1024); } while (0)
#define PG8_LDB(dst, b, h) do { _Pragma("unroll") for (int n = 0; n < 2; ++n) _Pragma("unroll") for (int k = 0; k < 2; ++k) dst[n][k] = *(const PG8_LAS bf16x8*)(lds + PG8_SB(b, h) + boff + n * 2048 + k * 1024); } while (0)
#define PG8_MMA(ai, bj, At, Bt) do { __builtin_amdgcn_s_setprio(1); _Pragma("unroll") for (int m = 0; m < 4; ++m) _Pragma("unroll") for (int n = 0; n < 2; ++n) _Pragma("unroll") for (int k = 0; k < 2; ++k) \
        acc[ai][bj][m][n] = __builtin_amdgcn_mfma_f32_16x16x32_bf16(Bt[n][k], At[m][k], acc[ai][bj][m][n], 0, 0, 0); __builtin_amdgcn_s_setprio(0); } while (0)
#define PG8_WAIT_V(n) asm volatile("s_waitcnt vmcnt(" #n ")" ::: "memory")
#define PG8_WAIT_L(n) asm volatile("s_waitcnt lgkmcnt(" #n ")" ::: "memory")
#define PG8_BAR __builtin_amdgcn_s_barrier()
#define PG8_SCHED __builtin_amdgcn_sched_barrier(0)
    Unit cur, nxt; int ui = 0;
    if (!S.next(0, cur)) return;
    f32x4 acc[2][2][4][2];
#pragma unroll
    for (int a = 0; a < 2; ++a)
#pragma unroll
        for (int b = 0; b < 2; ++b)
#pragma unroll
            for (int m = 0; m < 4; ++m)
#pragma unroll
                for (int n = 0; n < 2; ++n) acc[a][b][m][n] = (f32x4){0.f, 0.f, 0.f, 0.f};
    bf16x8 At[4][2], B0[2][2], B1[2][2];
    const size_t sstep = (size_t)g.kseg * 2;
    const char* cA = (const char*)g.A + (size_t)cur.pm * tstepA + (size_t)cur.ks * sstep; const char* cB = (const char*)g.Bt + (size_t)cur.pn * tstepB + (size_t)cur.ks * sstep;
    S.a_ready(cur);
    if constexpr (SP2) {
        PG8_STAGE(PG8_SB(0, 0), cB, voffB); PG8_STAGE(PG8_SB(0, 1), cB + hstepB, voffB); PG8_STAGE(PG8_SA(0, 0), cA, voffA); PG8_STAGE(PG8_SA(0, 1), cA + hstepA, voffA);
        if (wr == 1) PG8_BAR;
        PG8_WAIT_V(2); PG8_BAR;
        PG8_STAGE(PG8_SB(1, 0), cB + kstep, voffB); PG8_STAGE(PG8_SA(1, 0), cA + kstep, voffA); PG8_STAGE(PG8_SB(1, 1), cB + hstepB + kstep, voffB);
        PG8_WAIT_V(6); PG8_BAR;
    } else {
        PG8_STAGE(PG8_SB(0, 0), cB, voffB); PG8_STAGE(PG8_SA(0, 0), cA, voffA); PG8_STAGE(PG8_SB(0, 1), cB + hstepB, voffB); PG8_STAGE(PG8_SA(0, 1), cA + hstepA, voffA);
        if (wr == 1) PG8_BAR;
        PG8_WAIT_V(4); PG8_BAR;
        PG8_STAGE(PG8_SB(1, 0), cB + kstep, voffB); PG8_STAGE(PG8_SA(1, 0), cA + kstep, voffA); PG8_STAGE(PG8_SB(1, 1), cB + hstepB + kstep, voffB);
        PG8_WAIT_V(6); PG8_BAR;
    }
    for (;;) {
        const bool has_next = S.next(ui + 1, nxt);
        const char* nA = has_next ? (const char*)g.A + (size_t)nxt.pm * tstepA + (size_t)nxt.ks * sstep : cA; const char* nB = has_next ? (const char*)g.Bt + (size_t)nxt.pn * tstepB + (size_t)nxt.ks * sstep : cB;
        for (int t = 0; t < nt; t += 2) {
            const bool last = (t == nt - 2);
            const char* a1 = cA + (size_t)(t + 1) * kstep;
            const char* a2 = last ? nA : cA + (size_t)(t + 2) * kstep; const char* b2 = last ? nB : cB + (size_t)(t + 2) * kstep;
            const char* a3 = a2 + kstep; const char* b3 = b2 + kstep;
            if (last && has_next) S.a_ready(nxt);
            if constexpr (SP2) {
            PG8_LDB(B0, 0, 0); PG8_LDB(B1, 0, 1); PG8_SCHED; PG8_LDA(At, 0, 0); PG8_STAGE(PG8_SA(1, 1), a1 + hstepA, voffA);
            PG8_WAIT_V(8); PG8_WAIT_L(0); PG8_BAR; PG8_MMA(0, 0, At, B0); PG8_MMA(0, 1, At, B1); PG8_BAR; PG8_SCHED;
            PG8_LDA(At, 0, 1); PG8_STAGE(PG8_SB(0, 0), b2, voffB); PG8_STAGE(PG8_SB(0, 1), b2 + hstepB, voffB); PG8_STAGE(PG8_SA(0, 0), a2, voffA);
            PG8_WAIT_V(8); PG8_WAIT_L(0); PG8_BAR; PG8_MMA(1, 0, At, B0); PG8_MMA(1, 1, At, B1); PG8_BAR; PG8_SCHED;
            PG8_LDB(B0, 1, 0); PG8_LDB(B1, 1, 1); PG8_SCHED; PG8_LDA(At, 1, 0); PG8_STAGE(PG8_SA(0, 1), a2 + hstepA, voffA);
            PG8_WAIT_V(8); PG8_WAIT_L(0); PG8_BAR; PG8_MMA(0, 0, At, B0); PG8_MMA(0, 1, At, B1); PG8_BAR; PG8_SCHED;
            PG8_LDA(At, 1, 1); PG8_STAGE(PG8_SB(1, 0), b3, voffB); PG8_STAGE(PG8_SB(1, 1), b3 + hstepB, voffB); PG8_STAGE(PG8_SA(1, 0), a3, voffA);
            PG8_WAIT_V(8); PG8_WAIT_L(0); PG8_BAR; PG8_MMA(1, 0, At, B0); PG8_MMA(1, 1, At, B1); PG8_BAR; PG8_SCHED;
            } else {
            PG8_LDB(B0, 0, 0); PG8_SCHED; PG8_LDA(At, 0, 0); PG8_STAGE(PG8_SA(1, 1), a1 + hstepA, voffA);
            PG8_WAIT_L(8); PG8_BAR; PG8_WAIT_L(0); PG8_MMA(0, 0, At, B0); PG8_BAR; PG8_SCHED;
            PG8_LDB(B1, 0, 1); PG8_STAGE(PG8_SB(0, 0), b2, voffB);
            PG8_BAR; PG8_WAIT_L(0); PG8_MMA(0, 1, At, B1); PG8_BAR;
            PG8_LDA(At, 0, 1); PG8_STAGE(PG8_SA(0, 0), a2, voffA);
            PG8_BAR; PG8_WAIT_L(0); PG8_MMA(1, 0, At, B0); PG8_BAR; PG8_SCHED;
            PG8_STAGE(PG8_SB(0, 1), b2 + hstepB, voffB);
            PG8_WAIT_V(6); PG8_BAR; PG8_MMA(1, 1, At, B1); PG8_BAR;
            PG8_LDB(B0, 1, 0); PG8_SCHED; PG8_LDA(At, 1, 0); PG8_STAGE(PG8_SA(0, 1), a2 + hstepA, voffA);
            PG8_WAIT_L(8); PG8_BAR; PG8_WAIT_L(0); PG8_MMA(0, 0, At, B0); PG8_BAR; PG8_SCHED;
            PG8_LDB(B1, 1, 1); PG8_STAGE(PG8_SB(1, 0), b3, voffB);
            PG8_BAR; PG8_WAIT_L(0); PG8_MMA(0, 1, At, B1); PG8_BAR;
            PG8_LDA(At, 1, 1); PG8_STAGE(PG8_SA(1, 0), a3, voffA);
            PG8_BAR; PG8_WAIT_L(0); PG8_MMA(1, 0, At, B0); PG8_BAR; PG8_SCHED;
            PG8_STAGE(PG8_SB(1, 1), b3 + hstepB, voffB);
            PG8_WAIT_V(6); PG8_BAR; PG8_MMA(1, 1, At, B1); PG8_BAR;
            }
        }
        if constexpr (ALIGN_EPI) { if (wr == 0) PG8_BAR; }
        if constexpr (!Epi::AFTER_DRAIN) { int fr_ = fr, fq_ = fq; asm volatile("" : "+v"(fr_), "+v"(fq_));
            E(acc, cur, wr, wc, fr_, fq_); S.done(cur); }
        if (!has_next) break;
        if (!Epi::KEEP || nxt.ks == 0) {
#pragma unroll
        for (int a = 0; a < 2; ++a)
#pragma unroll
            for (int b = 0; b < 2; ++b)
#pragma unroll
                for (int m = 0; m < 4; ++m)
#pragma unroll
                    for (int n = 0; n < 2; ++n) acc[a][b][m][n] = (f32x4){0.f, 0.f, 0.f, 0.f};
        }
        cur = nxt; cA = nA; cB = nB; ++ui;
        if constexpr (ALIGN_EPI) { if (wr == 1) PG8_BAR; }
    }
    PG8_WAIT_V(0);
    if constexpr (!ALIGN_EPI) { if (wr == 0) PG8_BAR; }
    PG8_BAR;
#undef PG8_SA
#undef PG8_SB
#undef PG8_STAGE
#undef PG8_LDA
#undef PG8_LDB
#undef PG8_MMA
#undef PG8_WAIT_V
#undef PG8_WAIT_L
#undef PG8_BAR
#undef PG8_SCHED
}
}

#ifndef DUPSEL
#define DUPSEL 3
#endif
#ifndef TPHASE
#define TPHASE -1
#endif
#ifndef TSEL
#define TSEL 0
#endif
#ifndef TPASS
#define TPASS 3
#endif
#define TREG_W ((volatile LAS unsigned*)(lds + LDS_BYTES - 64))
#define TREG_BEGIN(id) do { if (TSEL == (id) && PASS == TPASS && tid == 0) TREG_W[6] = (unsigned)__builtin_amdgcn_s_memrealtime(); } while (0)
#define TREG_END(id) do { if (TSEL == (id) && PASS == TPASS && tid == 0) TREG_W[4] += (unsigned)__builtin_amdgcn_s_memrealtime() - TREG_W[6]; } while (0)
constexpr int NWAVES = 8;
constexpr int BATCH = 4, SEQ = 8192, D = 1024, DEPTH = 2, T = BATCH * SEQ;
constexpr int W_IN = 10768, BRW = 512;
constexpr float EPS = 1e-6f;
constexpr int GA0 = 0, GB0 = 1024, GC0 = 2560, GD0 = 5120, GG0 = 6656, NW1 = 10752;
__host__ __device__ __forceinline__ int orig_col(int j) { return j < 2560 ? j : (j < 5120 ? j + 8 : (j < 6656 ? j + 16 : j + 16)); }

constexpr size_t MiB = 1u << 20;
constexpr size_t WS_CTL = 0, CTL_ZERO_BYTES = 1 * MiB;
constexpr size_t WS_SMALL = 1 * MiB;
constexpr size_t WS_SCB = 3 * MiB, WS_SCC = WS_SCB + 16384, WS_SCD = WS_SCB + 32768;
constexpr size_t WS_RGST = WS_SCB + 65536;
constexpr size_t WS_NC = WS_SCB + 512 * 1024;
constexpr size_t WS_SSQB = 4 * MiB;
constexpr size_t WS_RSB = WS_SCB + 768 * 1024;
constexpr size_t WS_STD = 5 * MiB;
constexpr size_t WS_W1 = 16 * MiB;
constexpr size_t WS_WB = 37 * MiB;
constexpr size_t WS_WO = 41 * MiB;
constexpr size_t WS_HN = 48 * MiB;
constexpr size_t WS_Y = 112 * MiB;
constexpr size_t WS_ACT = (240 + 160) * MiB;
constexpr size_t WS_P = 240 * MiB;
constexpr size_t WS_STBC = 496 * MiB;
constexpr size_t WS_END = 512 * MiB;

constexpr int LDS_BYTES = 147456;

#define LAS __attribute__((address_space(3)))
typedef unsigned short bf16;
typedef unsigned v4u __attribute__((ext_vector_type(4)));
typedef unsigned v2u __attribute__((ext_vector_type(2)));
typedef float f32x4 __attribute__((ext_vector_type(4)));
#define LDS_WAIT() asm volatile("s_waitcnt lgkmcnt(0)" ::: "memory")

__device__ __forceinline__ unsigned pk2(float lo, float hi) { unsigned r; asm("v_cvt_pk_bf16_f32 %0, %1, %2" : "=v"(r) : "v"(lo), "v"(hi)); return r; }
__device__ __forceinline__ unsigned f2bf(float f) { return pk2(f, 0.f) & 0xffffu; }
__device__ __forceinline__ float bf2f(bf16 b) { return __uint_as_float(((unsigned)b) << 16); }
__device__ __forceinline__ float sigmoidf_(float x) { return __builtin_amdgcn_rcpf(1.0f + __expf(-x)); }
__device__ __forceinline__ float siluf_(float x) { return x * __builtin_amdgcn_rcpf(1.0f + __expf(-x)); }
__device__ __forceinline__ float log1pexp_neg(float x) {
    const float e = __expf(x); return e < 0.03125f ? e * (1.0f - e * (0.5f - e * (0.33333334f - 0.25f * e))) : __logf(1.0f + e); }
__device__ __forceinline__ float softplusf_(float x) { return fmaxf(x, 0.f) + log1pexp_neg(-fabsf(x)); }
__device__ __forceinline__ float neg_expm1_neg(float x) {
    return x > -0.03125f ? -x * (1.0f + x * (0.5f + x * (0.16666667f + 0.041666668f * x))) : 1.0f - __expf(x); }
__constant__ float ROPE_INV[32] = {1.f, 0.749894261f, 0.562341332f, 0.421696514f, 0.316227764f, 0.237137377f, 0.177827939f, 0.133352131f, 0.100000001f, 0.0749894157f, 0.0562341325f, 0.0421696529f, 0.0316227749f, 0.0237137377f, 0.0177827943f, 0.0133352149f,
    0.00999999978f, 0.00749894185f, 0.00562341325f, 0.00421696482f, 0.00316227763f, 0.00237137359f, 0.00177827943f, 0.00133352145f, 0.00100000005f, 0.000749894243f, 0.000562341302f, 0.000421696517f, 0.000316227757f, 0.00023713737f, 0.00017782794f, 0.00013335215f};
__device__ __forceinline__ float wave_sum(float v) {
#pragma unroll
    for (int o = 1; o < 64; o <<= 1) v += __shfl_xor(v, o);
    return v;
}


#define XB_TMO      128
#define XB_XCNT(j)  (256  + 64 * (j))
#define XB_XSUB(j)  (1280 + 64 * (j))
#define XB_XGEN(j)  (2304 + 64 * (j))
#define XB_TOP      3328
#define XB_TOPGEN   3392
#define XCD_BAR_WORDS 3456
#define XB_SPIN_CAP (1u << 18)
__device__ __forceinline__ unsigned xb_ld(unsigned* p)              { return __hip_atomic_load(p, __ATOMIC_RELAXED, __HIP_MEMORY_SCOPE_AGENT); }
__device__ __forceinline__ unsigned xb_add(unsigned* p, unsigned v) { return __hip_atomic_fetch_add(p, v, __ATOMIC_RELAXED, __HIP_MEMORY_SCOPE_AGENT); }
__device__ __forceinline__ unsigned xb_xcc_id() { return (unsigned)__builtin_amdgcn_s_getreg((3 << 11) | 20) & 0xFu; }
#define XB_SPIN(cond, bar) do { unsigned _sp = 0; while (cond) { __builtin_amdgcn_s_sleep(1); \
    if ((++_sp & 255u) == 0u) { if (xb_ld(&(bar)[XB_TMO])) break; if (_sp > XB_SPIN_CAP) { atomicAdd(&(bar)[XB_TMO], 1u); break; } } } } while (0)
struct XcdBarrier { unsigned* bar; unsigned x; volatile LAS unsigned* st; };
__device__ __forceinline__ XcdBarrier xcd_barrier_post(unsigned* bar, volatile LAS unsigned* st) {
    XcdBarrier b; b.bar = bar; b.x = xb_xcc_id(); b.st = st;
    if (threadIdx.x == 0) (void)xb_add(&bar[XB_XCNT(b.x)], 1u);
    return b;
}
__device__ __forceinline__ void xcd_barrier_complete(unsigned* bar, unsigned x, unsigned& nloc, unsigned& nx) {
    const unsigned G = gridDim.x * gridDim.y * gridDim.z;
    unsigned sum, cnt, mine, sp = 0u;
    for (;;) {
        sum = 0u; cnt = 0u; mine = 0u;
#pragma unroll
        for (unsigned j = 0; j < 16; ++j) { const unsigned c = xb_ld(&bar[XB_XCNT(j)]); sum += c; cnt += (c > 0u) ? 1u : 0u; mine = (j == x) ? c : mine; }
        if (sum == G) break;
        __builtin_amdgcn_s_sleep(1);
        if ((++sp & 255u) == 0u) { if (xb_ld(&bar[XB_TMO])) break; if (sp > XB_SPIN_CAP) { atomicAdd(&bar[XB_TMO], 1u); break; } }
    }
    nloc = mine > 0u ? mine : 1u; nx = cnt > 0u ? cnt : 1u;
}
__device__ __forceinline__ void xcd_barrier(unsigned* bar_, volatile LAS unsigned* st_) {
    XcdBarrier b; b.bar = bar_; b.x = xb_xcc_id(); b.st = st_;
    asm volatile("s_waitcnt vmcnt(0)" ::: "memory");
    __syncthreads();
    if (threadIdx.x == 0) {
        unsigned* bar = b.bar;
        __builtin_amdgcn_s_waitcnt(0);
        unsigned nloc = b.st[0], nx = b.st[1];
        if (nloc == 0u) { xcd_barrier_complete(bar, b.x, nloc, nx); b.st[0] = nloc; b.st[1] = nx; }
        const unsigned old = xb_add(&bar[XB_XSUB(b.x)], 1u);
        const unsigned gen = old / nloc;
        if (old + 1u == (gen + 1u) * nloc) {
            __builtin_amdgcn_fence(__ATOMIC_RELEASE, "agent");
            asm volatile("s_waitcnt vmcnt(0)" ::: "memory");
            const unsigned og = xb_add(&bar[XB_TOP], 1u);
            const unsigned tg = og / nx;
            if (og + 1u == (tg + 1u) * nx) xb_add(&bar[XB_TOPGEN], 1u);
            else XB_SPIN(xb_ld(&bar[XB_TOPGEN]) == tg, bar);
            __builtin_amdgcn_fence(__ATOMIC_ACQUIRE, "agent");
            xb_add(&bar[XB_XGEN(b.x)], 1u);
            asm volatile("s_waitcnt vmcnt(0)" ::: "memory");
        } else {
            XB_SPIN(xb_ld(&bar[XB_XGEN(b.x)]) == gen, bar);
            __builtin_amdgcn_fence(__ATOMIC_ACQUIRE, "agent");
            asm volatile("s_waitcnt vmcnt(0)" ::: "memory");
        }
    }
    __syncthreads();
}

struct Args {
    const float* in[23]; float* out; unsigned char* ws; int ph_lo, ph_hi;
};
typedef const float* cfp_t;
typedef __attribute__((address_space(4))) const cfp_t* InTab;
struct Frame {
    LAS unsigned char* lds;
    int tid, lane, wave, G, bid;
    InTab in; float* out; unsigned char* ws;
};
enum { I_X = 0, I_NORMG, I_WIN, I_ACW, I_ACB, I_AGAW, I_AGAB, I_AGXW, I_AGXB, I_ALAM, I_BCW, I_BCB, I_BDTB, I_BALOG, I_BDSKIP, I_BNORMG, I_CIB, I_CFB, I_CNORMG, I_DNORMG, I_WBR, I_WOUT, I_FNG };

__device__ __forceinline__ void transpose_item(const float* W, int ldw, int c0, int c1, const float* kscale, bf16* WT, int ldo, LAS float* scr, int k0, int lane) {
    const int sc_ = (lane & 31) < 16 ? c0 + (lane & 15) : c1 + (lane & 15);
#pragma unroll
    for (int i = 0; i < 32; ++i) { const int kk = 2 * i + (lane >> 5); float v = W[(size_t)(k0 + kk) * ldw + sc_]; if (kscale) v *= kscale[k0 + kk]; scr[kk * 33 + (lane & 31)] = v; }
    LDS_WAIT(); asm volatile("" ::: "memory");
    const int c = lane & 7;
#pragma unroll
    for (int j = 0; j < 4; ++j) { const int n = (lane >> 3) + 8 * j; const LAS float* sp = scr + (8 * c) * 33 + n;
        v4u o; o.x = pk2(sp[0 * 33], sp[1 * 33]); o.y = pk2(sp[2 * 33], sp[3 * 33]); o.z = pk2(sp[4 * 33], sp[5 * 33]); o.w = pk2(sp[6 * 33], sp[7 * 33]);
        *(v4u*)(WT + (size_t)n * ldo + k0 + 8 * c) = o; }
    LDS_WAIT(); asm volatile("" ::: "memory");
}
__device__ __forceinline__ void phase_weights(Frame& F, int layer) {
    LAS float* scr = (LAS float*)(F.lds + 65536 + F.wave * 8704);
    const int gw = F.bid * NWAVES + F.wave, NGW = F.G * NWAVES;
    const float* win = F.in[I_WIN] + (size_t)layer * D * W_IN;
    const float* wbr = F.in[I_WBR] + (size_t)layer * 4 * BRW * D;
    const float* wout = F.in[I_WOUT] + (size_t)layer * D * D;
    const float* bng = F.in[I_BNORMG] + (size_t)layer * BRW;
    bf16* W1 = (bf16*)(F.ws + WS_W1); bf16* WB = (bf16*)(F.ws + WS_WB); bf16* WO = (bf16*)(F.ws + WS_WO);
    constexpr int I1 = (D / 64) * (NW1 / 32), IB = 4 * (BRW / 64) * (D / 32), IO = (D / 64) * (D / 32);
    for (int it = gw; it < I1 + IB + IO; it += NGW) {
        int r = it;
        if (r < I1) { const int nb = r % (NW1 / 32), kb = r / (NW1 / 32); const int n0 = nb * 32;
            int c0, c1;
            if (n0 < GG0) { c0 = orig_col(n0); c1 = c0 + 16; }
            else {
                const int rel = n0 - GG0, u = rel >> 8, cl = rel & 255, bj = cl >> 7, wcg = (cl >> 5) & 3;
                c0 = 6672 + (2 * bj) * 1024 + 64 * u + 16 * wcg; c1 = c0 + 1024; }
            transpose_item(win, W_IN, c0, c1, nullptr, W1 + (size_t)n0 * D, D, scr, kb * 64, F.lane); continue; }
        r -= I1;
        if (r < IB) { const int n = r / ((BRW / 64) * (D / 32)); const int r2 = r % ((BRW / 64) * (D / 32)); const int nb = r2 % (D / 32), kb = r2 / (D / 32);
            transpose_item(wbr + (size_t)n * BRW * D, D, nb * 32, nb * 32 + 16, n == 1 ? bng : nullptr, WB + (size_t)(nb * 32) * 2048 + n * BRW, 2048, scr, kb * 64, F.lane); continue; }
        r -= IB;
        { const int nb = r % (D / 32), kb = r / (D / 32);
          transpose_item(wout, D, nb * 32, nb * 32 + 16, nullptr, WO + (size_t)(nb * 32) * D, D, scr, kb * 64, F.lane); }
    }
}
__device__ __forceinline__ void phase_prep(Frame& F, int layer, const float* xin, const bf16* delta, float* xout) {
    LAS float* tab = (LAS float*)F.lds;
    const float* win = F.in[I_WIN] + (size_t)layer * D * W_IN;
    const float* ng = F.in[I_NORMG] + (size_t)layer * D;
#pragma unroll
    for (int kk = 0; kk < 2; ++kk) { const int k = F.tid + 512 * kk; const float g = ng[k];
        const f32x4 w0 = *(const f32x4*)(win + (size_t)k * W_IN + 2560), w1 = *(const f32x4*)(win + (size_t)k * W_IN + 2564), w2 = *(const f32x4*)(win + (size_t)k * W_IN + 5128), w3 = *(const f32x4*)(win + (size_t)k * W_IN + 5132);
#pragma unroll
        for (int c = 0; c < 4; ++c) { tab[c * D + k] = w0[c] * g; tab[(4 + c) * D + k] = w1[c] * g; tab[(8 + c) * D + k] = w2[c] * g; tab[(12 + c) * D + k] = w3[c] * g; } }
    __syncthreads();
    bf16* hn = (bf16*)(F.ws + WS_HN); float* small = (float*)(F.ws + WS_SMALL);
    const int gw = F.bid * NWAVES + F.wave, NGW = F.G * NWAVES, lane = F.lane;
    constexpr int RPS = 2;
    f32x4 gv[4];
#pragma unroll
    for (int j = 0; j < 4; ++j) gv[j] = *((const f32x4*)ng + lane + 64 * j);
    for (int r0 = gw * RPS; r0 < T; r0 += NGW * RPS) {
        f32x4 v[RPS][4]; float rs[RPS];
#pragma unroll
        for (int r = 0; r < RPS; ++r)
#pragma unroll
            for (int j = 0; j < 4; ++j) v[r][j] = *((const f32x4*)(xin + (size_t)(r0 + r) * D) + lane + 64 * j);
        if (delta) {
#pragma unroll
            for (int r = 0; r < RPS; ++r)
#pragma unroll
                for (int j = 0; j < 4; ++j) { const v2u dw = *((const v2u*)(delta + (size_t)(r0 + r) * D) + lane + 64 * j);
                    v[r][j].x += pg8::bf_lo(dw.x); v[r][j].y += pg8::bf_hi(dw.x); v[r][j].z += pg8::bf_lo(dw.y); v[r][j].w += pg8::bf_hi(dw.y);
                    *((f32x4*)(xout + (size_t)(r0 + r) * D) + lane + 64 * j) = v[r][j]; }
        }
#pragma unroll
        for (int r = 0; r < RPS; ++r) { float s_ = 0.f;
#pragma unroll
            for (int j = 0; j < 4; ++j) s_ += (v[r][j].x * v[r][j].x + v[r][j].y * v[r][j].y) + (v[r][j].z * v[r][j].z + v[r][j].w * v[r][j].w);
            rs[r] = 1.0f / sqrtf(wave_sum(s_) * (1.f / D) + EPS);
            unsigned long long* o8 = (unsigned long long*)(hn + (size_t)(r0 + r) * D) + lane;
#pragma unroll
            for (int j = 0; j < 4; ++j) { const f32x4 h = v[r][j] * rs[r] * gv[j];
                o8[64 * j] = (unsigned long long)pk2(h.x, h.y) | ((unsigned long long)pk2(h.z, h.w) << 32); } }
#pragma unroll
        for (int h = 0; h < 2; ++h) {
            float a[RPS][8];
#pragma unroll
            for (int c = 0; c < 8; ++c) {
#pragma unroll
                for (int r = 0; r < RPS; ++r) a[r][c] = 0.f;
#pragma unroll
                for (int j = 0; j < 4; ++j) { const f32x4 w = *((const LAS f32x4*)(tab + (8 * h + c) * D) + lane + 64 * j);
#pragma unroll
                    for (int r = 0; r < RPS; ++r) a[r][c] += (v[r][j].x * w.x + v[r][j].y * w.y) + (v[r][j].z * w.z + v[r][j].w * w.w); }
                if ((c & 1) == 1) asm volatile("" ::: "memory"); }
#pragma unroll
            for (int r = 0; r < RPS; ++r) {
#pragma unroll
                for (int i = 0; i < 4; ++i) { const bool hi = (lane & 32) != 0; const float keep = hi ? a[r][i + 4] : a[r][i], send = hi ? a[r][i] : a[r][i + 4]; a[r][i] = keep + __shfl_xor(send, 32); }
#pragma unroll
                for (int i = 0; i < 2; ++i) { const bool hi = (lane & 16) != 0; const float keep = hi ? a[r][i + 2] : a[r][i], send = hi ? a[r][i] : a[r][i + 2]; a[r][i] = keep + __shfl_xor(send, 16); }
                { const bool hi = (lane & 8) != 0; const float keep = hi ? a[r][1] : a[r][0], send = hi ? a[r][0] : a[r][1]; a[r][0] = keep + __shfl_xor(send, 8); }
                a[r][0] += __shfl_xor(a[r][0], 4); a[r][0] += __shfl_xor(a[r][0], 2); a[r][0] += __shfl_xor(a[r][0], 1);
                if ((lane & 7) == 0) small[(size_t)(r0 + r) * 16 + 8 * h + (((lane >> 5) & 1) * 4 + ((lane >> 4) & 1) * 2 + ((lane >> 3) & 1))] = a[r][0] * rs[r];
            }
        }
    }
    __syncthreads();
}

namespace gla {
typedef short bf16x8 __attribute__((ext_vector_type(8)));
constexpr int P64 = 144;
constexpr int NCHUNK = SEQ / 64;
template <int KIND> struct GC;
template <> struct GC<0> { static constexpr int DK = 128, DV = 64,  PLD = 2560, PCOL = 1024, SLD = 1024, NH = 8, NCH = 8; };
template <> struct GC<1> { static constexpr int DK = 128, DV = 128, PLD = 4096, PCOL = 0, SLD = 4096, NH = 4, NCH = 8; };
template <> struct GC<2> { static constexpr int DK = 64,  DV = 128, PLD = 4096, PCOL = 2560, SLD = 4096, NH = 4, NCH = 8; };
template <int KIND> struct Lay {
    using C = GC<KIND>;
    static constexpr int PK = C::DK * 2 + 16;
    static constexpr int RP = KIND == 0 ? 144 : (KIND == 1 ? 272 : 528), RAWB = 64 * RP;
    static constexpr int Q = 0, KN = Q + 64 * PK, KUT = KN + 64 * PK, VT = KUT + C::DK * P64, XT = VT + C::DV * P64,
        PM = XT + (KIND == 0 ? C::DV * P64 : 0), ST = PM + 64 * P64, RAW = PM,
        SC = PM + ((64 * P64 + C::DV * PK) > RAWB ? (64 * P64 + C::DV * PK) : RAWB), END = SC + 8192;
    template <int PASS> static constexpr int npf() { return KIND == 0 ? (PASS == 3 ? 5 : 3) : (KIND == 1 ? (PASS == 3 ? 6 : 4) : (PASS == 3 ? 4 : 3)); }
    static constexpr int NTK = C::DK / 16, NTV = C::DV / 16, NKB = C::DK / 32, TKW = 2, TVW = NTK * NTV / 16, NWV = NTV / TVW;
    static constexpr int NREG = TKW * TVW * 4, NREGX = NREG, NEL = NREGX * 512;
    static constexpr int NSC = NCHUNK / C::NCH, NITEMS = BATCH * C::NH * NSC;
    static_assert(END <= LDS_BYTES - 64, "LDS");
    static_assert(64 * (KIND == 0 ? 40 : (KIND == 1 ? 48 : 32)) == 512 * npf<3>() && 64 * (KIND == 0 ? 24 : (KIND == 1 ? 32 : 24)) == 512 * npf<1>(), "every thread owns exactly npf pieces");
};
enum { S_ROWF = 0, S_COLF = 64, S_INTER = 128, S_U = 192, S_DT = 256, S_EINV = 320, S_QN = 448, S_RED = 512, S_NVEC = 768, S_MISC = 896, S_ROWSUM = 1024  , S_G = 1280  , S_NACC = 1408   };

__device__ __forceinline__ bf16x8 ldf(LAS const unsigned char* base, int pitch, int row, int kel) { return *(LAS const bf16x8*)(base + row * pitch + kel * 2); }
__device__ __forceinline__ v4u pack8(const float (&v)[8]) { v4u o; o.x = pk2(v[0], v[1]); o.y = pk2(v[2], v[3]); o.z = pk2(v[4], v[5]); o.w = pk2(v[6], v[7]); return o; }
__device__ __forceinline__ float bfround(float f) { return __uint_as_float(f2bf(f) << 16); }


template <int CTRL, int RMASK> __device__ __forceinline__ float dpp_f(float ident, float v) { return __uint_as_float(__builtin_amdgcn_update_dpp(__float_as_uint(ident), __float_as_uint(v), CTRL, RMASK, 0xf, false)); }
#define DPP_SCAN(v, OP, IDENT) do { \
    v = OP(v, dpp_f<0x111, 0xf>(IDENT, v)); v = OP(v, dpp_f<0x112, 0xf>(IDENT, v)); v = OP(v, dpp_f<0x114, 0xf>(IDENT, v)); v = OP(v, dpp_f<0x118, 0xf>(IDENT, v)); \
    v = OP(v, dpp_f<0x142, 0xa>(IDENT, v)); v = OP(v, dpp_f<0x143, 0xc>(IDENT, v)); } while (0)
__device__ __forceinline__ float op_add(float a, float b) { return a + b; }
__device__ __forceinline__ float op_max(float a, float b) { return fmaxf(a, b); }

template <int KIND, int PASS>
__device__ __forceinline__ void raw_piece(int tid, int i, int head, int& goff, int& loff) {
    using C = GC<KIND>; using LY = Lay<KIND>;
    constexpr int PK = LY::PK, RP = LY::RP, SLD = C::SLD;
    if (KIND == 0) {
        const int seg = PASS == 3 ? (i >> 1) : 1 + ((i + 0) >> 1), g = head >> 2;
        if (seg < 2) { const int idx = tid + 512 * (i & 1), r = idx >> 4, c8 = idx & 15;
            goff = r * SLD + (seg == 0 ? 768 : 512) + g * 128 + c8 * 8; loff = (seg == 0 ? LY::Q : LY::KN) + r * PK + c8 * 16; }
        else { const int r = tid >> 3, c8 = tid & 7; goff = r * SLD + head * 64 + c8 * 8; loff = LY::RAW + r * RP + c8 * 16; } }
    if (KIND == 1) {
        const int seg = (PASS == 3 ? 0 : 1) + (i >> 1); const int idx = tid + 512 * (i & 1), r = idx >> 4, c8 = idx & 15;
        goff = r * SLD + seg * 512 + head * 128 + c8 * 8;
        loff = seg == 0 ? LY::Q + r * PK + c8 * 16 : (seg == 1 ? LY::KN + r * PK + c8 * 16 : LY::RAW + r * RP + c8 * 16); }
    if (KIND == 2) {
        const int ii = PASS == 3 ? i : i + 1;
        if (ii < 2) { const int r = tid >> 3, c8 = tid & 7; goff = r * SLD + (ii == 0 ? 0 : 256) + head * 64 + c8 * 8; loff = LY::RAW + r * RP + (ii * 8 + c8) * 16; }
        else { const int idx = tid + 512 * (ii & 1), r = idx >> 4, c8 = idx & 15; goff = r * SLD + 512 + head * 128 + c8 * 8; loff = LY::RAW + r * RP + (16 + c8) * 16; } }
}
#define GLA_LOAD_ZO(ROW0) do { const int n_ = w & 3, mh_ = w >> 2, l_ = n_ * 16 + c; \
        _Pragma("unroll") for (int mm = 0; mm < NM; ++mm) { const int dv0_ = (mh_ * NM + mm) * 16 + 4 * q; \
            const int zc_ = KIND == 0 ? 1024 + head * 64 : (KIND == 1 ? 2048 + head * 128 : 1024 + head * 128); \
            zpf[mm] = *(const v2u*)(P + ((ROW0) + l_) * PLD + zc_ + dv0_); \
            if (KIND == 1) opf[mm] = *(const v2u*)(P + ((ROW0) + l_) * PLD + 1536 + head * 128 + dv0_); } } while (0)
template <int KIND, int PASS>
__device__ __forceinline__ void gla_item(Frame& F, int layer, int b, int head, int j, float* stbase, float* scbase, float* nbase, float* ssqB) {
    using C = GC<KIND>; using LY = Lay<KIND>;
    constexpr int DK = C::DK, DV = C::DV, PK = LY::PK, PLD = C::PLD, NKB = LY::NKB, TKW = LY::TKW, TVW = LY::TVW, NWV = LY::NWV, NM = LY::NTV / 2, NREG = LY::NREG;
    constexpr int RP = LY::RP, NPF = LY::template npf<PASS>();
    LAS unsigned char* const lds = F.lds;
    LAS float* const sc = (LAS float*)(lds + LY::SC);
    const int tid = F.tid, lane = F.lane, w = F.wave, c = lane & 15, q = lane >> 4;
    const int wk = w / NWV, wv = w % NWV;
    const bf16* P = (const bf16*)(F.ws + WS_P) + C::PCOL;
    const bf16* PS = KIND == 0 ? (const bf16*)(F.ws + WS_ACT) : P;
    constexpr int SLD = C::SLD;
    const float* small = (const float*)(F.ws + WS_SMALL);
    const int chain = b * C::NH + head, sl = chain * LY::NSC + j;
    TREG_BEGIN(1);
    __syncthreads();
    float* const stp = stbase + (size_t)sl * LY::NEL + tid;
    f32x4 st[TKW][TVW];
    float nreg = 0.f, mp = 0.f, asum = 0.f;
    if (PASS == 3) {
#pragma unroll
        for (int a = 0; a < TKW; ++a)
#pragma unroll
            for (int bb = 0; bb < TVW; ++bb)
#pragma unroll
                for (int r = 0; r < 4; ++r) st[a][bb][r] = stp[(size_t)((a * TVW + bb) * 4 + r) * 512];
        if (KIND == 1) { if (tid < 128) nreg = nbase[sl * 128 + tid]; mp = scbase[sl * 4 + 2]; }
    } else {
#pragma unroll
        for (int a = 0; a < TKW; ++a)
#pragma unroll
            for (int bb = 0; bb < TVW; ++bb) st[a][bb] = (f32x4){0.f, 0.f, 0.f, 0.f};
        if (KIND == 1) mp = -1e30f;
    }
    float dtb = 0.f, Aneg = 0.f, Dsk = 0.f, ib = 0.f, fb = 0.f, logg = 0.f, inv = 0.f, cd = 1.f, sd = 0.f;
    if (KIND == 0) {
        dtb = F.in[I_BDTB][layer * 8 + head]; Aneg = -__expf(F.in[I_BALOG][layer * 8 + head]); Dsk = F.in[I_BDSKIP][layer * 8 + head];
    }
    if (KIND == 1) { ib = F.in[I_CIB][layer * 4 + head]; fb = F.in[I_CFB][layer * 4 + head]; }
    if (PASS == 3 && KIND != 0 && tid < 128) sc[S_G + tid] = F.in[KIND == 1 ? I_CNORMG : I_DNORMG][layer * BRW + head * 128 + tid];
    if (KIND == 2) { logg = head == 0 ? -0.0317486983f : (head == 1 ? -0.0157483570f : (head == 2 ? -0.00784317746f : -0.00391389932f));
        inv = ROPE_INV[tid & 31]; cd = __cosf(inv); sd = __sinf(inv); }
    v4u pf[NPF];
    float spf0 = 0.f, spf1 = 0.f;
    {
        const int cg = j * C::NCH; const size_t row0 = (size_t)b * SEQ + (size_t)cg * 64;
        if (w == 0) { if (KIND == 0) spf0 = small[(row0 + lane) * 16 + head]; if (KIND == 1) { spf0 = small[(row0 + lane) * 16 + 8 + head]; spf1 = small[(row0 + lane) * 16 + 12 + head]; } }
#pragma unroll
        for (int i = 0; i < NPF; ++i) { int go, lo; raw_piece<KIND, PASS>(tid, i, head, go, lo); pf[i] = *(const v4u*)(PS + (ptrdiff_t)row0 * SLD + go); }
    }

    v2u zpf[NM], opf[NM];
    if (PASS == 3) { const size_t r0_ = (size_t)b * SEQ + (size_t)(j * C::NCH) * 64; GLA_LOAD_ZO(r0_); }

    TREG_END(1);
    for (int ci = 0; ci < C::NCH; ++ci) {
        const int cg = j * C::NCH + ci; const size_t row0 = (size_t)b * SEQ + (size_t)cg * 64;
        TREG_BEGIN(2);
        int tl = tid; asm volatile("" : "+v"(tl));
#pragma unroll
        for (int i = 0; i < NPF; ++i) { int go, lo; raw_piece<KIND, PASS>(tl, i, head, go, lo); *(LAS v4u*)(lds + lo) = pf[i]; }
        const float cur0 = spf0, cur1 = spf1;
        if (ci + 1 < C::NCH) {
            if (w == 0) { if (KIND == 0) spf0 = small[(row0 + 64 + lane) * 16 + head]; if (KIND == 1) { spf0 = small[(row0 + 64 + lane) * 16 + 8 + head]; spf1 = small[(row0 + 64 + lane) * 16 + 12 + head]; } }
#pragma unroll
            for (int i = 0; i < NPF; ++i) { int go, lo; raw_piece<KIND, PASS>(tl, i, head, go, lo); pf[i] = *(const v4u*)(PS + (ptrdiff_t)(row0 + 64) * SLD + go); } }
        if (w == 0) {
            float a = 0.f, li = 0.f, dtv = 0.f;
            if (KIND == 0) { dtv = softplusf_(cur0 + dtb); a = Aneg * dtv; }
            if (KIND == 1) { li = cur0 + ib; a = -softplusf_(-(cur1 + fb)); }
            if (KIND == 2) a = logg;
            float acs = a; DPP_SCAN(acs, op_add, 0.f);
            const float a63 = __uint_as_float(__builtin_amdgcn_readlane(__float_as_uint(acs), 63));
            float mrow = 0.f, mn = 0.f;
            if (KIND == 1) { float cm = li - acs; DPP_SCAN(cm, op_max, -3.0e38f);
                mrow = acs + fmaxf(mp, cm); mn = __uint_as_float(__builtin_amdgcn_readlane(__float_as_uint(mrow), 63)); }
            sc[S_ROWF + lane] = acs - mrow; sc[S_COLF + lane] = li - acs;
            sc[S_INTER + lane] = __expf(acs + mp - mrow);
            sc[S_U + lane] = __expf(a63 - acs + li - mn);
            if (KIND == 0) sc[S_DT + lane] = dtv;
            if (KIND == 1) sc[S_EINV + lane] = __expf(-mrow);
            if (lane == 0) sc[S_MISC] = __expf(a63 + mp - mn);
            if (KIND == 1) mp = mn;
            asum += a63;
        }
        __syncthreads();
        TREG_END(2); TREG_BEGIN(3);
        const float sdec = sc[S_MISC];
        if (KIND == 0 || KIND == 1) {
            {
                const int dk = tid & 127, rq = tid >> 7; float nsum = 0.f;
                if (KIND == 1 && PASS == 3 && tid < 128) sc[S_NVEC + tid] = nreg;
#pragma unroll 1
                for (int g = 0; g < 2; ++g) {
                    const f32x4 u0 = *(const LAS f32x4*)(sc + S_U + rq * 16 + 8 * g), u1 = *(const LAS f32x4*)(sc + S_U + rq * 16 + 8 * g + 4);
                    float ku[8];
#pragma unroll
                    for (int e = 0; e < 8; ++e) { const float kf = bf2f(*(const LAS bf16*)(lds + LY::KN + (rq * 16 + 8 * g + e) * PK + dk * 2)) * (KIND == 1 ? 0.08838834764831845f : 1.0f);
                        ku[e] = kf * (e < 4 ? u0[e & 3] : u1[e & 3]); nsum += ku[e]; }
                    *(LAS v4u*)(lds + LY::KUT + dk * P64 + rq * 32 + g * 16) = pack8(ku);
                }
                if (KIND == 1) sc[S_NACC + rq * 128 + dk] = nsum;
            }
            if (KIND == 0) { if (tid < 256) {
                const int dv = tid & 63, rq = tid >> 6;
#pragma unroll 1
                for (int g = 0; g < 2; ++g) {
                    const f32x4 u0 = *(const LAS f32x4*)(sc + S_DT + rq * 16 + 8 * g), u1 = *(const LAS f32x4*)(sc + S_DT + rq * 16 + 8 * g + 4);
                    float va[8], vb[8];
#pragma unroll
                    for (int e = 0; e < 8; ++e) { va[e] = bf2f(*(const LAS bf16*)(lds + LY::RAW + (rq * 16 + 8 * g + e) * RP + dv * 2)); vb[e] = va[e] * (e < 4 ? u0[e & 3] : u1[e & 3]); }
                    *(LAS v4u*)(lds + LY::VT + dv * P64 + rq * 32 + g * 16) = pack8(vb);
                    if (PASS == 3) *(LAS v4u*)(lds + LY::XT + dv * P64 + rq * 32 + g * 16) = pack8(va);
                } } }
            else {
                const int dv = tid & 127, rq = tid >> 7;
#pragma unroll 1
                for (int g = 0; g < 2; ++g) { unsigned r[8];
#pragma unroll
                    for (int e = 0; e < 8; ++e) r[e] = *(const LAS bf16*)(lds + LY::RAW + (rq * 16 + 8 * g + e) * RP + dv * 2);
                    v4u o; o.x = r[0] | (r[1] << 16); o.y = r[2] | (r[3] << 16); o.z = r[4] | (r[5] << 16); o.w = r[6] | (r[7] << 16);
                    *(LAS v4u*)(lds + LY::VT + dv * P64 + rq * 32 + g * 16) = o; }
            }
        }
        if (KIND == 2) {
            if (tid < 256) {
                const int jj = tid & 31, lq = tid >> 6; const bool isK = (tid >> 5) & 1;
                if (PASS == 3 || isK) {
                    const LAS unsigned char* rp = lds + LY::RAW + ((isK ? 64 : 0) + jj) * 2;
                    LAS unsigned char* nat = lds + (isK ? LY::KN : LY::Q);
                    const float ang = (float)(cg * 64 + lq * 16) * inv;
                    double ad = (double)ang; ad -= 6.283185307179586476925286766559 * rint(ad * 0.15915494309189533576888376337251);
                    const float ar = (float)ad; float cs = __cosf(ar), sn = __sinf(ar);
#pragma unroll
                    for (int g = 0; g < 2; ++g) {
                        const f32x4 u0 = *(const LAS f32x4*)(sc + S_U + lq * 16 + 8 * g), u1 = *(const LAS f32x4*)(sc + S_U + lq * 16 + 8 * g + 4);
                        float k1[8], k2[8];
#pragma unroll
                        for (int e = 0; e < 8; ++e) { const int l = lq * 16 + 8 * g + e;
                            const float x1 = bf2f(*(const LAS bf16*)(rp + l * RP)), x2 = bf2f(*(const LAS bf16*)(rp + l * RP + 64));
                            float o1 = x1 * cs - x2 * sn, o2 = x1 * sn + x2 * cs;
                            const float cn = cs * cd - sn * sd; sn = sn * cd + cs * sd; cs = cn;
                            if (isK) { o1 *= 0.125f; o2 *= 0.125f; }
                            if (PASS == 3) { *(LAS bf16*)(nat + l * PK + jj * 2) = (bf16)f2bf(o1); *(LAS bf16*)(nat + l * PK + (jj + 32) * 2) = (bf16)f2bf(o2); }
                            const float uu = e < 4 ? u0[e & 3] : u1[e & 3]; k1[e] = o1 * uu; k2[e] = o2 * uu; }
                        if (isK) { *(LAS v4u*)(lds + LY::KUT + jj * P64 + lq * 32 + g * 16) = pack8(k1); *(LAS v4u*)(lds + LY::KUT + (jj + 32) * P64 + lq * 32 + g * 16) = pack8(k2); }
                    }
                }
            }
            {
                const int dv = tid & 127, rq = tid >> 7;
#pragma unroll
                for (int g = 0; g < 2; ++g) { unsigned r[8];
#pragma unroll
                    for (int e = 0; e < 8; ++e) r[e] = *(const LAS bf16*)(lds + LY::RAW + (rq * 16 + 8 * g + e) * RP + (128 + dv) * 2);
                    v4u o; o.x = r[0] | (r[1] << 16); o.y = r[2] | (r[3] << 16); o.z = r[4] | (r[5] << 16); o.w = r[6] | (r[7] << 16);
                    *(LAS v4u*)(lds + LY::VT + dv * P64 + rq * 32 + g * 16) = o; }
            }
        }
        __syncthreads();
        TREG_END(3); TREG_BEGIN(4);
        if (KIND == 1 && tid < 128) nreg = sdec * nreg + ((sc[S_NACC + tid] + sc[S_NACC + 128 + tid]) + (sc[S_NACC + 256 + tid] + sc[S_NACC + 384 + tid]));
        f32x4 aD[NM], aI[NM];
        if (PASS == 3) {
            { const int ts = w >> 1, tl0 = 2 * (w & 1);
              f32x4 sacc[2] = {(f32x4){0.f, 0.f, 0.f, 0.f}, (f32x4){0.f, 0.f, 0.f, 0.f}};
#pragma unroll
              for (int kb = 0; kb < NKB; ++kb) { const bf16x8 xf = ldf(lds + LY::KN, PK, ts * 16 + c, kb * 32 + q * 8);
#pragma unroll
                  for (int i = 0; i < 2; ++i) { const bf16x8 yf = ldf(lds + LY::Q, PK, (tl0 + i) * 16 + c, kb * 32 + q * 8); sacc[i] = __builtin_amdgcn_mfma_f32_16x16x32_bf16(xf, yf, sacc[i], 0, 0, 0); } }
              const f32x4 cf = *(const LAS f32x4*)(sc + S_COLF + ts * 16 + 4 * q);
              const float ksc = KIND == 1 ? 0.08838834764831845f : 1.0f;
#pragma unroll
              for (int i = 0; i < 2; ++i) { const int l = (tl0 + i) * 16 + c; const float rf = sc[S_ROWF + l];
                  float p[4];
#pragma unroll
                  for (int r = 0; r < 4; ++r) { const int s = ts * 16 + 4 * q + r; const float wgt = (s <= l) ? __expf(rf + cf[r]) * ksc : 0.f; p[r] = sacc[i][r] * wgt; }
                  v2u o; o.x = pk2(p[0], p[1]); o.y = pk2(p[2], p[3]);
                  *(LAS v2u*)(lds + LY::PM + l * P64 + (ts * 16 + 4 * q) * 2) = o;
                  if (KIND == 1) { float ps = (bfround(p[0]) + bfround(p[1])) + (bfround(p[2]) + bfround(p[3])); ps += __shfl_xor(ps, 16); ps += __shfl_xor(ps, 32);
                      if (q == 0) sc[S_ROWSUM + ts * 64 + l] = ps; } } }
#pragma unroll
            for (int a = 0; a < TKW; ++a)
#pragma unroll
                for (int bb = 0; bb < TVW; ++bb) { const int dv = (wv * TVW + bb) * 16 + c, dk0 = (wk * TKW + a) * 16 + 4 * q;
                    v2u o; o.x = pk2(st[a][bb][0], st[a][bb][1]); o.y = pk2(st[a][bb][2], st[a][bb][3]);
                    *(LAS v2u*)(lds + LY::ST + dv * PK + dk0 * 2) = o; }
            if (KIND == 1) { const int l = tid >> 3, part = tid & 7; float a = 0.f;
                const v4u qa = *(const LAS v4u*)(lds + LY::Q + l * PK + part * 32), qb = *(const LAS v4u*)(lds + LY::Q + l * PK + part * 32 + 16);
                const unsigned qw[8] = {qa.x, qa.y, qa.z, qa.w, qb.x, qb.y, qb.z, qb.w};
#pragma unroll
                for (int i = 0; i < 8; ++i) a += pg8::bf_lo(qw[i]) * sc[S_NVEC + part * 16 + 2 * i] + pg8::bf_hi(qw[i]) * sc[S_NVEC + part * 16 + 2 * i + 1];
                a += __shfl_xor(a, 1); a += __shfl_xor(a, 2); a += __shfl_xor(a, 4);
                if (part == 0) sc[S_QN + l] = a; }
            __syncthreads();
            TREG_END(4); TREG_BEGIN(5);
            { const int n = w & 3, mh = w >> 2;
#pragma unroll
              for (int mm = 0; mm < NM; ++mm) { aD[mm] = (f32x4){0.f, 0.f, 0.f, 0.f}; aI[mm] = (f32x4){0.f, 0.f, 0.f, 0.f}; }
#pragma unroll
              for (int kb = 0; kb < 2; ++kb) { const bf16x8 yf = ldf(lds + LY::PM, P64, n * 16 + c, kb * 32 + q * 8);
#pragma unroll
                  for (int mm = 0; mm < NM; ++mm) { const bf16x8 xf = ldf(lds + LY::VT, P64, (mh * NM + mm) * 16 + c, kb * 32 + q * 8); aD[mm] = __builtin_amdgcn_mfma_f32_16x16x32_bf16(xf, yf, aD[mm], 0, 0, 0); } }
#pragma unroll
              for (int kb = 0; kb < NKB; ++kb) { const bf16x8 yf = ldf(lds + LY::Q, PK, n * 16 + c, kb * 32 + q * 8);
#pragma unroll
                  for (int mm = 0; mm < NM; ++mm) { const bf16x8 xf = ldf(lds + LY::ST, PK, (mh * NM + mm) * 16 + c, kb * 32 + q * 8); aI[mm] = __builtin_amdgcn_mfma_f32_16x16x32_bf16(xf, yf, aI[mm], 0, 0, 0); } } }
        }
#pragma unroll
        for (int a = 0; a < TKW; ++a)
#pragma unroll
            for (int bb = 0; bb < TVW; ++bb) st[a][bb] *= sdec;
#pragma unroll
        for (int kb = 0; kb < 2; ++kb) { bf16x8 xf[TKW];
#pragma unroll
            for (int a = 0; a < TKW; ++a) xf[a] = ldf(lds + LY::KUT, P64, (wk * TKW + a) * 16 + c, kb * 32 + q * 8);
#pragma unroll
            for (int bb = 0; bb < TVW; ++bb) { const bf16x8 yf = ldf(lds + LY::VT, P64, (wv * TVW + bb) * 16 + c, kb * 32 + q * 8);
#pragma unroll
                for (int a = 0; a < TKW; ++a) st[a][bb] = __builtin_amdgcn_mfma_f32_16x16x32_bf16(xf[a], yf, st[a][bb], 0, 0, 0); } }
        TREG_END(5); TREG_BEGIN(6);
        if (PASS == 3) {
            const int n = w & 3, mh = w >> 2, l = n * 16 + c; const float inter = sc[S_INTER + l];
            const size_t grow = row0 + l;
            if (KIND == 0) {
                bf16* Y = (bf16*)(F.ws + WS_Y); float ssq = 0.f;
#pragma unroll
                for (int mm = 0; mm < NM; ++mm) { const int dv0 = (mh * NM + mm) * 16 + 4 * q;
                    const v2u zw = zpf[mm];
                    const float zf[4] = {pg8::bf_lo(zw.x), pg8::bf_hi(zw.x), pg8::bf_lo(zw.y), pg8::bf_hi(zw.y)};
                    float o[4];
#pragma unroll
                    for (int r = 0; r < 4; ++r) { const float xv = bf2f(*(const LAS bf16*)(lds + LY::XT + (dv0 + r) * P64 + l * 2));
                        o[r] = bfround((aD[mm][r] + inter * aI[mm][r] + Dsk * xv) * siluf_(zf[r])); ssq += o[r] * o[r]; }
                    v2u ow; ow.x = pk2(o[0], o[1]); ow.y = pk2(o[2], o[3]);
                    *(v2u*)(Y + grow * 2048 + 512 + head * 64 + dv0) = ow; }
                ssq += __shfl_xor(ssq, 16); ssq += __shfl_xor(ssq, 32);
                const int par = ci & 1;
                if (q == 0) sc[S_RED + par * 128 + mh * 64 + l] = ssq;
                __syncthreads();
                if (mh == 0 && q == 0) ssqB[grow * 8 + head] = sc[S_RED + par * 128 + l] + sc[S_RED + par * 128 + 64 + l];
                if (ci + 1 < C::NCH) GLA_LOAD_ZO(row0 + 64);
            } else {
                float dinv = 1.0f;
                if (KIND == 1) { const float den = ((sc[S_ROWSUM + l] + sc[S_ROWSUM + 64 + l]) + (sc[S_ROWSUM + 128 + l] + sc[S_ROWSUM + 192 + l])) + inter * sc[S_QN + l]; dinv = 1.0f / fmaxf(fabsf(den), sc[S_EINV + l]); }
                float hv[NM][4]; float ssq = 0.f;
#pragma unroll
                for (int mm = 0; mm < NM; ++mm) {
                    float og[4] = {1.f, 1.f, 1.f, 1.f};
                    if (KIND == 1) { const v2u ow = opf[mm];
                        og[0] = sigmoidf_(pg8::bf_lo(ow.x)); og[1] = sigmoidf_(pg8::bf_hi(ow.x)); og[2] = sigmoidf_(pg8::bf_lo(ow.y)); og[3] = sigmoidf_(pg8::bf_hi(ow.y)); }
#pragma unroll
                    for (int r = 0; r < 4; ++r) { hv[mm][r] = (aD[mm][r] + inter * aI[mm][r]) * dinv * og[r]; ssq += hv[mm][r] * hv[mm][r]; } }
                ssq += __shfl_xor(ssq, 16); ssq += __shfl_xor(ssq, 32);
                const int par = ci & 1;
                if (q == 0) sc[S_RED + par * 128 + mh * 64 + l] = ssq;
                __syncthreads();
                const float tot = sc[S_RED + par * 128 + l] + sc[S_RED + par * 128 + 64 + l];
                const float rs = 1.0f / sqrtf(tot * (1.f / 128.f) + EPS);
                const int ycol = KIND == 1 ? 1024 : 1536;
                bf16* Y = (bf16*)(F.ws + WS_Y);
#pragma unroll
                for (int mm = 0; mm < NM; ++mm) { const int dv0 = (mh * NM + mm) * 16 + 4 * q;
                    const v2u zw = zpf[mm];
                    const f32x4 gv = *(const LAS f32x4*)(sc + S_G + dv0);
                    const float o0 = hv[mm][0] * rs * gv[0] * siluf_(pg8::bf_lo(zw.x)), o1 = hv[mm][1] * rs * gv[1] * siluf_(pg8::bf_hi(zw.x));
                    const float o2 = hv[mm][2] * rs * gv[2] * siluf_(pg8::bf_lo(zw.y)), o3 = hv[mm][3] * rs * gv[3] * siluf_(pg8::bf_hi(zw.y));
                    v2u o; o.x = pk2(o0, o1); o.y = pk2(o2, o3);
                    *(v2u*)(Y + grow * 2048 + ycol + head * 128 + dv0) = o; }
                if (ci + 1 < C::NCH) GLA_LOAD_ZO(row0 + 64);
            }
        } else {
            __syncthreads();
        }
        TREG_END(6);
    }
    if (PASS == 1) {
#pragma unroll
        for (int a = 0; a < TKW; ++a)
#pragma unroll
            for (int bb = 0; bb < TVW; ++bb)
#pragma unroll
                for (int r = 0; r < 4; ++r) stp[(size_t)((a * TVW + bb) * 4 + r) * 512] = st[a][bb][r];
        if (KIND == 1 && tid < 128) nbase[sl * 128 + tid] = nreg;
        if (tid == 0) { scbase[sl * 4 + 0] = asum; scbase[sl * 4 + 1] = mp; }
    }
}
template <int KIND>
__device__ __forceinline__ void scan_part(Frame& F, float* stbase, float* scbase, float* nbase) {
    using C = GC<KIND>; using LY = Lay<KIND>;
    const int total = BATCH * C::NH * LY::NEL + (KIND == 1 ? BATCH * C::NH * 128 : 0);
    for (int idx = F.bid * (NWAVES * 64) + F.tid; idx < total; idx += F.G * NWAVES * 64) {
        const bool isn = idx >= BATCH * C::NH * LY::NEL;
        const int i2 = isn ? idx - BATCH * C::NH * LY::NEL : idx, per = isn ? 128 : LY::NEL;
        const int chain = i2 / per, e = i2 % per;
        float* base = isn ? nbase : stbase;
        float start = 0.f, m = 0.f;
        for (int j = 0; j < LY::NSC; ++j) { const int sl = chain * LY::NSC + j; const float A = scbase[sl * 4];
            float fo, fl;
            if (KIND == 1) { const float ml = scbase[sl * 4 + 1], mnew = fmaxf(A + m, ml); fo = __expf(A + m - mnew); fl = __expf(ml - mnew); if (e == 0 && !isn) scbase[sl * 4 + 2] = m; m = mnew; }
            else { fo = __expf(A); fl = 1.f; }
            const float loc = base[(size_t)sl * per + e]; base[(size_t)sl * per + e] = start; start = fo * start + fl * loc; }
    }
}
}

namespace rg {
using gla::ldf; using gla::pack8; using gla::P64; using gla::bf16x8;
constexpr int NCH = 8, NSC = gla::NCHUNK / NCH, NITEMS = BATCH * 8 * NSC;
constexpr int PLD = 2560, PCOL = 0;
constexpr int L_WA = 0, L_WX = 9216, L_XB = 18432, L_XF = 27648, L_A = L_XF + 16384, L_D = L_A + 17408, L_RU = L_D + 17408, L_RZ = L_RU + 67 * 144, L_YT = L_RZ + 64 * 144, L_SG = L_YT + 8192, L_END = L_SG + 4352;
static_assert(L_END <= LDS_BYTES - 64 && L_RU % 16 == 0 && L_RZ % 16 == 0 && L_YT % 16 == 0, "LDS");
template <int PASS> __device__ __forceinline__ void raw_piece(int tid, int i, int hb, int& goff, int& loff) {
    int idx = tid + 512 * i; const int npieces = PASS == 3 ? 1048 : 536; if (idx >= npieces) idx -= 512;
    if (idx < 536) { const int r = idx >> 3, c8 = idx & 7; goff = (r - 3) * PLD + hb * 64 + c8 * 8; loff = L_RU + r * 144 + c8 * 16; }
    else { const int i2 = idx - 536, r = i2 >> 3, c8 = i2 & 7; goff = r * PLD + 512 + hb * 64 + c8 * 8; loff = L_RZ + r * 144 + c8 * 16; }
}
template <int PASS>
__device__ __forceinline__ void item(Frame& F, int layer, int b, int hb, int j, float* stA) {
    constexpr int NPF = PASS == 3 ? 3 : 2;
    LAS unsigned char* const lds = F.lds;
    const int tid = F.tid, lane = F.lane, w = F.wave, c = lane & 15, q = lane >> 4;
    const bf16* P = (const bf16*)(F.ws + WS_P) + PCOL; bf16* Y = (bf16*)(F.ws + WS_Y);
    float* slot = stA + (size_t)(((b * 8 + hb) * NSC + j) * 128);
    LAS float* const sg = (LAS float*)(lds + L_SG);
    TREG_BEGIN(11); TREG_BEGIN(12);
    __syncthreads();
    { const float* wa = F.in[I_AGAW] + ((size_t)layer * 8 + hb) * 4096; const float* wx = F.in[I_AGXW] + ((size_t)layer * 8 + hb) * 4096;
      const int jo = tid & 63, i0 = (tid >> 6) * 8; float va[8], vx[8];
#pragma unroll
      for (int e = 0; e < 8; ++e) { va[e] = wa[(i0 + e) * 64 + jo]; vx[e] = wx[(i0 + e) * 64 + jo]; }
      *(LAS v4u*)(lds + L_WA + jo * P64 + i0 * 2) = pack8(va); *(LAS v4u*)(lds + L_WX + jo * P64 + i0 * 2) = pack8(vx); }
    if (tid < 64) { sg[1024 + tid] = PASS == 3 ? slot[64 + tid] : 0.f; sg[1088 + tid] = 1.f; }
    float cw0 = 0.f, cw1 = 0.f, cw2 = 0.f, cw3 = 0.f, cbs = 0.f;
    if (tid < 256) { const int chg = hb * 64 + (tid & 63); const float* cwp = F.in[I_ACW] + (size_t)layer * 4 * BRW + chg;
        cw0 = cwp[0]; cw1 = cwp[BRW]; cw2 = cwp[2 * BRW]; cw3 = cwp[3 * BRW]; cbs = F.in[I_ACB][layer * BRW + chg]; }
    float ba[2], bx[2], sp[2];
#pragma unroll
    for (int i2 = 0; i2 < 2; ++i2) { const int chg = hb * 64 + (2 * (w & 1) + i2) * 16 + c;
        ba[i2] = F.in[I_AGAB][layer * BRW + chg]; bx[i2] = F.in[I_AGXB][layer * BRW + chg]; sp[i2] = softplusf_(-F.in[I_ALAM][layer * BRW + chg]); }
    v4u pf[NPF];
    { const int cg = j * NCH; const size_t row0 = (size_t)b * SEQ + (size_t)cg * 64;
#pragma unroll
      for (int i = 0; i < NPF; ++i) { int go, lo; raw_piece<PASS>(tid, i, hb, go, lo); pf[i] = (v4u){0u, 0u, 0u, 0u};
          if (!(cg == 0 && go < 0)) pf[i] = *(const v4u*)(P + (ptrdiff_t)row0 * PLD + go); } }
    TREG_END(12);
    for (int ci = 0; ci < NCH; ++ci) {
        const int cg = j * NCH + ci; const size_t row0 = (size_t)b * SEQ + (size_t)cg * 64;
        int tl = tid; asm volatile("" : "+v"(tl));
#pragma unroll
        for (int i = 0; i < NPF; ++i) { int go, lo; raw_piece<PASS>(tl, i, hb, go, lo); *(LAS v4u*)(lds + lo) = pf[i]; }
        if (ci + 1 < NCH) {
#pragma unroll
            for (int i = 0; i < NPF; ++i) { int go, lo; raw_piece<PASS>(tl, i, hb, go, lo); pf[i] = *(const v4u*)(P + (ptrdiff_t)(row0 + 64) * PLD + go); } }
        __syncthreads();
        if (tid < 256) {
            const int ch = tid & 63, lq = tid >> 6; const LAS unsigned char* rp = lds + L_RU + (lq * 16) * 144 + ch * 2;
            float x3 = bf2f(*(const LAS bf16*)(rp)), x2 = bf2f(*(const LAS bf16*)(rp + 144)), x1 = bf2f(*(const LAS bf16*)(rp + 288));
#pragma unroll
            for (int e = 0; e < 16; ++e) { const float x0 = bf2f(*(const LAS bf16*)(rp + (3 + e) * 144));
                const float xc = cbs + cw3 * x0 + cw2 * x1 + cw1 * x2 + cw0 * x3; x3 = x2; x2 = x1; x1 = x0;
                const int l = lq * 16 + e;
                *(LAS bf16*)(lds + L_XB + l * P64 + ch * 2) = (bf16)f2bf(xc); *(LAS float*)(lds + L_XF + (l * 64 + ch) * 4) = xc; }
        }
        __syncthreads();
        { const int lt = w >> 1, jt0 = 2 * (w & 1);
          f32x4 ra[2] = {(f32x4){0.f, 0.f, 0.f, 0.f}, (f32x4){0.f, 0.f, 0.f, 0.f}}, ia[2] = {(f32x4){0.f, 0.f, 0.f, 0.f}, (f32x4){0.f, 0.f, 0.f, 0.f}};
#pragma unroll
          for (int kb = 0; kb < 2; ++kb) { const bf16x8 xf = ldf(lds + L_XB, P64, lt * 16 + c, kb * 32 + q * 8);
#pragma unroll
              for (int i2 = 0; i2 < 2; ++i2) { const bf16x8 ya = ldf(lds + L_WA, P64, (jt0 + i2) * 16 + c, kb * 32 + q * 8), yx = ldf(lds + L_WX, P64, (jt0 + i2) * 16 + c, kb * 32 + q * 8);
                  ra[i2] = __builtin_amdgcn_mfma_f32_16x16x32_bf16(xf, ya, ra[i2], 0, 0, 0); ia[i2] = __builtin_amdgcn_mfma_f32_16x16x32_bf16(xf, yx, ia[i2], 0, 0, 0); } }
#pragma unroll
          for (int i2 = 0; i2 < 2; ++i2)
#pragma unroll
              for (int r = 0; r < 4; ++r) { const int l = lt * 16 + 4 * q + r, jj = (jt0 + i2) * 16 + c;
                  const float rr = sigmoidf_(ra[i2][r] + ba[i2]), ig = sigmoidf_(ia[i2][r] + bx[i2]);
                  const float la = -8.0f * rr * sp[i2]; const float a = __expf(la);
                  const float dr = sqrtf(neg_expm1_neg(2.0f * la)) * (ig * *(const LAS float*)(lds + L_XF + (l * 64 + jj) * 4));
                  *(LAS float*)(lds + L_A + (l * 68 + jj) * 4) = a; *(LAS float*)(lds + L_D + (l * 68 + jj) * 4) = dr; } }
        __syncthreads();
        { const int ch = lane, l0 = w * 8;
          float av[8], dv[8];
#pragma unroll
          for (int e = 0; e < 8; ++e) { av[e] = *(const LAS float*)(lds + L_A + ((l0 + e) * 68 + ch) * 4); dv[e] = *(const LAS float*)(lds + L_D + ((l0 + e) * 68 + ch) * 4); }
          float pa = 1.f, hl = 0.f;
#pragma unroll
          for (int e = 0; e < 8; ++e) { hl = av[e] * hl + dv[e]; pa *= av[e]; }
          sg[w * 64 + ch] = pa; sg[512 + w * 64 + ch] = hl;
          __syncthreads();
          float hs = sg[1024 + ch], ap = sg[1088 + ch];
          for (int s2 = 0; s2 < w; ++s2) { const float pa2 = sg[s2 * 64 + ch]; hs = pa2 * hs + sg[512 + s2 * 64 + ch]; ap *= pa2; }
#pragma unroll
          for (int e = 0; e < 8; ++e) { hs = av[e] * hs + dv[e];
              if (PASS == 3) { const float z = bf2f(*(const LAS bf16*)(lds + L_RZ + (l0 + e) * 144 + ch * 2)); *(LAS bf16*)(lds + L_YT + (l0 + e) * 128 + ch * 2) = (bf16)f2bf(hs * siluf_(z)); } }
          __syncthreads();
          if (w == 7) { sg[1024 + ch] = hs; sg[1088 + ch] = ap * pa; }
        }
        if (PASS == 3) {
            const int r = tid >> 3, c8 = tid & 7;
            *(v4u*)(Y + (row0 + r) * 2048 + hb * 64 + c8 * 8) = *(const LAS v4u*)(lds + L_YT + r * 128 + c8 * 16);
        }
    }
    __syncthreads();
    TREG_END(11);
    if (PASS == 1 && tid < 64) { slot[tid] = sg[1088 + tid]; slot[64 + tid] = sg[1024 + tid]; }
}
__device__ __forceinline__ void scan_part(Frame& F, float* stA) {
    for (int idx = F.bid * (NWAVES * 64) + F.tid; idx < BATCH * BRW; idx += F.G * NWAVES * 64) {
        const int b = idx >> 9, chx = idx & 511, hb = chx >> 6, ch = chx & 63; float start = 0.f;
        for (int j = 0; j < NSC; ++j) { float* s = stA + (size_t)(((b * 8 + hb) * NSC + j) * 128); const float ap = s[ch], hl = s[64 + ch]; s[64 + ch] = start; start = ap * start + hl; }
    }
}
}

__device__ __forceinline__ void conv_unit(Frame& F, int layer, int u) {
    const bf16* P = (const bf16*)(F.ws + WS_P) + 1024; bf16* ACT = (bf16*)(F.ws + WS_ACT);
    const int c0 = 2 * F.tid; const size_t row0 = (size_t)u * 64;
    const float* cwp = F.in[I_BCW] + (size_t)layer * 4 * 1024 + c0; const float* cbp = F.in[I_BCB] + (size_t)layer * 1024 + c0;
    const float a0 = cwp[0], a1 = cwp[1024], a2 = cwp[2048], a3 = cwp[3072], ab = cbp[0];
    const float b0 = cwp[1], b1 = cwp[1025], b2 = cwp[2049], b3 = cwp[3073], bb = cbp[1];
    const bf16* src = P + row0 * 2560 + c0;
    float xa1 = 0.f, xa2 = 0.f, xa3 = 0.f, xb1 = 0.f, xb2 = 0.f, xb3 = 0.f;
    if ((row0 & (SEQ - 1)) != 0) { const unsigned h1 = *(const unsigned*)(src - 2560), h2 = *(const unsigned*)(src - 2 * 2560), h3 = *(const unsigned*)(src - 3 * 2560);
        xa1 = pg8::bf_lo(h1); xb1 = pg8::bf_hi(h1); xa2 = pg8::bf_lo(h2); xb2 = pg8::bf_hi(h2); xa3 = pg8::bf_lo(h3); xb3 = pg8::bf_hi(h3); }
#pragma unroll 1
    for (int g = 0; g < 4; ++g) { unsigned r[16];
#pragma unroll
        for (int e = 0; e < 16; ++e) r[e] = *(const unsigned*)(src + (size_t)(16 * g + e) * 2560);
#pragma unroll
        for (int e = 0; e < 16; ++e) { const float xa0 = pg8::bf_lo(r[e]), xb0 = pg8::bf_hi(r[e]);
            const float ca = ab + a3 * xa0 + a2 * xa1 + a1 * xa2 + a0 * xa3, cb = bb + b3 * xb0 + b2 * xb1 + b1 * xb2 + b0 * xb3;
            xa3 = xa2; xa2 = xa1; xa1 = xa0; xb3 = xb2; xb2 = xb1; xb1 = xb0;
            *(unsigned*)(ACT + (row0 + 16 * g + e) * 1024 + c0) = pk2(siluf_(ca), siluf_(cb)); } }
}

__device__ __forceinline__ void phase_final(Frame& F) {
    const bf16* delta = (const bf16*)(F.ws + WS_Y);
    const int gw = F.bid * NWAVES + F.wave, NGW = F.G * NWAVES;
    const float* ng = F.in[I_FNG];
    f32x4 gv[4];
#pragma unroll
    for (int j = 0; j < 4; ++j) gv[j] = *((const f32x4*)ng + F.lane + 64 * j);
    for (int row = gw; row < T; row += NGW) {
        f32x4* xr = (f32x4*)(F.out + (size_t)row * D) + F.lane;
        f32x4 v[4]; float s = 0.f;
#pragma unroll
        for (int j = 0; j < 4; ++j) { v[j] = xr[64 * j]; const v2u dw = *((const v2u*)(delta + (size_t)row * D) + F.lane + 64 * j);
            v[j].x += pg8::bf_lo(dw.x); v[j].y += pg8::bf_hi(dw.x); v[j].z += pg8::bf_lo(dw.y); v[j].w += pg8::bf_hi(dw.y);
            s += (v[j].x * v[j].x + v[j].y * v[j].y) + (v[j].z * v[j].z + v[j].w * v[j].w); }
        const float rs = 1.0f / sqrtf(wave_sum(s) * (1.f / D) + EPS);
#pragma unroll
        for (int j = 0; j < 4; ++j) xr[64 * j] = v[j] * rs * gv[j];
    }
}

constexpr int NPL = 13;
constexpr int NPH = DEPTH * NPL + 1;

__device__ __forceinline__ void gemm_in_group(Frame& F, int col0, int ncols) {
    pg8::Gemm g{(const pg8::bf16_t*)(F.ws + WS_HN), (const pg8::bf16_t*)(F.ws + WS_W1) + (size_t)col0 * D, T, ncols, D, D, D, 0};
    pg8::StaticOrder S; S.init(T, ncols, F.G, F.bid);
    pg8::EpiBf16S E{(pg8::bf16_t*)(F.ws + WS_P), ncols, 0};
    pg8::gemm_phase<pg8::EpiBf16S, pg8::StaticOrder, true, true>(F.lds, g, S, E, F.tid);
}


__device__ __forceinline__ void phase_body(Frame& F, int layer, const int k) {
        float* const stBC = (float*)(F.ws + WS_STBC); float* const stD = (float*)(F.ws + WS_STD); float* const stA = (float*)(F.ws + WS_RGST);
        float* const scB = (float*)(F.ws + WS_SCB); float* const scC = (float*)(F.ws + WS_SCC); float* const scD = (float*)(F.ws + WS_SCD);
        float* const nC = (float*)(F.ws + WS_NC); float* const ssqB = (float*)(F.ws + WS_SSQB);
        switch (k) {
        case 0: { volatile LAS unsigned* tw_ = (volatile LAS unsigned*)(F.lds + LDS_BYTES - 64);
            if (TPHASE == 21 && F.tid == 0) tw_[6] = (unsigned)__builtin_amdgcn_s_memrealtime();
            phase_prep(F, layer, layer <= 1 ? F.in[I_X] : F.out, layer == 0 ? nullptr : (const bf16*)(F.ws + WS_Y), F.out);
            if (TPHASE == 21 && F.tid == 0) tw_[4] += (unsigned)__builtin_amdgcn_s_memrealtime() - tw_[6];
            if (TPHASE == 20 && F.tid == 0) tw_[6] = (unsigned)__builtin_amdgcn_s_memrealtime();
            phase_weights(F, layer);
            if (TPHASE == 20) { __syncthreads(); if (F.tid == 0) tw_[4] += (unsigned)__builtin_amdgcn_s_memrealtime() - tw_[6]; } } break;
        case 1: gemm_in_group(F, GA0, 2560); break;
        case 2: for (int it = F.bid; it < 1024; it += F.G) {
                if (it < 512) conv_unit(F, layer, it);
                else { const int i2 = it - 512, j = i2 % rg::NSC, hb = (i2 / rg::NSC) & 7, b = i2 / (rg::NSC * 8); rg::item<1>(F, layer, b, hb, j, stA); } } break;
        case 3: for (int it = F.bid; it < 512; it += F.G) { const int j = it % 16, head = (it / 16) & 7, b = it / 128; gla::gla_item<0, 1>(F, layer, b, head, j, stBC, scB, nullptr, ssqB); } break;
        case 4: rg::scan_part(F, stA); gla::scan_part<0>(F, stBC, scB, nullptr); break;
        case 5: for (int it = F.bid; it < 1024; it += F.G) {
                if (it < 512) { const int j = it % rg::NSC, hb = (it / rg::NSC) & 7, b = it / (rg::NSC * 8); rg::item<3>(F, layer, b, hb, j, stA); }
                else { const int i2 = it - 512, j = i2 % 16, head = (i2 / 16) & 7, b = i2 / 128; gla::gla_item<0, 3>(F, layer, b, head, j, stBC, scB, nullptr, ssqB); } } break;
        case 6: gemm_in_group(F, GC0, 4096); break;
        case 7: for (int it = F.bid; it < 512; it += F.G) {
                const int i2 = it & 255, j = i2 % 16, head = (i2 / 16) & 3, b = i2 / 64;
                if (it < 256) gla::gla_item<1, 1>(F, layer, b, head, j, stBC, scC, nC, nullptr); else gla::gla_item<2, 1>(F, layer, b, head, j, stD, scD, nullptr, nullptr); } break;
        case 8: gla::scan_part<1>(F, stBC, scC, nC); gla::scan_part<2>(F, stD, scD, nullptr);
            for (int row = F.bid * (NWAVES * 64) + F.tid; row < T; row += F.G * NWAVES * 64) {
                const f32x4 s0 = *(const f32x4*)(ssqB + (size_t)row * 8), s1 = *(const f32x4*)(ssqB + (size_t)row * 8 + 4);
                ((float*)(F.ws + WS_RSB))[row] = 1.0f / sqrtf((((s0[0] + s0[1]) + (s0[2] + s0[3])) + ((s1[0] + s1[1]) + (s1[2] + s1[3]))) * (1.0f / 512.0f) + EPS); }
            break;
        case 9: for (int it = F.bid; it < 512; it += F.G) {
                const int i2 = it & 255, j = i2 % 16, head = (i2 / 16) & 3, b = i2 / 64;
                if (it < 256) gla::gla_item<1, 3>(F, layer, b, head, j, stBC, scC, nC, nullptr); else gla::gla_item<2, 3>(F, layer, b, head, j, stD, scD, nullptr, nullptr); } break;
        case 10: {
            pg8::Gemm g{(const pg8::bf16_t*)(F.ws + WS_HN), (const pg8::bf16_t*)(F.ws + WS_W1) + (size_t)GG0 * D, T, 4096, D, D, D, 0};
            pg8::StaticOrder S; S.init(T, 4096, F.G, F.bid);
            pg8::EpiGates E{(pg8::bf16_t*)(F.ws + WS_P)};
            pg8::gemm_phase<pg8::EpiGates, pg8::StaticOrder, true, true>(F.lds, g, S, E, F.tid);
        } break;
        case 11: {
            pg8::Gemm g{(const pg8::bf16_t*)(F.ws + WS_Y), (const pg8::bf16_t*)(F.ws + WS_WB), T, D, BRW, 2048, 2048, BRW};
            pg8::SegOrder<4> S; S.init(T, D, F.G, F.bid);
            pg8::EpiHorner E{(const pg8::bf16_t*)(F.ws + WS_P), (const float*)(F.ws + WS_RSB), (pg8::bf16_t*)(F.ws + WS_HN), 1024};
            pg8::gemm_phase<pg8::EpiHorner, pg8::SegOrder<4>, true, true>(F.lds, g, S, E, F.tid);
        } break;
        case 12: {
            pg8::Gemm g{(const pg8::bf16_t*)(F.ws + WS_HN), (const pg8::bf16_t*)(F.ws + WS_WO), T, D, D, D, D, 0};
            pg8::StaticOrder S; S.init(T, D, F.G, F.bid);
            pg8::EpiBf16S E{(pg8::bf16_t*)(F.ws + WS_Y), D, 0};
            pg8::gemm_phase<pg8::EpiBf16S, pg8::StaticOrder, true, true>(F.lds, g, S, E, F.tid);
        } break;
        }
}
template <int PH>
__device__ __forceinline__ void run_phases(const Args& args, unsigned char* ldsg) {
    Frame F;
    { int t_ = threadIdx.x, layer_ = PH / NPL; size_t z_ = 0; InTab i_ = (InTab)__builtin_amdgcn_kernarg_segment_ptr(); unsigned l_ = (unsigned)(size_t)(LAS unsigned char*)ldsg;
      asm volatile("" : "+v"(t_), "+s"(z_), "+s"(layer_), "+s"(i_), "+s"(l_));
      F.lds = (LAS unsigned char*)(size_t)l_; F.in = i_; F.tid = t_; F.lane = t_ & 63; F.wave = __builtin_amdgcn_readfirstlane(t_ >> 6); F.ws = args.ws + z_; F.out = (float*)((unsigned char*)args.out + z_); F.G = gridDim.x; F.bid = blockIdx.x;
      if (PH == 1) cooperative_groups::this_grid().sync();
      else if (PH > 1) xcd_barrier((unsigned*)(F.ws + WS_CTL) + 4096, (volatile LAS unsigned*)(F.lds + LDS_BYTES - 64));
      const bool timed_ = TPHASE >= 0 && (PH == NPH - 1 ? TPHASE == NPL : TPHASE == PH % NPL);
      if (timed_ && F.tid == 0) ((volatile LAS unsigned*)(F.lds + LDS_BYTES - 64))[6] = (unsigned)__builtin_amdgcn_s_memrealtime();
      if (PH == NPH - 1) phase_final(F); else phase_body(F, layer_, PH % NPL);
      if (timed_) { __syncthreads(); if (F.tid == 0) { volatile LAS unsigned* w_ = (volatile LAS unsigned*)(F.lds + LDS_BYTES - 64); w_[4] += (unsigned)__builtin_amdgcn_s_memrealtime() - w_[6]; } } }
    if constexpr (PH + 1 < NPH) run_phases<PH + 1>(args, ldsg);
}

__global__ void __launch_bounds__(NWAVES * 64, 2) fwd(Args args) {
    extern __shared__ __attribute__((aligned(16))) unsigned char lds[];
    { volatile LAS unsigned* bst = (volatile LAS unsigned*)((LAS unsigned char*)lds + LDS_BYTES - 64);
      if (threadIdx.x < 16) bst[threadIdx.x] = 0u;
      __syncthreads();
      (void)xcd_barrier_post((unsigned*)(args.ws + WS_CTL) + 4096, bst); }
    run_phases<0>(args, lds);
    if ((TSEL != 0 || TPHASE >= 0) && blockIdx.x == 0 && threadIdx.x == 0) { volatile LAS unsigned* bst = (volatile LAS unsigned*)((LAS unsigned char*)lds + LDS_BYTES - 64);
        const unsigned long long t0_ = __builtin_amdgcn_s_memrealtime(); const unsigned ticks = bst[4];
        while (__builtin_amdgcn_s_memrealtime() - t0_ < (unsigned long long)ticks) __builtin_amdgcn_s_sleep(8); }
}

extern "C" void kernel_launch(void* const* d_in, const int* in_sizes, int n_in, void* d_out, int out_size, void* d_ws, size_t ws_size, hipStream_t stream) {
    static int grid = 0;
    if (grid == 0) {
        if (n_in != 23 || in_sizes[0] != T * D || out_size != T * D || ws_size < WS_END) { fprintf(stderr, "kernel_launch: unexpected shapes (n_in %d, in0 %d, out %d, ws %zu)\n", n_in, n_in > 0 ? in_sizes[0] : -1, out_size, ws_size); grid = -1; return; }
        int dev = 0, cus = 0, per_cu = 0;
        if (hipGetDevice(&dev) != hipSuccess || hipDeviceGetAttribute(&cus, hipDeviceAttributeMultiprocessorCount, dev) != hipSuccess) { grid = -1; return; }
        if (hipFuncSetAttribute((const void*)fwd, hipFuncAttributeMaxDynamicSharedMemorySize, LDS_BYTES) != hipSuccess) { fprintf(stderr, "kernel_launch: hipFuncSetAttribute failed\n"); grid = -1; return; }
        if (hipOccupancyMaxActiveBlocksPerMultiprocessor(&per_cu, (const void*)fwd, NWAVES * 64, LDS_BYTES) != hipSuccess || per_cu < 1) { fprintf(stderr, "kernel_launch: occupancy query says %d blocks per CU\n", per_cu); grid = -1; return; }
        grid = cus;
    }
    if (grid < 0) return;
    Args a{};
    for (int i = 0; i < 23; ++i) a.in[i] = (const float*)d_in[i];
    a.out = (float*)d_out; a.ws = (unsigned char*)d_ws; a.ph_lo = 0; a.ph_hi = NPH;
    if (hipMemsetAsync((char*)d_ws + WS_CTL, 0, CTL_ZERO_BYTES, stream) != hipSuccess) { fprintf(stderr, "kernel_launch: memset failed\n"); return; }
    void* kargs[] = {&a};
    hipError_t e = hipLaunchCooperativeKernel((const void*)fwd, dim3(grid), dim3(NWAVES * 64), kargs, LDS_BYTES, stream);
    if (e != hipSuccess) fprintf(stderr, "kernel_launch: cooperative launch failed: %s (grid %d)\n", hipGetErrorString(e), grid);
}
```
